# Optimizing an MI355X kernel written in HIP

```python
import math
import jax
import jax.numpy as jnp
from jax import lax
import numpy as np

D_MODEL = 1024
BATCH = 8
SEQ = 8192
DEPTH = 1

N_META = 16
CHUNK = 64
META_PAD = CHUNK - N_META
HG_HEADS = 8
HG_DK = 128
HG_DV = 128
ML_HEADS = 4
ML_DK = 128
ML_DV = 256
CONV_W = 4
FG_BIAS_LO = 3.0
FG_BIAS_HI = 6.0
N_EXPERTS = 64
TOP_K = 8
N_GROUPS = 8
TOPK_GROUPS = 4
D_EXPERT = 256
ROUTED_SCALE = 2.5
MOE_BLOCK = 256
DN_ALPHA = (2.0 * DEPTH) ** 0.25
DN_BETA = (8.0 * DEPTH) ** -0.25
EPS = 1e-5

HG_KW = HG_HEADS * HG_DK
HG_VW = HG_HEADS * HG_DV
ML_KW = ML_HEADS * ML_DK
ML_VW = ML_HEADS * ML_DV
IN_SPLITS = (HG_KW, HG_KW, HG_VW, HG_VW, ML_KW, ML_KW, ML_VW, ML_VW, ML_HEADS, ML_HEADS, D_MODEL, D_MODEL)
IN_WIDTH = sum(IN_SPLITS)

kernel_name = 'hybrid_hgrn2_mlstm_moe_block'


def _layer_norm(x, g, b):
    xf = x.astype(jnp.float32)
    xc = xf - jnp.mean(xf, axis=-1, keepdims=True)
    var = jnp.mean(xc * xc, axis=-1, keepdims=True)
    return (xc * lax.rsqrt(var + EPS) * g + b).astype(x.dtype)


def _head_norm(x, heads, g, center):
    b_, l_, w_ = x.shape
    xf = x.astype(jnp.float32).reshape(b_, l_, heads, w_ // heads)
    if center:
        xf = xf - jnp.mean(xf, axis=-1, keepdims=True)
    var = jnp.mean(xf * xf, axis=-1, keepdims=True)
    return (xf * lax.rsqrt(var + EPS)).reshape(b_, l_, w_) * g


def _front_pad(a, value):
    pads = [(0, 0), (META_PAD, 0)] + [(0, 0)] * (a.ndim - 2)
    return jnp.pad(a, pads, constant_values=value)


def _to_chunks(a, heads):
    b_, lp, w_ = a.shape
    return a.reshape(b_, lp // CHUNK, CHUNK, heads, w_ // heads).transpose(1, 0, 3, 2, 4)


def _from_chunks(o):
    n_, b_, h_, c_, d_ = o.shape
    return o.transpose(1, 0, 3, 2, 4).reshape(b_, n_ * c_, h_ * d_)


def _causal_dwconv(x, w, b):
    y = lax.conv_general_dilated(x, w[:, None, :], window_strides=(1,), padding=[(CONV_W - 1, 0)],
                                 dimension_numbers=('NWC', 'WIO', 'NWC'), feature_group_count=x.shape[-1])
    return y + b


def _hgrn2_chunkwise(q, k, v, log_f):
    q, k, v, log_f = (_to_chunks(_front_pad(a.astype(jnp.float32), 0.0), HG_HEADS) for a in (q, k, v, log_f))
    causal = jnp.tril(jnp.ones((CHUNK, CHUNK), dtype=bool))

    def step(state, inp):
        qc, kc, vc, lfc = inp
        b = jnp.cumsum(lfc, axis=2)
        o_inter = jnp.einsum('bhtk,bhkv->bhtv', qc * jnp.exp(b), state)
        rel = b[:, :, :, None, :] - b[:, :, None, :, :]
        decay = jnp.exp(jnp.where(causal[:, :, None], rel, -jnp.inf))
        scores = jnp.einsum('bhtk,bhsk,bhtsk->bhts', qc, kc, decay)
        o = o_inter + jnp.einsum('bhts,bhsv->bhtv', scores, vc)
        b_last = b[:, :, -1:, :]
        state = jnp.exp(b_last[:, :, 0, :])[..., None] * state + jnp.einsum(
            'bhsk,bhsv->bhkv', kc * jnp.exp(b_last - b), vc)
        return state, o

    s0 = jnp.zeros((q.shape[1], HG_HEADS, HG_DK, HG_DV), jnp.float32)
    _, o = lax.scan(step, s0, (q, k, v, log_f))
    return _from_chunks(o)[:, META_PAD:]


def _mlstm_chunkwise(q, k, v, ig, log_f):
    q, k, v = (_to_chunks(_front_pad(a.astype(jnp.float32), 0.0), ML_HEADS) for a in (q, k, v))
    ig = _to_chunks(_front_pad(ig.astype(jnp.float32), -jnp.inf), ML_HEADS)[..., 0]
    log_f = _to_chunks(_front_pad(log_f.astype(jnp.float32), 0.0), ML_HEADS)[..., 0]
    causal = jnp.tril(jnp.ones((CHUNK, CHUNK), dtype=bool))

    def step(carry, inp):
        c_st, n_st, m_st = carry
        qc, kc, vc, igc, lfc = inp
        b = jnp.cumsum(lfc, axis=-1)
        log_intra = jnp.where(causal, b[..., :, None] - b[..., None, :] + igc[..., None, :], -jnp.inf)
        log_inter = b + m_st[..., None]
        m_t = jnp.maximum(log_inter, jnp.max(log_intra, axis=-1))
        w_intra = jnp.exp(log_intra - m_t[..., None])
        w_inter = jnp.exp(log_inter - m_t)
        s = jnp.einsum('bhtd,bhsd->bhts', qc, kc) * w_intra
        num = w_inter[..., None] * jnp.einsum('bhtd,bhdv->bhtv', qc, c_st) + jnp.einsum('bhts,bhsv->bhtv', s, vc)
        den = w_inter * jnp.einsum('bhtd,bhd->bht', qc, n_st) + jnp.sum(s, axis=-1)
        h = num / jnp.maximum(jnp.abs(den), jnp.exp(-m_t))[..., None]
        b_last = b[..., -1]
        log_w = b_last[..., None] - b + igc
        m_new = jnp.maximum(b_last + m_st, jnp.max(log_w, axis=-1))
        w_s = jnp.exp(log_w - m_new[..., None])
        decay = jnp.exp(b_last + m_st - m_new)
        c_st = decay[..., None, None] * c_st + jnp.einsum('bhsd,bhsv->bhdv', kc * w_s[..., None], vc)
        n_st = decay[..., None] * n_st + jnp.einsum('bhsd,bhs->bhd', kc, w_s)
        return (c_st, n_st, m_new), h

    b_ = q.shape[1]
    carry0 = (jnp.zeros((b_, ML_HEADS, ML_DK, ML_DV), jnp.float32),
              jnp.zeros((b_, ML_HEADS, ML_DK), jnp.float32),
              jnp.zeros((b_, ML_HEADS), jnp.float32))
    _, h = lax.scan(step, carry0, (q, k, v, ig, log_f))
    return _from_chunks(h)[:, META_PAD:]


def _hybrid_mixer(h, w_in, lb, hg_norm_g, conv_w, conv_b, ig_bias, fg_bias, ml_norm_g, w_a, w_b, w_out):
    proj = jnp.einsum('bld,de->ble', h, w_in)
    split_at = [int(s) for s in np.cumsum(IN_SPLITS)[:-1]]
    (q_a, f_a, i_a, g_a, q_b, k_b, v_b, o_b, ig_b, fg_b, gate_a, gate_b) = jnp.split(proj, split_at, axis=-1)
    f = lb + (1.0 - lb) * jax.nn.sigmoid(f_a.astype(jnp.float32))
    o_a = _hgrn2_chunkwise(q_a, 1.0 - f, i_a, jnp.log(f))
    y_a = (_head_norm(o_a, HG_HEADS, hg_norm_g, False) * jax.nn.silu(g_a.astype(jnp.float32))).astype(h.dtype)
    qk = jax.nn.silu(_causal_dwconv(jnp.concatenate([q_b, k_b], axis=-1), conv_w, conv_b))
    q_b, k_b = jnp.split(qk, 2, axis=-1)
    h_b = _mlstm_chunkwise(q_b * (ML_DK ** -0.5), k_b, v_b,
                           ig_b.astype(jnp.float32) + ig_bias,
                           jax.nn.log_sigmoid(fg_b.astype(jnp.float32) + fg_bias))
    y_b = (_head_norm(h_b, ML_HEADS, ml_norm_g, True) * jax.nn.sigmoid(o_b.astype(jnp.float32))).astype(h.dtype)
    merged = (jax.nn.sigmoid(gate_a) * jnp.einsum('blv,vd->bld', y_a, w_a)
              + jax.nn.sigmoid(gate_b) * jnp.einsum('blv,vd->bld', y_b, w_b))
    return jnp.einsum('bld,de->ble', merged, w_out)


def _moe_ffn(h, w_router, router_bias, w_gate, w_up, w_down, w_sh_gate, w_sh_up, w_sh_down):
    b_, l_, d_ = h.shape
    n_tok = b_ * l_
    hf = h.reshape(n_tok, d_)
    scores = jax.nn.sigmoid(jnp.einsum('td,de->te', hf, w_router).astype(jnp.float32))
    biased = scores + router_bias.astype(jnp.float32)
    grouped = biased.reshape(n_tok, N_GROUPS, N_EXPERTS // N_GROUPS)
    group_score = jnp.sum(lax.top_k(grouped, 2)[0], axis=-1)
    _, gidx = lax.top_k(group_score, TOPK_GROUPS)
    gmask = jnp.any(gidx[..., None] == jnp.arange(N_GROUPS)[None, None, :], axis=1)
    emask = jnp.repeat(gmask, N_EXPERTS // N_GROUPS, axis=1)
    _, eidx = lax.top_k(jnp.where(emask, biased, -jnp.inf), TOP_K)
    gw = jnp.take_along_axis(scores, eidx, axis=1)
    gw = gw / jnp.sum(gw, axis=-1, keepdims=True) * ROUTED_SCALE
    n_assign = n_tok * TOP_K
    e_flat = eidx.reshape(-1).astype(jnp.int32)
    tok_flat = jnp.arange(n_assign, dtype=jnp.int32) // TOP_K
    w_flat = gw.reshape(-1)
    order = jnp.argsort(e_flat)
    se, stok, sw = e_flat[order], tok_flat[order], w_flat[order]
    counts = jnp.bincount(e_flat, length=N_EXPERTS).astype(jnp.int32)
    starts = jnp.cumsum(counts) - counts
    padded = (counts + MOE_BLOCK - 1) // MOE_BLOCK * MOE_BLOCK
    pends = jnp.cumsum(padded)
    pstarts = pends - padded
    dest = pstarts[se] + jnp.arange(n_assign, dtype=jnp.int32) - starts[se]
    n_blocks = -(-n_assign // MOE_BLOCK) + N_EXPERTS
    n_slots = n_blocks * MOE_BLOCK
    tok_buf = jnp.full((n_slots,), n_tok, jnp.int32).at[dest].set(stok)
    w_buf = jnp.zeros((n_slots,), jnp.float32).at[dest].set(sw)
    blk_start = jnp.arange(n_blocks, dtype=jnp.int32) * MOE_BLOCK
    blk_expert = jnp.minimum(jnp.searchsorted(pends, blk_start, side='right'), N_EXPERTS - 1)
    h_pad = jnp.concatenate([hf, jnp.zeros((1, d_), hf.dtype)], axis=0)

    def step(acc, inp):
        tok, w, e = inp
        xb = h_pad[tok]
        a = jnp.einsum('td,df->tf', xb, w_gate[e])
        u = jnp.einsum('td,df->tf', xb, w_up[e])
        y = jnp.einsum('tf,fd->td', jax.nn.silu(a) * u, w_down[e]) * w[:, None]
        return acc.at[tok].add(y.astype(acc.dtype)), None

    acc0 = jnp.zeros((n_tok + 1, d_), jnp.float32)
    routed, _ = lax.scan(step, acc0, (tok_buf.reshape(n_blocks, MOE_BLOCK),
                                      w_buf.reshape(n_blocks, MOE_BLOCK), blk_expert))
    shared = jnp.einsum('tf,fd->td', jax.nn.silu(jnp.einsum('td,df->tf', hf, w_sh_gate))
                        * jnp.einsum('td,df->tf', hf, w_sh_up), w_sh_down)
    return (routed[:n_tok] + shared).reshape(b_, l_, d_).astype(h.dtype)


def setup_inputs(seed: int = 0) -> dict:
    key = jax.random.key(seed)
    ks = jax.random.split(key, 27)
    nrm = lambda k, shp: jax.random.normal(k, shp, jnp.float32)
    L = DEPTH
    return {
        'x': nrm(ks[0], (BATCH, SEQ, D_MODEL)),
        'meta_tokens': nrm(ks[1], (N_META, D_MODEL)),
        'ln_emb_g': 1.0 + 0.02 * nrm(ks[2], (D_MODEL,)),
        'ln_emb_b': 0.02 * nrm(ks[3], (D_MODEL,)),
        'w_in': nrm(ks[4], (L, D_MODEL, IN_WIDTH)) * D_MODEL ** -0.5,
        'hg_lb_logits': 0.5 * nrm(ks[5], (DEPTH + 1, HG_KW)),
        'hg_norm_g': 1.0 + 0.02 * nrm(ks[6], (L, HG_VW)),
        'ml_conv_w': nrm(ks[7], (L, CONV_W, 2 * ML_KW)) * CONV_W ** -0.5,
        'ml_conv_b': 0.02 * nrm(ks[8], (L, 2 * ML_KW)),
        'ml_ig_bias': 0.1 * nrm(ks[9], (L, ML_HEADS)),
        'ml_fg_bias': jnp.linspace(FG_BIAS_LO, FG_BIAS_HI, ML_HEADS, dtype=jnp.float32)[None, :] + 0.1 * nrm(ks[10], (L, ML_HEADS)),
        'ml_norm_g': 1.0 + 0.02 * nrm(ks[11], (L, ML_VW)),
        'w_branch_a': nrm(ks[12], (L, HG_VW, D_MODEL)) * HG_VW ** -0.5 * DN_BETA,
        'w_branch_b': nrm(ks[13], (L, ML_VW, D_MODEL)) * ML_VW ** -0.5 * DN_BETA,
        'w_out': nrm(ks[14], (L, D_MODEL, D_MODEL)) * D_MODEL ** -0.5 * DN_BETA,
        'ln1_g': 1.0 + 0.02 * nrm(ks[15], (L, D_MODEL)),
        'ln1_b': 0.02 * nrm(ks[16], (L, D_MODEL)),
        'w_router': nrm(ks[17], (L, D_MODEL, N_EXPERTS)) * D_MODEL ** -0.5,
        'router_bias': 0.01 * nrm(ks[18], (L, N_EXPERTS)),
        'w_exp_gate': nrm(ks[19], (L, N_EXPERTS, D_MODEL, D_EXPERT)) * D_MODEL ** -0.5,
        'w_exp_up': nrm(ks[20], (L, N_EXPERTS, D_MODEL, D_EXPERT)) * D_MODEL ** -0.5,
        'w_exp_down': nrm(ks[21], (L, N_EXPERTS, D_EXPERT, D_MODEL)) * D_EXPERT ** -0.5 * DN_BETA,
        'w_sh_gate': nrm(ks[22], (L, D_MODEL, D_EXPERT)) * D_MODEL ** -0.5,
        'w_sh_up': nrm(ks[23], (L, D_MODEL, D_EXPERT)) * D_MODEL ** -0.5,
        'w_sh_down': nrm(ks[24], (L, D_EXPERT, D_MODEL)) * D_EXPERT ** -0.5 * DN_BETA,
        'ln2_g': 1.0 + 0.02 * nrm(ks[25], (L, D_MODEL)),
        'ln2_b': 0.02 * nrm(ks[26], (L, D_MODEL)),
    }


def reference(x, meta_tokens, ln_emb_g, ln_emb_b, w_in, hg_lb_logits, hg_norm_g, ml_conv_w, ml_conv_b,
              ml_ig_bias, ml_fg_bias, ml_norm_g, w_branch_a, w_branch_b, w_out, ln1_g, ln1_b,
              w_router, router_bias, w_exp_gate, w_exp_up, w_exp_down, w_sh_gate, w_sh_up, w_sh_down,
              ln2_g, ln2_b):
    b_ = x.shape[0]
    meta = jnp.broadcast_to(meta_tokens.astype(x.dtype)[None], (b_, N_META, D_MODEL))
    h = _layer_norm(jnp.concatenate([meta, x], axis=1), ln_emb_g, ln_emb_b)
    lower_bounds = jnp.cumsum(jax.nn.softmax(hg_lb_logits.astype(jnp.float32), axis=0), axis=0)
    for layer in range(DEPTH):
        mix = _hybrid_mixer(h, w_in[layer], lower_bounds[layer], hg_norm_g[layer], ml_conv_w[layer],
                            ml_conv_b[layer], ml_ig_bias[layer], ml_fg_bias[layer], ml_norm_g[layer],
                            w_branch_a[layer], w_branch_b[layer], w_out[layer])
        h = _layer_norm(DN_ALPHA * h + mix, ln1_g[layer], ln1_b[layer])
        ffn = _moe_ffn(h, w_router[layer], router_bias[layer], w_exp_gate[layer], w_exp_up[layer],
                       w_exp_down[layer], w_sh_gate[layer], w_sh_up[layer], w_sh_down[layer])
        h = _layer_norm(DN_ALPHA * h + ffn, ln2_g[layer], ln2_b[layer])
    return h[:, N_META:]
```

```cpp
#include <hip/hip_runtime.h>
#include <stdint.h>
#include <stdio.h>
#include <type_traits>

#define LAS __attribute__((address_space(3)))
typedef unsigned short bf16;
typedef float f32x4 __attribute__((ext_vector_type(4)));
typedef unsigned u32x4 __attribute__((ext_vector_type(4)));
typedef unsigned u32x2 __attribute__((ext_vector_type(2)));

constexpr int D = 1024, NB = 8, SEQ = 8192, T = NB * SEQ, NMETA = 16, INW = 9224;
constexpr int NEXP = 64, TOPK = 8, DEXP = 256;
constexpr float EPS = 1e-5f, DN_ALPHA = 1.189207115002721f, ROUTED_SCALE = 2.5f;
constexpr int HALF_T = T / 2;
constexpr int NSLOTMAX = HALF_T * TOPK + NEXP * 256;

constexpr size_t MiB = 1u << 20;
constexpr size_t WS_CTL = 0, CTL_ZERO_BYTES = 1 * MiB;
constexpr size_t WS_WINT = 1 * MiB;
constexpr size_t WS_WAT = 19 * MiB, WS_WBT = 21 * MiB, WS_WOT = 23 * MiB;
constexpr size_t WS_WSGU = 25 * MiB;
constexpr size_t WS_WSD = 26 * MiB;
constexpr size_t WS_META = 27 * MiB;
constexpr size_t WS_WRT = 27 * MiB + 512 * 1024;
constexpr size_t WS_IGFG = 28 * MiB;
constexpr size_t WS_LNST0 = 30 * MiB;
constexpr size_t WS_LNST1 = 30 * MiB + 512 * 1024;
constexpr size_t WS_STA = 31 * MiB;
constexpr size_t WS_STB = 33 * MiB;
constexpr size_t WS_EIDX = 35 * MiB, WS_GW = 37 * MiB, WS_LPOS = 39 * MiB, WS_SLOTOF = 41 * MiB;
constexpr size_t WS_TOKSLOT = 43 * MiB;
constexpr size_t WS_WSLOT = 46 * MiB;
constexpr size_t WS_WGBASE = 49 * MiB;
constexpr size_t WS_IDENT = 49 * MiB + 128 * 1024;
constexpr size_t WS_EM = 50 * MiB, WS_EL = 54 * MiB;
constexpr size_t WS_HALO = 58 * MiB;
constexpr size_t WS_GATES = 932 * MiB;
constexpr size_t WS_SMETA = 940 * MiB;
constexpr size_t WS_CMETA = 941 * MiB;
constexpr size_t WS_NMETA = 942 * MiB;
constexpr size_t WS_STA2 = 944 * MiB;
constexpr size_t WS_STB2 = 948 * MiB;
constexpr size_t WS_WGU = 64 * MiB;
constexpr size_t WS_WD = 128 * MiB;
constexpr size_t WS_H0 = 162 * MiB;
constexpr size_t WS_QA = 290 * MiB, WS_LFA = 418 * MiB, WS_IA = 546 * MiB, WS_QKB = 674 * MiB, WS_VB = 802 * MiB;
constexpr size_t WS_HH = 290 * MiB;
constexpr size_t WS_YH = 444 * MiB;
constexpr size_t WS_HS = 980 * MiB;
constexpr size_t WS_Z = 720 * MiB;
constexpr size_t WS_END = 1024 * MiB;
static_assert(WS_HH + (size_t)(NSLOTMAX + HALF_T) * 512 <= WS_YH && WS_YH + (size_t)NSLOTMAX * 1024 <= WS_Z && WS_Z + (size_t)T * D * 2 <= WS_GATES, "moe map");
constexpr int CW_BAR = 4096, CW_GCNT = 8192;

constexpr int LDS_BYTES = 147456;
constexpr int NPHASE = 20;

__device__ __forceinline__ unsigned f2bf(float f) { unsigned u = __float_as_uint(f); return (u + 0x7fffu + ((u >> 16) & 1u)) >> 16; }
__device__ __forceinline__ float bf2f(unsigned h) { return __uint_as_float(h << 16); }
typedef __bf16 hwbf16x2_t __attribute__((ext_vector_type(2)));
typedef float f32x2_t __attribute__((ext_vector_type(2)));
__device__ __forceinline__ unsigned pk2(float lo, float hi) { const f32x2_t f = {lo, hi}; const hwbf16x2_t b = __builtin_convertvector(f, hwbf16x2_t); return __builtin_bit_cast(unsigned, b); }
__device__ __forceinline__ unsigned f2h(float f) { _Float16 h = (_Float16)f; return (unsigned)__builtin_bit_cast(unsigned short, h); }
__device__ __forceinline__ float h2f(unsigned u) { return (float)__builtin_bit_cast(_Float16, (unsigned short)u); }
__device__ __forceinline__ float wave_sum(float v) {
#pragma unroll
    for (int o = 1; o < 64; o <<= 1) v += __shfl_xor(v, o);
    return v;
}
__device__ __forceinline__ void store8_bf16(bf16* p, const float (&v)[8]);
__device__ __forceinline__ float sigmoidf_(float x) { return __builtin_amdgcn_rcpf(1.0f + __expf(-x)); }
__device__ __forceinline__ float siluf_(float x) { return x * __builtin_amdgcn_rcpf(1.0f + __expf(-x)); }


#define XB_TMO      128
#define XB_XCNT(j)  (256  + 64 * (j))
#define XB_XSUB(j)  (1280 + 64 * (j))
#define XB_XGEN(j)  (2304 + 64 * (j))
#define XB_TOP      3328
#define XB_TOPGEN   3392
#define XCD_BAR_WORDS 3456
#define XB_SPIN_CAP (1u << 20)
__device__ __forceinline__ unsigned xb_ld(unsigned* p)              { return __hip_atomic_load(p, __ATOMIC_RELAXED, __HIP_MEMORY_SCOPE_AGENT); }
__device__ __forceinline__ unsigned xb_add(unsigned* p, unsigned v) { return __hip_atomic_fetch_add(p, v, __ATOMIC_RELAXED, __HIP_MEMORY_SCOPE_AGENT); }
__device__ __forceinline__ unsigned xb_xcc_id() { return (unsigned)__builtin_amdgcn_s_getreg((3 << 11) | 20) & 0xFu; }
#define XB_SPIN(cond, bar) do { unsigned _sp = 0; while (cond) { __builtin_amdgcn_s_sleep(1); \
    if ((++_sp & 255u) == 0u) { if (xb_ld(&(bar)[XB_TMO])) break; if (_sp > XB_SPIN_CAP) { atomicAdd(&(bar)[XB_TMO], 1u); break; } } } } while (0)
struct XcdBarrier { unsigned* bar; unsigned x; volatile LAS unsigned* st; };
__device__ __forceinline__ XcdBarrier xcd_barrier_post(unsigned* bar, volatile LAS unsigned* st) {
    XcdBarrier b; b.bar = bar; b.x = xb_xcc_id(); b.st = st;
    if (threadIdx.x == 0) (void)xb_add(&bar[XB_XCNT(b.x)], 1u);
    return b;
}
__device__ __forceinline__ void xcd_barrier_complete(unsigned* bar, unsigned x, unsigned& nloc, unsigned& nx) {
    const unsigned G = gridDim.x * gridDim.y * gridDim.z;
    unsigned sum, cnt, mine, sp = 0u;
    for (;;) {
        sum = 0u; cnt = 0u; mine = 0u;
#pragma unroll
        for (unsigned j = 0; j < 16; ++j) { const unsigned c = xb_ld(&bar[XB_XCNT(j)]); sum += c; cnt += (c > 0u) ? 1u : 0u; mine = (j == x) ? c : mine; }
        if (sum == G) break;
        __builtin_amdgcn_s_sleep(1);
        if ((++sp & 255u) == 0u) { if (xb_ld(&bar[XB_TMO])) break; if (sp > XB_SPIN_CAP) { atomicAdd(&bar[XB_TMO], 1u); break; } }
    }
    nloc = mine > 0u ? mine : 1u; nx = cnt > 0u ? cnt : 1u;
}
__device__ __forceinline__ void xcd_barrier(const XcdBarrier& b) {
    asm volatile("s_waitcnt vmcnt(0)" ::: "memory");
    __syncthreads();
    if (threadIdx.x == 0) {
        unsigned* bar = b.bar;
        __builtin_amdgcn_s_waitcnt(0);
        unsigned nloc = b.st[0], nx = b.st[1];
        if (nloc == 0u) { xcd_barrier_complete(bar, b.x, nloc, nx); b.st[0] = nloc; b.st[1] = nx; }
        const unsigned old = xb_add(&bar[XB_XSUB(b.x)], 1u);
        const unsigned gen = old / nloc;
        if (old + 1u == (gen + 1u) * nloc) {
            __builtin_amdgcn_fence(__ATOMIC_RELEASE, "agent");
            asm volatile("s_waitcnt vmcnt(0)" ::: "memory");
            const unsigned og = xb_add(&bar[XB_TOP], 1u);
            const unsigned tg = og / nx;
            if (og + 1u == (tg + 1u) * nx) xb_add(&bar[XB_TOPGEN], 1u);
            else XB_SPIN(xb_ld(&bar[XB_TOPGEN]) == tg, bar);
            __builtin_amdgcn_fence(__ATOMIC_ACQUIRE, "agent");
            xb_add(&bar[XB_XGEN(b.x)], 1u);
            asm volatile("s_waitcnt vmcnt(0)" ::: "memory");
        } else {
            XB_SPIN(xb_ld(&bar[XB_XGEN(b.x)]) == gen, bar);
            __builtin_amdgcn_fence(__ATOMIC_ACQUIRE, "agent");
            asm volatile("s_waitcnt vmcnt(0)" ::: "memory");
        }
    }
    __syncthreads();
}

struct Args { const float* in[27]; float* out; unsigned char* ws; int ph_lo, ph_hi; };

struct TrDesc { const float* W; bf16* WT; int ldw, K, nblk, item, mode; };
__device__ __forceinline__ void tr_load(const TrDesc& d, f32x4 (&t)[8], int lane) {
    const int kb = d.item / d.nblk, nb = d.item % d.nblk, k0 = 64 * kb, n0 = 32 * nb;
#pragma unroll
    for (int i = 0; i < 8; ++i) t[i] = *(const f32x4*)(d.W + (size_t)(k0 + 8 * i + (lane >> 3)) * d.ldw + n0 + 4 * (lane & 7));
}
__device__ __forceinline__ void tr_store(const TrDesc& d, const f32x4 (&t)[8], LAS float* scr, int lane) {
    const int kb = d.item / d.nblk, nb = d.item % d.nblk, k0 = 64 * kb, n0 = 32 * nb;
#pragma unroll
    for (int i = 0; i < 8; ++i) { LAS float* p = scr + (8 * i + (lane >> 3)) * 33 + 4 * (lane & 7); p[0] = t[i].x; p[1] = t[i].y; p[2] = t[i].z; p[3] = t[i].w; }
    asm volatile("s_waitcnt lgkmcnt(0)" ::: "memory");
    const int c = lane & 7;
#pragma unroll
    for (int j = 0; j < 4; ++j) { const int n = (lane >> 3) + 8 * j; const LAS float* s = scr + (8 * c) * 33 + n;
        u32x4 o; o.x = pk2(s[0 * 33], s[1 * 33]); o.y = pk2(s[2 * 33], s[3 * 33]); o.z = pk2(s[4 * 33], s[5 * 33]); o.w = pk2(s[6 * 33], s[7 * 33]);
        const int nn = n0 + n, row = d.mode == 0 ? nn : (nn >> 7) * 256 + (d.mode - 1) * 128 + (nn & 127);
        *(u32x4*)(d.WT + (size_t)row * d.K + k0 + 8 * c) = o; }
    asm volatile("s_waitcnt lgkmcnt(0)" ::: "memory");
}
__device__ __forceinline__ int win_src_off(int g) {
    switch (g) { case 0: return 0; case 1: return 1024; case 2: return 2048; case 3: return 4096; case 4: return 5120; case 5: return 7176; case 6: return 8200; case 7: return 3072; default: return 6144; }
}

__device__ __forceinline__ void p0_prologue(const Args& a, LAS unsigned char* lds) {
    const int tid = threadIdx.x, lane = tid & 63, wave = tid >> 6;
    unsigned char* ws = a.ws;
    const int gw = blockIdx.x * 8 + wave, NGW = gridDim.x * 8;
    {
        LAS float* scr = (LAS float*)(lds + 32768 + wave * 8704);
        constexpr int NA = 12 * 512, NBt = 130 * 128, NC = 65 * 128, NTOT = NA + NBt + NC;
        auto decode = [&](int it) -> TrDesc { TrDesc d;
            if (it < NA) { const int job = it / 512; d.item = it % 512; d.ldw = job < 9 ? INW : 1024; d.K = 1024; d.nblk = 32; d.mode = 0;
                if (job < 9) { d.W = a.in[4] + win_src_off(job); d.WT = (bf16*)(ws + WS_WINT) + (size_t)job * 1024 * 1024; }
                else { d.W = a.in[12 + (job - 9)]; d.WT = (bf16*)(ws + (job == 9 ? WS_WAT : job == 10 ? WS_WBT : WS_WOT)); } }
            else if (it < NA + NBt) { const int r = it - NA, job = r / 128; d.item = r % 128; d.ldw = 256; d.K = 1024; d.nblk = 8;
                if (job < 128) { const int e = job & 63, up = job >> 6; d.mode = 1 + up; d.W = a.in[19 + up] + (size_t)e * 1024 * 256; d.WT = (bf16*)(ws + WS_WGU) + (size_t)e * 512 * 1024; }
                else { const int up = job - 128; d.mode = 1 + up; d.W = a.in[22 + up]; d.WT = (bf16*)(ws + WS_WSGU); } }
            else { const int r = it - NA - NBt, job = r / 128; d.item = r % 128; d.ldw = 1024; d.K = 256; d.nblk = 32; d.mode = 0;
                if (job < 64) { d.W = a.in[21] + (size_t)job * 256 * 1024; d.WT = (bf16*)(ws + WS_WD) + (size_t)job * 1024 * 256; }
                else { d.W = a.in[24]; d.WT = (bf16*)(ws + WS_WSD); } }
            return d; };
        if (gw < NTOT) {
            TrDesc d0 = decode(gw); f32x4 t0[8]; tr_load(d0, t0, lane);
            for (int it = gw; it < NTOT; it += NGW) {
                TrDesc d1 = d0; f32x4 t1[8]; const bool more = it + NGW < NTOT;
                if (more) { d1 = decode(it + NGW); tr_load(d1, t1, lane); }
                tr_store(d0, t0, scr, lane);
                if (more) { d0 = d1;
#pragma unroll
                    for (int i = 0; i < 8; ++i) t0[i] = t1[i]; }
            }
        }
    }
    __syncthreads();
    LAS float* Wg8 = (LAS float*)lds;
    for (int i = tid; i < 1024 * 8; i += 512) Wg8[i] = a.in[4][(size_t)(i >> 3) * INW + 7168 + (i & 7)];
    __syncthreads();
    {
        const float* x = a.in[0]; const f32x4* gp = (const f32x4*)a.in[2] + lane; const f32x4* bp = (const f32x4*)a.in[3] + lane;
        f32x4 g[4], b[4];
#pragma unroll
        for (int j = 0; j < 4; ++j) { g[j] = gp[64 * j]; b[j] = bp[64 * j]; }
        bf16* h0 = (bf16*)(ws + WS_H0); float* lnst = (float*)(ws + WS_LNST0); float* igfg = (float*)(ws + WS_IGFG);
        f32x4 vn[4];
        if (gw < T) { const f32x4* xr = (const f32x4*)(x + (size_t)gw * D) + lane;
#pragma unroll
            for (int j = 0; j < 4; ++j) vn[j] = xr[64 * j]; }
        for (int m = gw; m < T; m += NGW) {
            f32x4 v[4]; float s = 0.f;
#pragma unroll
            for (int j = 0; j < 4; ++j) { v[j] = vn[j]; s += (v[j].x + v[j].y) + (v[j].z + v[j].w); }
            if (m + NGW < T) { const f32x4* xr = (const f32x4*)(x + (size_t)(m + NGW) * D) + lane;
#pragma unroll
                for (int j = 0; j < 4; ++j) vn[j] = xr[64 * j]; }
            const float mean = wave_sum(s) * (1.f / D); float s2 = 0.f;
#pragma unroll
            for (int j = 0; j < 4; ++j) { v[j] = v[j] - mean; s2 += (v[j].x * v[j].x + v[j].y * v[j].y) + (v[j].z * v[j].z + v[j].w * v[j].w); }
            const float rstd = 1.f / sqrtf(wave_sum(s2) * (1.f / D) + EPS);
            float acc[8];
#pragma unroll
            for (int c = 0; c < 8; ++c) acc[c] = 0.f;
            unsigned long long* o8 = (unsigned long long*)(h0 + (size_t)m * D) + lane;
#pragma unroll
            for (int j = 0; j < 4; ++j) {
                f32x4 h = v[j] * rstd * g[j] + b[j];
                o8[64 * j] = (unsigned long long)pk2(h.x, h.y) | ((unsigned long long)pk2(h.z, h.w) << 32);
#pragma unroll
                for (int i = 0; i < 4; ++i) { const int k = 4 * lane + i + 256 * j; const f32x4 w0 = *(const LAS f32x4*)(Wg8 + k * 8), w1 = *(const LAS f32x4*)(Wg8 + k * 8 + 4);
                    const float hv = h[i];
                    acc[0] += hv * w0.x; acc[1] += hv * w0.y; acc[2] += hv * w0.z; acc[3] += hv * w0.w; acc[4] += hv * w1.x; acc[5] += hv * w1.y; acc[6] += hv * w1.z; acc[7] += hv * w1.w; }
            }
            float r4[4], r2[2], r1;
            { const bool up = lane & 1;
#pragma unroll
              for (int c = 0; c < 4; ++c) { const float send = up ? acc[c] : acc[4 + c], keep = up ? acc[4 + c] : acc[c]; r4[c] = keep + __shfl_xor(send, 1); } }
            { const bool up = lane & 2;
#pragma unroll
              for (int c = 0; c < 2; ++c) { const float send = up ? r4[c] : r4[2 + c], keep = up ? r4[2 + c] : r4[c]; r2[c] = keep + __shfl_xor(send, 2); } }
            { const bool up = lane & 4; const float send = up ? r2[0] : r2[1], keep = up ? r2[1] : r2[0]; r1 = keep + __shfl_xor(send, 4); }
            r1 += __shfl_xor(r1, 8); r1 += __shfl_xor(r1, 16); r1 += __shfl_xor(r1, 32);
            if (lane < 8) igfg[(size_t)m * 8 + 4 * (lane & 1) + 2 * ((lane >> 1) & 1) + ((lane >> 2) & 1)] = r1;
            if (lane == 0) { lnst[2 * m] = mean; lnst[2 * m + 1] = rstd; }
        }
    }
    __syncthreads();
    for (int cgp = blockIdx.x; cgp < 81; cgp += gridDim.x) {
        LAS float* hm = (LAS float*)(lds + 32768);
        LAS float* part = (LAS float*)(lds + 32768 + 65536);
        __syncthreads();
        for (int r = wave * 2; r < wave * 2 + 2; ++r) {
            const f32x4* xr = (const f32x4*)(a.in[1] + (size_t)r * D) + lane; const f32x4* gp = (const f32x4*)a.in[2] + lane; const f32x4* bp = (const f32x4*)a.in[3] + lane;
            f32x4 v[4]; float s = 0.f;
#pragma unroll
            for (int j = 0; j < 4; ++j) { v[j] = xr[64 * j]; s += (v[j].x + v[j].y) + (v[j].z + v[j].w); }
            const float mean = wave_sum(s) * (1.f / D); float s2 = 0.f;
#pragma unroll
            for (int j = 0; j < 4; ++j) { v[j] = v[j] - mean; s2 += (v[j].x * v[j].x + v[j].y * v[j].y) + (v[j].z * v[j].z + v[j].w * v[j].w); }
            const float rstd = 1.f / sqrtf(wave_sum(s2) * (1.f / D) + EPS);
#pragma unroll
            for (int j = 0; j < 4; ++j) { const f32x4 h = v[j] * rstd * gp[64 * j] + bp[64 * j]; *(LAS f32x4*)(hm + r * 1024 + 4 * (lane + 64 * j)) = h; }
        }
        __syncthreads();
        const int c = cgp * 64 + lane;
        const int cc = c < 5128 ? c : 5127, g = cc >> 10, srccol = (cc < 5120) ? win_src_off(g) + (cc & 1023) : 7168 + (cc - 5120);
        float acc[16];
#pragma unroll
        for (int r = 0; r < 16; ++r) acc[r] = 0.f;
        const float* wp = a.in[4] + (size_t)(wave * 128) * INW + srccol;
#pragma unroll 4
        for (int k = 0; k < 128; ++k) { const float w = wp[(size_t)k * INW];
#pragma unroll
            for (int r = 0; r < 16; ++r) acc[r] += hm[r * 1024 + wave * 128 + k] * w; }
#pragma unroll
        for (int r = 0; r < 16; ++r) part[(wave * 16 + r) * 64 + lane] = acc[r];
        __syncthreads();
        if (c < 5128) {
            float* meta = (float*)(ws + WS_META);
            for (int r = wave * 2; r < wave * 2 + 2; ++r) { float v = 0.f;
#pragma unroll
                for (int w8 = 0; w8 < 8; ++w8) v += part[(w8 * 16 + r) * 64 + lane];
                if (c < 5120) { const int c1 = c & 1023;
                    if (g == 1) { const float lb = 1.0f / (1.0f + expf(a.in[5][1024 + c1] - a.in[5][c1])); v = logf(lb + (1.0f - lb) * sigmoidf_(v)); }
                    meta[(size_t)g * 16384 + r * 1024 + c1] = v; }
                else meta[5 * 16384 + r * 8 + (c - 5120)] = v; }
        }
    }
    for (int it = blockIdx.x * 512 + tid; it < 64 * 128; it += gridDim.x * 512) { const int e = it >> 7, k0 = (it & 127) * 8; float hi[8], lo[8];
#pragma unroll
        for (int j = 0; j < 8; ++j) { const float wv = a.in[17][(size_t)(k0 + j) * 64 + e]; const float h = bf2f(f2bf(wv)); hi[j] = h; lo[j] = wv - h; }
        store8_bf16((bf16*)(ws + WS_WRT) + (size_t)e * 1024 + k0, hi); store8_bf16((bf16*)(ws + WS_WRT) + 65536 + (size_t)e * 1024 + k0, lo); }
    {
        int* ts = (int*)(ws + WS_TOKSLOT); float* wsl = (float*)(ws + WS_WSLOT);
        for (int i = blockIdx.x * 512 + tid; i < 2 * NSLOTMAX; i += gridDim.x * 512) { ts[i] = 0; wsl[i] = 0.f; }
        int* ident = (int*)(ws + WS_IDENT);
        for (int i = blockIdx.x * 512 + tid; i < T; i += gridDim.x * 512) ident[i] = i;
    }
}

__device__ __forceinline__ void store8_bf16(bf16* p, const float (&v)[8]) { u32x4 w; w.x = pk2(v[0], v[1]); w.y = pk2(v[2], v[3]); w.z = pk2(v[4], v[5]); w.w = pk2(v[6], v[7]); *(u32x4*)p = w; }
__device__ __forceinline__ void load8_bf16(const bf16* p, float (&v)[8]) { const u32x4 w = *(const u32x4*)p;
    v[0] = bf2f(w.x & 0xffffu); v[1] = bf2f(w.x >> 16); v[2] = bf2f(w.y & 0xffffu); v[3] = bf2f(w.y >> 16); v[4] = bf2f(w.z & 0xffffu); v[5] = bf2f(w.z >> 16); v[6] = bf2f(w.w & 0xffffu); v[7] = bf2f(w.w >> 16); }

struct NoData {};
template <int K> struct KindTag { static constexpr int value = K; };
template <class T, class = void> struct epigroup { static constexpr int value = 4; };
template <class T> struct epigroup<T, typename std::enable_if<(T::GROUP > 0)>::type> { static constexpr int value = T::GROUP; };
template <class T, class = void> struct pairbj : std::false_type {};
template <class T> struct pairbj<T, typename std::enable_if<T::PAIRBJ>::type> : std::true_type {};
__device__ __forceinline__ void unpack8(const u32x4 w, float (&v)[8]) { v[0] = bf2f(w.x & 0xffffu); v[1] = bf2f(w.x >> 16); v[2] = bf2f(w.y & 0xffffu); v[3] = bf2f(w.y >> 16); v[4] = bf2f(w.z & 0xffffu); v[5] = bf2f(w.z >> 16); v[6] = bf2f(w.w & 0xffffu); v[7] = bf2f(w.w >> 16); }
struct EpiA {
    static constexpr bool PIPE = false; static constexpr int NKIND = 4;
    unsigned char* ws; unsigned char* dout; const float* lbl;
    struct Cl { float lb[8]; bf16* base; }; typedef NoData Ld;
    __device__ __forceinline__ int kind(int col0) const { const int g = col0 >> 10; return g == 1 ? 1 : g >= 5 ? 2 : g == 3 ? 3 : 0; }
    template <int K> __device__ __forceinline__ void colload(int col0, Cl& cl) const { const int g = col0 >> 10, c = col0 & 1023;
        if (K == 1) {
#pragma unroll
            for (int j = 0; j < 8; ++j) cl.lb[j] = __builtin_amdgcn_rcpf(1.0f + __expf(lbl[1024 + c + j] - lbl[c + j]));
            cl.base = (bf16*)(ws + WS_LFA) + c; }
        else if (K == 2) cl.base = (bf16*)dout + (size_t)(g - 5) * T * D + c;
        else if (K == 3) cl.base = (bf16*)(ws + WS_QKB) + c;
        else cl.base = (bf16*)(ws + (g == 0 ? WS_QA : g == 2 ? WS_IA : WS_VB)) + c; }
    template <int K> __device__ __forceinline__ void load(int, int, Ld&) const {}
    template <int K> __device__ __forceinline__ void apply(int row, int col0, int m, const float (&v)[8], const Ld&, const Cl& cl) const {
        if (K == 1) { float o[8];
#pragma unroll
            for (int j = 0; j < 8; ++j) o[j] = __logf(cl.lb[j] + (1.0f - cl.lb[j]) * sigmoidf_(v[j]));
            u32x4 w; w.x = f2h(o[0]) | (f2h(o[1]) << 16); w.y = f2h(o[2]) | (f2h(o[3]) << 16); w.z = f2h(o[4]) | (f2h(o[5]) << 16); w.w = f2h(o[6]) | (f2h(o[7]) << 16);
            *(u32x4*)(cl.base + (size_t)row * D) = w; }
        else if (K == 2) { float o[8];
#pragma unroll
            for (int j = 0; j < 8; ++j) o[j] = sigmoidf_(v[j]);
            store8_bf16(cl.base + (size_t)row * D, o); }
        else { store8_bf16(cl.base + (size_t)row * D, v);
            if (K == 3 && m == 3) { if ((row & 63) >= 61) store8_bf16((bf16*)(ws + WS_HALO) + ((size_t)(row >> 6) * 3 + ((row & 63) - 61)) * D + (col0 & 1023), v); } }
    }
};
struct EpiB {
    static constexpr bool PIPE = false; static constexpr int NKIND = 2; static constexpr int GROUP = 2;
    unsigned char* ws; const float* hg_g; const float* ml_g;
    struct Cl { float gn[8]; }; struct Ld { u32x4 x; float mean, rstd; };
    __device__ __forceinline__ int kind(int col0) const { return col0 >> 10; }
    template <int K> __device__ __forceinline__ void colload(int col0, Cl& cl) const { const int c = col0 & 1023; const float* gp = (K == 0 ? hg_g : ml_g) + c;
#pragma unroll
        for (int j = 0; j < 8; ++j) cl.gn[j] = gp[j]; }
    template <int K> __device__ __forceinline__ void load(int row, int col0, Ld& ld) const { const int c = col0 & 1023;
        if (K == 0) { ld.x = *(const u32x4*)((const bf16*)(ws + WS_IA) + (size_t)row * D + c); ld.mean = 0.f;
            const f32x2_t p = *(const f32x2_t*)((const float*)(ws + WS_STA2) + (size_t)row * 16 + (c >> 7) * 2); ld.rstd = __builtin_amdgcn_rsqf((p.x + p.y) * (1.f / 128.f) + EPS); }
        else { ld.x = *(const u32x4*)((const bf16*)(ws + WS_VB) + (size_t)row * D + c); const f32x4* st = (const f32x4*)((const float*)(ws + WS_STB2) + ((size_t)row * 16 + (c >> 8) * 4) * 2);
            const f32x4 a0 = st[0], a1 = st[1]; const float s1 = (a0.x + a0.z) + (a1.x + a1.z), s2 = (a0.y + a0.w) + (a1.y + a1.w);
            ld.mean = s1 * (1.f / 256.f); ld.rstd = __builtin_amdgcn_rsqf(fmaxf(s2 * (1.f / 256.f) - ld.mean * ld.mean, 0.f) + EPS); } }
    template <int K> __device__ __forceinline__ void apply(int row, int col0, int, const float (&v)[8], const Ld& ld, const Cl& cl) const {
        const int c = col0 & 1023; float x[8], o[8]; unpack8(ld.x, x);
        if (K == 0) {
#pragma unroll
            for (int j = 0; j < 8; ++j) o[j] = x[j] * ld.rstd * cl.gn[j] * siluf_(v[j]);
            store8_bf16((bf16*)(ws + WS_LFA) + (size_t)row * D + c, o);
        } else {
#pragma unroll
            for (int j = 0; j < 8; ++j) o[j] = (x[j] - ld.mean) * ld.rstd * cl.gn[j] * sigmoidf_(v[j]);
            store8_bf16((bf16*)(ws + WS_QKB) + (size_t)row * D + c, o);
        }
    }
};
struct EpiC {
    static constexpr bool PIPE = true; static constexpr int NKIND = 1;
    unsigned char* ws; const bf16* sga; const bf16* sgb;
    typedef NoData Cl; struct Ld { u32x4 a, b; };
    __device__ __forceinline__ int kind(int) const { return 0; }
    template <int K> __device__ __forceinline__ void colload(int, Cl&) const {}
    __device__ __forceinline__ void midload(int row, int col0, Ld& ld) const { ld.a = *(const u32x4*)(sga + (size_t)row * D + col0); ld.b = *(const u32x4*)(sgb + (size_t)row * D + col0); }
    __device__ __forceinline__ void mid(float (&v)[8], const Ld& ld) const { float sa[8], sb[8]; unpack8(ld.a, sa); unpack8(ld.b, sb);
#pragma unroll
        for (int j = 0; j < 8; ++j) v[j] *= sa[j] * __builtin_amdgcn_rcpf(sb[j]); }
    template <int K> __device__ __forceinline__ void load(int row, int col0, Ld& ld) const { ld.b = *(const u32x4*)(sgb + (size_t)row * D + col0); }
    template <int K> __device__ __forceinline__ void apply(int row, int col0, int, const float (&v)[8], const Ld& ld, const Cl&) const { float sb[8], o[8]; unpack8(ld.b, sb);
#pragma unroll
        for (int j = 0; j < 8; ++j) o[j] = sb[j] * v[j];
        store8_bf16((bf16*)(ws + WS_IA) + (size_t)row * D + col0, o); }
};
struct EpiD {
    static constexpr bool PIPE = false; static constexpr int NKIND = 1;
    unsigned char* ws; float* dout; const float* x; const float* g; const float* b;
    struct Cl { float g[8], b[8]; }; struct Ld { f32x4 x0, x1; float mean, rstd; };
    __device__ __forceinline__ int kind(int) const { return 0; }
    template <int K> __device__ __forceinline__ void colload(int col0, Cl& cl) const {
#pragma unroll
        for (int j = 0; j < 8; ++j) { cl.g[j] = g[col0 + j]; cl.b[j] = b[col0 + j]; } }
    template <int K> __device__ __forceinline__ void load(int row, int col0, Ld& ld) const { const float* st = (const float*)(ws + WS_LNST0) + 2 * (size_t)row; ld.mean = st[0]; ld.rstd = st[1];
        ld.x0 = *(const f32x4*)(x + (size_t)row * D + col0); ld.x1 = *(const f32x4*)(x + (size_t)row * D + col0 + 4); }
    template <int K> __device__ __forceinline__ void apply(int row, int col0, int, const float (&v)[8], const Ld& ld, const Cl& cl) const { float o[8];
#pragma unroll
        for (int j = 0; j < 4; ++j) { o[j] = DN_ALPHA * ((ld.x0[j] - ld.mean) * ld.rstd * cl.g[j] + cl.b[j]) + v[j]; o[4 + j] = DN_ALPHA * ((ld.x1[j] - ld.mean) * ld.rstd * cl.g[4 + j] + cl.b[4 + j]) + v[4 + j]; }
        store8_bf16((bf16*)(ws + WS_Z) + (size_t)row * D + col0, o); }
};
struct EpiGU {
    static constexpr bool PIPE = false; static constexpr int NKIND = 1; static constexpr bool PAIRBJ = true;
    bf16* H;
    typedef NoData Cl; typedef NoData Ld;
    __device__ __forceinline__ int kind(int) const { return 0; }
    __device__ __forceinline__ void apply_pair(int row, int col0, const float (&g)[8], const float (&u)[8]) const {
        float o[8];
#pragma unroll
        for (int j = 0; j < 8; ++j) o[j] = siluf_(g[j]) * u[j];
        store8_bf16(H + (size_t)row * DEXP + (col0 >> 8) * 128 + (col0 & 127), o); }
};
struct EpiDown {
    static constexpr bool PIPE = true; static constexpr int NKIND = 1;
    unsigned char* Y; const float* w;
    typedef NoData Cl; struct Ld { float s; };
    __device__ __forceinline__ int kind(int) const { return 0; }
    template <int K> __device__ __forceinline__ void colload(int, Cl&) const {}
    template <int K> __device__ __forceinline__ void load(int row, int, Ld& ld) const { ld.s = w[row]; }
    template <int K> __device__ __forceinline__ void apply(int row, int col0, int, const float (&v)[8], const Ld& ld, const Cl&) const { float o[8]; const float s = ld.s * 32.0f;
#pragma unroll
        for (int j = 0; j < 8; ++j) o[j] = fminf(fmaxf(s * v[j], -448.f), 448.f);
        int w0 = __builtin_amdgcn_cvt_pk_fp8_f32(o[0], o[1], 0, false); w0 = __builtin_amdgcn_cvt_pk_fp8_f32(o[2], o[3], w0, true);
        int w1 = __builtin_amdgcn_cvt_pk_fp8_f32(o[4], o[5], 0, false); w1 = __builtin_amdgcn_cvt_pk_fp8_f32(o[6], o[7], w1, true);
        *(u32x2*)(Y + (size_t)row * D + col0) = (u32x2){(unsigned)w0, (unsigned)w1}; }
};
struct EpiSD2 {
    static constexpr bool PIPE = false; static constexpr int NKIND = 1;
    unsigned char* ws; float* dout; const float* g; const float* b; int tokbase;
    struct Cl { float g[8], b[8]; }; struct Ld { u32x4 z; float mean, rstd; };
    __device__ __forceinline__ int kind(int) const { return 0; }
    template <int K> __device__ __forceinline__ void colload(int col0, Cl& cl) const {
#pragma unroll
        for (int j = 0; j < 8; ++j) { cl.g[j] = g[col0 + j]; cl.b[j] = b[col0 + j]; } }
    template <int K> __device__ __forceinline__ void load(int row, int col0, Ld& ld) const { const int tok = tokbase + row - NSLOTMAX; const float* st = (const float*)(ws + WS_LNST1) + 2 * (size_t)tok; ld.mean = st[0]; ld.rstd = st[1];
        ld.z = *(const u32x4*)((const bf16*)(ws + WS_Z) + (size_t)tok * D + col0); }
    template <int K> __device__ __forceinline__ void apply(int row, int col0, int, const float (&v)[8], const Ld& ld, const Cl& cl) const { const int tok = tokbase + row - NSLOTMAX; float z[8], o[8]; unpack8(ld.z, z);
#pragma unroll
        for (int j = 0; j < 8; ++j) o[j] = DN_ALPHA * ((z[j] - ld.mean) * ld.rstd * cl.g[j] + cl.b[j]) + v[j];
        store8_bf16((bf16*)(ws + WS_H0) + (size_t)tok * D + col0, o); }
};

namespace pg8 {
typedef short bf16x8 __attribute__((ext_vector_type(8)));
constexpr int BM = 256, BK = 64, HALF = 128, HTB = HALF * BK * 2, STAGE_BYTES = 8 * HTB, NXCD = 8, WGM = 8;
__device__ __forceinline__ int lds_byte(int r, int c) { const int st = (r >> 4) * 2 + (c >> 5), rr = r & 15, cc = c & 31, ob = rr * 64 + cc * 2; return st * 1024 + (ob ^ (((ob >> 9) & 1) << 5)); }
__device__ __forceinline__ void stage_rc(int b, int& R, int& C) { const int st = b / 1024, sb = b % 1024, swz = sb ^ (((sb >> 9) & 1) << 5); R = (st >> 1) * 16 + swz / 64; C = (st & 1) * 32 + (swz % 64) / 2; }
__device__ __forceinline__ int perm32(int rho) { const int n = rho >> 4, i = rho & 15; return 8 * (i >> 2) + 4 * n + (i & 3); }
struct Unit { int row0, col0; const char* A; const char* B; const int* idx; int mode; };
__device__ __forceinline__ int xcd_remap(int L, int nwg) { const int q = nwg / NXCD, r = nwg % NXCD, xcd = L % NXCD, off = L / NXCD; return (xcd < r ? xcd * (q + 1) : r * (q + 1) + (xcd - r) * q) + off; }
struct DenseOrder {
    int nM, nN, nwg, G, c, K; const char* A; const char* Bt;
    __device__ __forceinline__ void init(const bf16* A_, const bf16* Bt_, int M, int N, int K_) { A = (const char*)A_; Bt = (const char*)Bt_; K = K_; nM = M / BM; nN = N / BM; nwg = nM * nN; G = gridDim.x; c = blockIdx.x; }
    __device__ __forceinline__ bool next(int i, Unit& u) const {
        const long L = (long)i * G + c; if (L >= nwg) return false;
        const int wgid = xcd_remap((int)L, nwg);
        const int nig = WGM * nN, gid = wgid / nig, fm = gid * WGM, gsz = (nM - fm) < WGM ? (nM - fm) : WGM;
        const int pm = fm + ((wgid % nig) % gsz), pn = (wgid % nig) / gsz;
        u.row0 = pm * BM; u.col0 = pn * BM; u.A = A + (size_t)pm * BM * K * 2; u.B = Bt + (size_t)pn * BM * K * 2; u.idx = nullptr; u.mode = 0; return true;
    }
};
struct PairedOrder {
    DenseOrder d; const char* A2; const char* B2;
    __device__ __forceinline__ bool next(int i, Unit& u) const {
        if (!d.next(i >> 1, u)) return false;
        if (i & 1) { u.A = A2 + (size_t)u.row0 * d.K * 2; u.B = B2 + (size_t)u.col0 * d.K * 2; u.mode = 2; } else u.mode = 1;
        return true;
    }
};
struct GroupedOrder {
    const LAS int* te; int nct, nrt, nwg1, nwg2, G, c, K; const char* A; const int* idx; const int* ident; const char* Bt; const char* Bsh; size_t estride; bool gather;
    __device__ __forceinline__ bool next(int i, Unit& u) const {
        const int n1 = c < nwg1 ? (nwg1 - c + G - 1) / G : 0;
        if (i < n1) { const int wgid = xcd_remap(i * G + c, nwg1), rt = wgid / nct, ct = wgid % nct, row0 = rt * BM; const int e = __builtin_amdgcn_readfirstlane(te[rt]); u.mode = 0; u.col0 = ct * BM;
            u.row0 = row0; u.A = gather ? A : A + (size_t)row0 * K * 2; u.idx = idx + row0; u.B = Bt + (size_t)e * estride + (size_t)ct * BM * K * 2; return true; }
        const int L2 = (i - n1) * G + c; if (L2 >= nwg2) return false;
        const int wgid = xcd_remap(L2, nwg2), rt = wgid / nct, ct = wgid % nct, row0 = NSLOTMAX + rt * BM; u.mode = 3; u.col0 = ct * BM;
        u.row0 = row0; u.A = gather ? A : A + (size_t)row0 * K * 2; u.idx = ident + rt * BM; u.B = Bsh + (size_t)ct * BM * K * 2; return true;
    }
};

template <bool GATHER, bool PAIRED, class Epi, class Sched, class Epi2>
__device__ __forceinline__ void gemm_phase2(LAS unsigned char* lds, const int K, const Sched& S, const Epi& E, const Epi2& E2) {
    const int tid = threadIdx.x, wid = __builtin_amdgcn_readfirstlane(tid >> 6), lane = tid & 63, wr = wid >> 2, wc = wid & 3, fr = lane & 15, fq = lane >> 4;
    const int nt = K / BK;
    unsigned voffA[2], voffB[2]; int stR[2], stC[2];
#pragma unroll
    for (int i = 0; i < 2; ++i) { int R, C; stage_rc(tid * 16 + i * 8192, R, C); const int Rb = (R & ~31) + perm32(R & 31);
        voffA[i] = (unsigned)(R * K + C) * 2u; voffB[i] = (unsigned)(Rb * K + C) * 2u; stR[i] = R; stC[i] = C; }
    const size_t kstep = (size_t)(BK * 2);
    const size_t hstep = (size_t)HALF * K * 2;
    const unsigned ldsw = (unsigned)wid * 1024u;
    const int aoff = lds_byte(wr * 64 + fr, fq * 8), boff = lds_byte(wc * 32 + fr, fq * 8);
    unsigned cvA[2][2], nvA[2][2];
#define PG8_SA(b, h) (((b) * 2 + (h)) * HTB)
#define PG8_SB(b, h) ((4 + (b) * 2 + (h)) * HTB)
#define PG8_STAGE(bufoff, gbase, voff) do { _Pragma("unroll") for (int _i = 0; _i < 2; ++_i) \
        __builtin_amdgcn_global_load_lds((const unsigned*)((const char*)(gbase) + (voff)[_i]), (LAS unsigned*)(lds + (bufoff) + ldsw + _i * 8192), 16, 0, 0); } while (0)
#define PG8_STAGE_A(bufoff, kbase, h, usenext) do { if constexpr (GATHER) { unsigned _o[2]; _o[0] = (usenext) ? nvA[h][0] : cvA[h][0]; _o[1] = (usenext) ? nvA[h][1] : cvA[h][1]; PG8_STAGE(bufoff, kbase, _o); } \
        else { PG8_STAGE(bufoff, (kbase) + (h) * hstep, voffA); } } while (0)
#define PG8_LOADIDX(dst, un) do { _Pragma("unroll") for (int _h = 0; _h < 2; ++_h) _Pragma("unroll") for (int _i = 0; _i < 2; ++_i) \
        dst[_h][_i] = ((unsigned)(un).idx[_h * HALF + stR[_i]] * (unsigned)K + (unsigned)stC[_i]) * 2u; } while (0)
#define PG8_LDA(dst, b, h) do { _Pragma("unroll") for (int m = 0; m < 4; ++m) _Pragma("unroll") for (int k = 0; k < 2; ++k) dst[m][k] = *(const LAS bf16x8*)(lds + PG8_SA(b, h) + aoff + m * 2048 + k * 1024); } while (0)
#define PG8_LDB(dst, b, h) do { _Pragma("unroll") for (int n = 0; n < 2; ++n) _Pragma("unroll") for (int k = 0; k < 2; ++k) dst[n][k] = *(const LAS bf16x8*)(lds + PG8_SB(b, h) + boff + n * 2048 + k * 1024); } while (0)
#define PG8_MMA(ai, bj, At, Bt) do { __builtin_amdgcn_s_setprio(1); _Pragma("unroll") for (int m = 0; m < 4; ++m) _Pragma("unroll") for (int n = 0; n < 2; ++n) _Pragma("unroll") for (int k = 0; k < 2; ++k) \
        acc[ai][bj][m][n] = __builtin_amdgcn_mfma_f32_16x16x32_bf16(Bt[n][k], At[m][k], acc[ai][bj][m][n], 0, 0, 0); __builtin_amdgcn_s_setprio(0); } while (0)
#define PG8_WAIT_V(n) asm volatile("s_waitcnt vmcnt(" #n ")" ::: "memory")
#define PG8_WAIT_L(n) asm volatile("s_waitcnt lgkmcnt(" #n ")" ::: "memory")
#define PG8_BAR __builtin_amdgcn_s_barrier()
#define PG8_SCHED __builtin_amdgcn_sched_barrier(0)
    Unit cur, nxt; int ui = 0; bool relax = false;
    if (!S.next(0, cur)) return;
    f32x4 acc[2][2][4][2];
#pragma unroll
    for (int a = 0; a < 2; ++a)
#pragma unroll
        for (int b = 0; b < 2; ++b)
#pragma unroll
            for (int m = 0; m < 4; ++m)
#pragma unroll
                for (int n = 0; n < 2; ++n) acc[a][b][m][n] = (f32x4){0.f, 0.f, 0.f, 0.f};
    bf16x8 At[4][2], B0[2][2], B1[2][2];
    const char* cA = cur.A; const char* cB = cur.B;
    if constexpr (GATHER) { PG8_LOADIDX(cvA, cur);
#pragma unroll
        for (int h = 0; h < 2; ++h) { nvA[h][0] = cvA[h][0]; nvA[h][1] = cvA[h][1]; } }
    PG8_STAGE(PG8_SB(0, 0), cB, voffB); PG8_STAGE(PG8_SB(0, 1), cB + hstep, voffB); PG8_STAGE_A(PG8_SA(0, 0), cA, 0, false); PG8_STAGE_A(PG8_SA(0, 1), cA, 1, false);
    if (wr == 1) PG8_BAR;
    PG8_WAIT_V(2); PG8_BAR;
    PG8_STAGE(PG8_SB(1, 0), cB + kstep, voffB); PG8_STAGE_A(PG8_SA(1, 0), cA + kstep, 0, false); PG8_STAGE(PG8_SB(1, 1), cB + hstep + kstep, voffB);
    PG8_WAIT_V(6); PG8_BAR;
    for (;;) {
        const bool has_next = S.next(ui + 1, nxt);
        const char* nA = has_next ? nxt.A : cA; const char* nB = has_next ? nxt.B : cB;
#pragma unroll 1
        for (int t = 0; t < nt; t += 2) {
            const bool last = (t == nt - 2);
            const char* a1 = cA + (size_t)(t + 1) * kstep;
            const char* a2 = last ? nA : cA + (size_t)(t + 2) * kstep; const char* b2 = last ? nB : cB + (size_t)(t + 2) * kstep;
            const char* a3 = a2 + kstep; const char* b3 = b2 + kstep;
            if constexpr (GATHER) { if (last && has_next) PG8_LOADIDX(nvA, nxt); }
            const bool rlx = relax && t == 0;
            PG8_LDB(B0, 0, 0); PG8_LDB(B1, 0, 1); PG8_SCHED; PG8_LDA(At, 0, 0); PG8_STAGE_A(PG8_SA(1, 1), a1, 1, false);
            if (rlx) PG8_WAIT_V(24); else PG8_WAIT_V(8);
            PG8_WAIT_L(0); PG8_BAR; PG8_MMA(0, 0, At, B0); PG8_MMA(0, 1, At, B1); PG8_BAR; PG8_SCHED;
            PG8_LDA(At, 0, 1); PG8_STAGE(PG8_SB(0, 0), b2, voffB); PG8_STAGE(PG8_SB(0, 1), b2 + hstep, voffB); PG8_STAGE_A(PG8_SA(0, 0), a2, 0, last);
            if (rlx) PG8_WAIT_V(24); else PG8_WAIT_V(8);
            PG8_WAIT_L(0); PG8_BAR; PG8_MMA(1, 0, At, B0); PG8_MMA(1, 1, At, B1); PG8_BAR; PG8_SCHED;
            PG8_LDB(B0, 1, 0); PG8_LDB(B1, 1, 1); PG8_SCHED; PG8_LDA(At, 1, 0); PG8_STAGE_A(PG8_SA(0, 1), a2, 1, last);
            PG8_WAIT_V(8); PG8_WAIT_L(0); PG8_BAR; PG8_MMA(0, 0, At, B0); PG8_MMA(0, 1, At, B1); PG8_BAR; PG8_SCHED;
            PG8_LDA(At, 1, 1); PG8_STAGE(PG8_SB(1, 0), b3, voffB); PG8_STAGE(PG8_SB(1, 1), b3 + hstep, voffB); PG8_STAGE_A(PG8_SA(1, 0), a3, 0, last);
            PG8_WAIT_V(8); PG8_WAIT_L(0); PG8_BAR; PG8_MMA(1, 0, At, B0); PG8_MMA(1, 1, At, B1); PG8_BAR; PG8_SCHED;
        }
        if (wr == 0) PG8_BAR;
        {
            const int erow = cur.row0 + wr * 64 + fr, ecol = cur.col0 + wc * 32 + 8 * fq;
#define PG8_V8(ai, bj, m) { acc[ai][bj][m][0][0], acc[ai][bj][m][0][1], acc[ai][bj][m][0][2], acc[ai][bj][m][0][3], acc[ai][bj][m][1][0], acc[ai][bj][m][1][1], acc[ai][bj][m][1][2], acc[ai][bj][m][1][3] }
            auto run = [&](const auto& EE, auto KT) {
                typedef typename std::remove_cv<typename std::remove_reference<decltype(EE)>::type>::type EP; constexpr int KIND = decltype(KT)::value;
                if constexpr (pairbj<EP>::value) {
#pragma unroll
                    for (int ai = 0; ai < 2; ++ai)
#pragma unroll
                        for (int m = 0; m < 4; ++m) { const float vg[8] = PG8_V8(ai, 0, m); const float vu[8] = PG8_V8(ai, 1, m); EE.apply_pair(erow + ai * HALF + m * 16, ecol, vg, vu); }
                } else if constexpr (EP::PIPE) {
                    typename EP::Cl cl[2]; EE.template colload<KIND>(ecol, cl[0]); EE.template colload<KIND>(ecol + HALF, cl[1]);
                    typename EP::Ld ld[2][4];
#pragma unroll
                    for (int m = 0; m < 4; ++m) EE.template load<KIND>(erow + m * 16, ecol, ld[0][m]);
#pragma unroll
                    for (int gi = 0; gi < 4; ++gi) { const int ai = gi >> 1, bj = gi & 1;
                        if (gi < 3) { const int ai2 = (gi + 1) >> 1, bj2 = (gi + 1) & 1;
#pragma unroll
                            for (int m = 0; m < 4; ++m) EE.template load<KIND>(erow + ai2 * HALF + m * 16, ecol + bj2 * HALF, ld[(gi + 1) & 1][m]); }
#pragma unroll
                        for (int m = 0; m < 4; ++m) { const float v[8] = PG8_V8(ai, bj, m); EE.template apply<KIND>(erow + ai * HALF + m * 16, ecol + bj * HALF, m, v, ld[gi & 1][m], cl[bj]); } }
                } else {
#pragma unroll
                    for (int bj = 0; bj < 2; ++bj) { typename EP::Cl cl; EE.template colload<KIND>(ecol + bj * HALF, cl);
#pragma unroll
                        for (int ai = 0; ai < 2; ++ai)
#pragma unroll
                            for (int mg = 0; mg < 4; mg += epigroup<EP>::value) { typename EP::Ld ld[4];
#pragma unroll
                                for (int m = mg; m < mg + epigroup<EP>::value; ++m) EE.template load<KIND>(erow + ai * HALF + m * 16, ecol + bj * HALF, ld[m]);
#pragma unroll
                                for (int m = mg; m < mg + epigroup<EP>::value; ++m) { const float v[8] = PG8_V8(ai, bj, m); EE.template apply<KIND>(erow + ai * HALF + m * 16, ecol + bj * HALF, m, v, ld[m], cl); } } }
                }
            };
            if (cur.mode == 3) run(E2, KindTag<0>{});
            else if (PAIRED && cur.mode == 1) {
                if constexpr (PAIRED) {
#pragma unroll
                for (int bj = 0; bj < 2; ++bj)
#pragma unroll
                    for (int ai = 0; ai < 2; ++ai) { typename Epi::Ld ld[4];
#pragma unroll
                        for (int m = 0; m < 4; ++m) E.midload(erow + ai * HALF + m * 16, ecol + bj * HALF, ld[m]);
#pragma unroll
                        for (int m = 0; m < 4; ++m) { float v[8] = PG8_V8(ai, bj, m); E.mid(v, ld[m]);
                            acc[ai][bj][m][0] = (f32x4){v[0], v[1], v[2], v[3]}; acc[ai][bj][m][1] = (f32x4){v[4], v[5], v[6], v[7]}; } }
                }
            } else if constexpr (Epi::NKIND == 1) run(E, KindTag<0>{});
            else { const int kd = __builtin_amdgcn_readfirstlane(E.kind(cur.col0));
                if (kd == 0) run(E, KindTag<0>{}); else if (kd == 1) run(E, KindTag<1>{});
                else if constexpr (Epi::NKIND > 2) { if (kd == 2) run(E, KindTag<2>{}); else run(E, KindTag<3>{}); } }
#undef PG8_V8
        }
        if (!has_next) break;
        relax = !(PAIRED && cur.mode == 1);
        if (!PAIRED || cur.mode != 1) {
#pragma unroll
        for (int a = 0; a < 2; ++a)
#pragma unroll
            for (int b = 0; b < 2; ++b)
#pragma unroll
                for (int m = 0; m < 4; ++m)
#pragma unroll
                    for (int n = 0; n < 2; ++n) acc[a][b][m][n] = (f32x4){0.f, 0.f, 0.f, 0.f};
        }
        cur = nxt; cA = nA; cB = nB; ++ui;
        if constexpr (GATHER) {
#pragma unroll
            for (int h = 0; h < 2; ++h) { cvA[h][0] = nvA[h][0]; cvA[h][1] = nvA[h][1]; } }
        if (wr == 1) PG8_BAR;
    }
    PG8_WAIT_V(0);
    PG8_BAR;
#undef PG8_SA
#undef PG8_SB
#undef PG8_STAGE
#undef PG8_STAGE_A
#undef PG8_LOADIDX
#undef PG8_LDA
#undef PG8_LDB
#undef PG8_MMA
#undef PG8_WAIT_V
#undef PG8_WAIT_L
#undef PG8_BAR
#undef PG8_SCHED
}
template <bool GATHER, bool PAIRED, class Epi, class Sched>
__device__ __forceinline__ void gemm_phase(LAS unsigned char* lds, const int K, const Sched& S, const Epi& E) { gemm_phase2<GATHER, PAIRED>(lds, K, S, E, E); }
}
template <class Epi>
__device__ __forceinline__ void fgemm_dense(LAS unsigned char* lds, const bf16* A, const bf16* Bt, int M, int N, int K, const Epi& epi) {
    pg8::DenseOrder S; S.init(A, Bt, M, N, K);
    pg8::gemm_phase<false, false>(lds, K, S, epi);
}
template <class Epi>
__device__ __forceinline__ void fgemm_paired(LAS unsigned char* lds, const bf16* A1, const bf16* B1, const bf16* A2, const bf16* B2, int M, int N, int K, const Epi& epi) {
    pg8::PairedOrder S; S.d.init(A1, B1, M, N, K); S.A2 = (const char*)A2; S.B2 = (const char*)B2;
    pg8::gemm_phase<false, true>(lds, K, S, epi);
}

__device__ __forceinline__ void scan_hgrn(const Args& a, LAS unsigned char* lds, int b, int h, bool meta_only) {
    unsigned char* ws = a.ws; const int tid = threadIdx.x, v = tid >> 2, kq = tid & 3;
    LAS float* qs = (LAS float*)lds; LAS float* fs = qs + 16 * 128;
    const float* meta = (const float*)(ws + WS_META);
    bf16* QA = (bf16*)(ws + WS_QA); const bf16* LFA = (const bf16*)(ws + WS_LFA); const bf16* IA = (const bf16*)(ws + WS_IA);
    float S[32];
#pragma unroll
    for (int j = 0; j < 32; ++j) S[j] = 0.f;
    for (int blk = -1; blk < SEQ / 16; ++blk) {
        __syncthreads();
        for (int i = tid; i < 16 * 128; i += 512) { const int s = i >> 7, k = i & 127;
            if (blk < 0) { qs[i] = meta[0 * 16384 + s * 1024 + h * 128 + k]; fs[i] = __expf(meta[1 * 16384 + s * 1024 + h * 128 + k]); }
            else { const size_t t = (size_t)b * SEQ + blk * 16 + s; qs[i] = bf2f(QA[t * D + h * 128 + k]); fs[i] = __expf(h2f(LFA[t * D + h * 128 + k])); } }
        __syncthreads();
        for (int s = 0; s < 16; ++s) {
            float vt; size_t t = 0;
            if (blk < 0) vt = meta[2 * 16384 + s * 1024 + h * 128 + v]; else { t = (size_t)b * SEQ + blk * 16 + s; vt = bf2f(IA[t * D + h * 128 + v]); }
            float o = 0.f;
#pragma unroll
            for (int j = 0; j < 32; ++j) { const float f = fs[s * 128 + kq * 32 + j], q = qs[s * 128 + kq * 32 + j]; S[j] = f * S[j] + (1.0f - f) * vt; o += S[j] * q; }
            o += __shfl_xor(o, 1); o += __shfl_xor(o, 2);
            if (blk >= 0 && kq == 0) QA[t * D + h * 128 + v] = (bf16)f2bf(o);
        }
        if (meta_only) { float* sm = (float*)(ws + WS_SMETA) + (size_t)h * 128 * 128;
#pragma unroll
            for (int j = 0; j < 32; ++j) sm[(kq * 32 + j) * 128 + v] = S[j];
            break; }
    }
}
__device__ __forceinline__ void scan_mlstm(const Args& a, LAS unsigned char* lds, int b, int h, bool meta_only) {
    unsigned char* ws = a.ws; const int tid = threadIdx.x, v = tid >> 1, kh = tid & 1;
    LAS float* qs = (LAS float*)lds; LAS float* ks = qs + 16 * 128; LAS float* raw = ks + 16 * 128; LAS float* sc = raw + 19 * 256;
    const float* meta = (const float*)(ws + WS_META); const float* igfg = (const float*)(ws + WS_IGFG);
    const bf16* QKB = (const bf16*)(ws + WS_QKB); bf16* VB = (bf16*)(ws + WS_VB);
    const float* cw = a.in[7]; const float* cb = a.in[8]; const float igb = a.in[9][h], fgb = a.in[10][h];
    float C[64], n[64];
#pragma unroll
    for (int j = 0; j < 64; ++j) { C[j] = 0.f; n[j] = 0.f; }
    float M = 0.f;
    for (int blk = -1; blk < SEQ / 16; ++blk) {
        __syncthreads();
        for (int i = tid; i < 19 * 256; i += 512) { const int r = i >> 8, c = i & 255; const int ch = (c < 128) ? h * 128 + c : 512 + h * 128 + (c - 128);
            float val;
            if (blk < 0) { const int mr = r - 3; val = mr >= 0 ? meta[3 * 16384 + mr * 1024 + ch] : 0.f; }
            else { const int tt = blk * 16 + r - 3; val = tt >= 0 ? bf2f(QKB[((size_t)b * SEQ + tt) * D + ch]) : meta[3 * 16384 + (16 + tt) * 1024 + ch]; }
            raw[i] = val; }
        if (tid < 16) { float ig, fg;
            if (blk < 0) { ig = meta[5 * 16384 + tid * 8 + h]; fg = meta[5 * 16384 + tid * 8 + 4 + h]; }
            else { const size_t t = (size_t)b * SEQ + blk * 16 + tid; ig = igfg[t * 8 + h]; fg = igfg[t * 8 + 4 + h]; }
            ig += igb; fg += fgb;
            sc[tid] = ig; sc[16 + tid] = fminf(fg, 0.f) - log1pf(__expf(-fabsf(fg))); }
        __syncthreads();
        for (int i = tid; i < 16 * 256; i += 512) { const int s = i >> 8, c = i & 255; const int ch = (c < 128) ? h * 128 + c : 512 + h * 128 + (c - 128);
            float y = cb[ch];
#pragma unroll
            for (int j = 0; j < 4; ++j) y += cw[j * 1024 + ch] * raw[(s + j) * 256 + c];
            y = siluf_(y);
            if (c < 128) qs[s * 128 + c] = y * 0.08838834764831845f; else ks[s * 128 + c - 128] = y; }
        __syncthreads();
        for (int s = 0; s < 16; ++s) {
            float vt; size_t t = 0;
            if (blk < 0) vt = meta[4 * 16384 + s * 1024 + h * 256 + v]; else { t = (size_t)b * SEQ + blk * 16 + s; vt = bf2f(VB[t * D + h * 256 + v]); }
            const float ig = sc[s], lf = sc[16 + s]; const float Mn = fmaxf(lf + M, ig), fd = __expf(lf + M - Mn), iw = __expf(ig - Mn); M = Mn;
            float num = 0.f, den = 0.f; const float iv = iw * vt;
#pragma unroll
            for (int j = 0; j < 64; ++j) { const float kv = ks[s * 128 + kh * 64 + j], q = qs[s * 128 + kh * 64 + j]; C[j] = fd * C[j] + iv * kv; n[j] = fd * n[j] + iw * kv; num += C[j] * q; den += n[j] * q; }
            num += __shfl_xor(num, 1); den += __shfl_xor(den, 1);
            const float hv = num / fmaxf(fabsf(den), __expf(-M));
            if (blk >= 0 && kh == 0) VB[t * D + h * 256 + v] = (bf16)f2bf(hv);
        }
        if (meta_only) { float* cm = (float*)(ws + WS_CMETA) + (size_t)h * 128 * 256; float* nm = (float*)(ws + WS_NMETA);
#pragma unroll
            for (int j = 0; j < 64; ++j) { cm[(kh * 64 + j) * 256 + v] = C[j]; if (v == 0) nm[h * 128 + kh * 64 + j] = n[j]; }
            if (tid == 0) nm[1024 + h] = M;
            break; }
    }
}

__device__ __forceinline__ void s0_hgrn_prep(const Args& a) {
    unsigned char* ws = a.ws;
    for (int it = blockIdx.x * 512 + threadIdx.x; it < 1024 * 128; it += gridDim.x * 512) {
        const int oct = it & 127, cg = it >> 7; const size_t base = (size_t)cg * 64 * D + oct * 8;
        bf16* Q = (bf16*)(ws + WS_QA) + base; bf16* L = (bf16*)(ws + WS_LFA) + base;
        float r[8], bc[8];
#pragma unroll
        for (int j = 0; j < 8; ++j) { r[j] = 0.f; bc[j] = 0.f; }
#pragma unroll 4
        for (int s = 0; s < 32; ++s) { const u32x4 w = *(const u32x4*)(L + (size_t)s * D);
#pragma unroll
            for (int i = 0; i < 4; ++i) { r[2 * i] += h2f(w[i] & 0xffffu); r[2 * i + 1] += h2f(w[i] >> 16); } }
#pragma unroll 2
        for (int s = 0; s < 64; ++s) { const u32x4 wl = *(const u32x4*)(L + (size_t)s * D), wq = *(const u32x4*)(Q + (size_t)s * D); float qt[8], kt[8];
#pragma unroll
            for (int i = 0; i < 4; ++i) {
#pragma unroll
                for (int hh = 0; hh < 2; ++hh) { const int j = 2 * i + hh; const float lf = h2f(hh ? (wl[i] >> 16) : (wl[i] & 0xffffu)), q = bf2f(hh ? (wq[i] >> 16) : (wq[i] & 0xffffu));
                    bc[j] += lf; qt[j] = q * __expf(fminf(bc[j] - r[j], 80.f)); kt[j] = -expm1f(lf) * __expf(fminf(r[j] - bc[j], 80.f)); } }
            store8_bf16(Q + (size_t)s * D, qt); store8_bf16(L + (size_t)s * D, kt); }
        float* em = (float*)(ws + WS_EM) + (size_t)cg * 1024 + oct * 8; float* el = (float*)(ws + WS_EL) + (size_t)cg * 1024 + oct * 8;
        *(f32x4*)em = (f32x4){__expf(r[0]), __expf(r[1]), __expf(r[2]), __expf(r[3])}; *(f32x4*)(em + 4) = (f32x4){__expf(r[4]), __expf(r[5]), __expf(r[6]), __expf(r[7])};
        *(f32x4*)el = (f32x4){__expf(bc[0] - r[0]), __expf(bc[1] - r[1]), __expf(bc[2] - r[2]), __expf(bc[3] - r[3])}; *(f32x4*)(el + 4) = (f32x4){__expf(bc[4] - r[4]), __expf(bc[5] - r[5]), __expf(bc[6] - r[6]), __expf(bc[7] - r[7])};
    }
}
__device__ __forceinline__ void s0_mlstm_conv(const Args& a) {
    unsigned char* ws = a.ws; const float* cw = a.in[7]; const float* cb = a.in[8]; const float* meta = (const float*)(ws + WS_META);
    for (int it = blockIdx.x * 512 + threadIdx.x; it < 1024 * 128; it += gridDim.x * 512) {
        const int oct = it & 127, cg = it >> 7, ch = oct * 8; bf16* X = (bf16*)(ws + WS_QKB) + (size_t)cg * 64 * D + ch;
        float w0[8], w1[8], w2[8], c0[8], c1[8], c2[8], c3[8], bb[8];
#pragma unroll
        for (int j = 0; j < 8; ++j) { c0[j] = cw[ch + j]; c1[j] = cw[1024 + ch + j]; c2[j] = cw[2048 + ch + j]; c3[j] = cw[3072 + ch + j]; bb[j] = cb[ch + j]; }
        if ((cg & 127) == 0) {
#pragma unroll
            for (int j = 0; j < 8; ++j) { w0[j] = meta[3 * 16384 + 13 * 1024 + ch + j]; w1[j] = meta[3 * 16384 + 14 * 1024 + ch + j]; w2[j] = meta[3 * 16384 + 15 * 1024 + ch + j]; }
        } else { const bf16* hp = (const bf16*)(ws + WS_HALO) + (size_t)(cg - 1) * 3 * D + ch; load8_bf16(hp, w0); load8_bf16(hp + D, w1); load8_bf16(hp + 2 * D, w2); }
        const bool isq = ch < 512; const int hh = (ch & 511) >> 7; const f32x4* gates = (const f32x4*)(ws + WS_GATES);
        const float scale = isq ? 0.08838834764831845f : 1.0f;
#pragma unroll 2
        for (int s = 0; s < 64; ++s) { float x[8], y[8]; load8_bf16(X + (size_t)s * D, x);
            const f32x4 gt = gates[((size_t)cg * 64 + s) * 4 + hh]; const float rs_ = scale * (isq ? gt.x : gt.y);
#pragma unroll
            for (int j = 0; j < 8; ++j) { const float t = bb[j] + c0[j] * w0[j] + c1[j] * w1[j] + c2[j] * w2[j] + c3[j] * x[j]; y[j] = siluf_(t) * rs_; w0[j] = w1[j]; w1[j] = w2[j]; w2[j] = x[j]; }
            store8_bf16(X + (size_t)s * D, y); }
    }
}
__device__ __forceinline__ float logsigmoidf_(float x) { return fminf(x, 0.f) - log1pf(__expf(-fabsf(x))); }
__device__ __forceinline__ void s0_mlstm_gates(const Args& a, LAS unsigned char* lds, int b, int h) {
    unsigned char* ws = a.ws; const int tid = threadIdx.x, lane = tid & 63, wave = tid >> 6; const float igb = a.in[9][h], fgb = a.in[10][h];
    const float* meta = (const float*)(ws + WS_META); const float* igfg = (const float*)(ws + WS_IGFG); f32x4* gates = (f32x4*)(ws + WS_GATES);
    LAS float* sum = (LAS float*)lds;
    LAS float* mc = sum + 256;
    float bcv[16], pmv[16], igv[16];
    __syncthreads();
#pragma unroll
    for (int i = 0; i < 16; ++i) {
        const int c = wave * 16 + i; const size_t t = (size_t)b * SEQ + c * 64 + lane;
        const float ig = igfg[t * 8 + h] + igb, lf = logsigmoidf_(igfg[t * 8 + 4 + h] + fgb);
        float bc = lf;
#pragma unroll
        for (int o = 1; o < 64; o <<= 1) { const float u = __shfl_up(bc, o); if (lane >= o) bc += u; }
        float pm = ig - bc;
#pragma unroll
        for (int o = 1; o < 64; o <<= 1) { const float u = __shfl_up(pm, o); if (lane >= o) pm = fmaxf(pm, u); }
        bcv[i] = bc; pmv[i] = pm; igv[i] = ig;
        if (lane == 63) { sum[2 * c] = bc; sum[2 * c + 1] = pm; }
    }
    __syncthreads();
    if (tid == 0) { float Mc = 0.f;
        for (int s = 0; s < 16; ++s) { const float ig = meta[5 * 16384 + s * 8 + h] + igb, lf = logsigmoidf_(meta[5 * 16384 + s * 8 + 4 + h] + fgb); Mc = fmaxf(lf + Mc, ig); }
        for (int c = 0; c < 128; ++c) { mc[c] = Mc; Mc = sum[2 * c] + fmaxf(Mc, sum[2 * c + 1]); } }
    __syncthreads();
#pragma unroll
    for (int i = 0; i < 16; ++i) { const int c = wave * 16 + i; const size_t t = (size_t)b * SEQ + c * 64 + lane;
        const float Mt = bcv[i] + fmaxf(mc[c], pmv[i]), bL = __shfl(bcv[i], 63), ML = __shfl(Mt, 63);
        gates[t * 4 + h] = (f32x4){__expf(bcv[i] - Mt - bL + ML), __expf(igv[i] - bcv[i] + bL - ML), __expf(-Mt), __expf(bL + mc[c] - ML)}; }
    __syncthreads();
}
__device__ __forceinline__ void s0_prepass(const Args& a, LAS unsigned char* lds) {
    s0_hgrn_prep(a);
    s0_mlstm_conv(a);
    for (int u = blockIdx.x; u < 12; u += gridDim.x) {
        if (u < 8) scan_hgrn(a, lds, 0, u, true);
        else scan_mlstm(a, lds, 0, u - 8, true); }
}

typedef short v4i16_t __attribute__((ext_vector_type(4)));
typedef short bf16x8_t __attribute__((ext_vector_type(8)));
__device__ __forceinline__ v4i16_t tr16(LAS unsigned char* p) { return __builtin_amdgcn_ds_read_tr16_b64_v4i16((LAS v4i16_t*)p); }
__device__ __forceinline__ bf16x8_t cat44(v4i16_t a, v4i16_t b) { return (bf16x8_t){a[0], a[1], a[2], a[3], b[0], b[1], b[2], b[3]}; }
__device__ __forceinline__ bf16x8_t pack8(f32x4 a, f32x4 b) { const u32x4 w = {pk2(a.x, a.y), pk2(a.z, a.w), pk2(b.x, b.y), pk2(b.z, b.w)}; return __builtin_bit_cast(bf16x8_t, w); }
__device__ __forceinline__ bf16x8_t cat22(u32x2 a, u32x2 b) { const u32x4 w = {a.x, a.y, b.x, b.y}; return __builtin_bit_cast(bf16x8_t, w); }
constexpr int SC_QT = 0, SC_KT = 17408, SC_VT = 34816, SC_PT = 44032, SC_EM = 53248, SC_EL = 53760, SC_QS = 272, SC_VS = 144;

constexpr int S3_SET = 45056, S3_P = 90112, S3_ST = 99328;
__device__ __forceinline__ void fscan3_hgrn(const Args& a, LAS unsigned char* lds, int b, int h, int vh) {
    unsigned char* ws = a.ws; const int tid = threadIdx.x, lane = tid & 63, w = tid >> 6, fr = lane & 15, g = lane >> 4, q4 = fr >> 2, p4 = fr & 3;
    const bf16* QA = (const bf16*)(ws + WS_QA); const bf16* KA = (const bf16*)(ws + WS_LFA); bf16* IA = (bf16*)(ws + WS_IA);
    const float* EMg = (const float*)(ws + WS_EM); const float* ELg = (const float*)(ws + WS_EL);
    const int vt = w & 3, th = w >> 2, tt = w & 3, sh = w >> 2;
    f32x4 S[8];
    { const float* sm = (const float*)(ws + WS_SMETA) + (size_t)h * 128 * 128 + vh * 64 + vt * 16 + fr;
#pragma unroll
      for (int kt = 0; kt < 8; ++kt)
#pragma unroll
          for (int r = 0; r < 4; ++r) S[kt][r] = sm[(16 * kt + 4 * g + r) * 128]; }
    const int r0 = tid >> 4, c0 = tid & 15, rv = tid >> 3, cv = tid & 7;
    u32x4 pq0, pq1, pk0, pk1, pv; f32x4 pe;
#define HG_FETCH(c) do { const size_t t0 = (size_t)b * SEQ + (size_t)(c) * 64; \
        pq0 = *(const u32x4*)(QA + (t0 + r0) * D + h * 128 + c0 * 8); pq1 = *(const u32x4*)(QA + (t0 + r0 + 32) * D + h * 128 + c0 * 8); \
        pk0 = *(const u32x4*)(KA + (t0 + r0) * D + h * 128 + c0 * 8); pk1 = *(const u32x4*)(KA + (t0 + r0 + 32) * D + h * 128 + c0 * 8); \
        pv = *(const u32x4*)(IA + (t0 + rv) * D + h * 128 + vh * 64 + cv * 8); \
        if (tid < 64) { const size_t cgi = ((size_t)b * 128 + (c)) * 1024 + h * 128; pe = *(const f32x4*)((tid < 32 ? EMg : ELg) + cgi + (tid & 31) * 4); } } while (0)
#define HG_COMMIT(sb) do { LAS unsigned char* B_ = lds + (sb); *(LAS u32x4*)(B_ + r0 * SC_QS + c0 * 16) = pq0; *(LAS u32x4*)(B_ + (r0 + 32) * SC_QS + c0 * 16) = pq1; \
        *(LAS u32x4*)(B_ + 17408 + r0 * SC_QS + c0 * 16) = pk0; *(LAS u32x4*)(B_ + 17408 + (r0 + 32) * SC_QS + c0 * 16) = pk1; \
        *(LAS u32x4*)(B_ + 34816 + rv * SC_VS + cv * 16) = pv; \
        if (tid < 64) *(LAS f32x4*)(B_ + (tid < 32 ? 44032 : 44544) + (tid & 31) * 16) = pe; } while (0)
    __syncthreads();
    HG_FETCH(0); HG_COMMIT(0);
    __syncthreads();
    for (int c = 0; c < SEQ / 64; ++c) {
        const int sb = (c & 1) * S3_SET;
        LAS unsigned char* Q_ = lds + sb; LAS unsigned char* K_ = Q_ + 17408; LAS unsigned char* V_ = Q_ + 34816; LAS unsigned char* P_ = lds + S3_P;
        if (c + 1 < SEQ / 64) HG_FETCH(c + 1);
        {
            bf16x8_t bq[4];
#pragma unroll
            for (int ks = 0; ks < 4; ++ks) bq[ks] = *(const LAS bf16x8_t*)(Q_ + (tt * 16 + fr) * SC_QS + ks * 64 + g * 16);
#pragma unroll
            for (int si = 0; si < 2; ++si) { const int st = 2 * sh + si; f32x4 acc = {0.f, 0.f, 0.f, 0.f};
#pragma unroll
                for (int ks = 0; ks < 4; ++ks) { const bf16x8_t ak = *(const LAS bf16x8_t*)(K_ + (st * 16 + fr) * SC_QS + ks * 64 + g * 16); acc = __builtin_amdgcn_mfma_f32_16x16x32_bf16(ak, bq[ks], acc, 0, 0, 0); }
                const int t = tt * 16 + fr, s0 = st * 16 + 4 * g; u32x2 pw;
                pw.x = pk2(s0 + 0 <= t ? acc[0] : 0.f, s0 + 1 <= t ? acc[1] : 0.f); pw.y = pk2(s0 + 2 <= t ? acc[2] : 0.f, s0 + 3 <= t ? acc[3] : 0.f);
                *(LAS u32x2*)(P_ + t * SC_VS + s0 * 2) = pw; }
        }
        __syncthreads();
        {
            bf16x8_t afr[4], vfr[2];
#pragma unroll
            for (int kt = 0; kt < 8; ++kt) S[kt] = S[kt] * *(const LAS f32x4*)(Q_ + 44032 + (16 * kt + 4 * g) * 4);
#pragma unroll
            for (int ks = 0; ks < 4; ++ks) afr[ks] = pack8(S[2 * ks], S[2 * ks + 1]);
#pragma unroll
            for (int k2 = 0; k2 < 2; ++k2) { LAS unsigned char* pa = V_ + (32 * k2 + 8 * g + q4) * SC_VS + (vt * 16 + 4 * p4) * 2; vfr[k2] = cat44(tr16(pa), tr16(pa + 4 * SC_VS)); }
            const size_t t0 = (size_t)b * SEQ + (size_t)c * 64;
#pragma unroll
            for (int ti = 0; ti < 2; ++ti) { const int t = (2 * th + ti) * 16 + fr; f32x4 acc = {0.f, 0.f, 0.f, 0.f};
#pragma unroll
                for (int ks = 0; ks < 4; ++ks) { const u32x2 lo = *(const LAS u32x2*)(Q_ + t * SC_QS + (32 * ks + 4 * g) * 2), hi = *(const LAS u32x2*)(Q_ + t * SC_QS + (32 * ks + 16 + 4 * g) * 2);
                    acc = __builtin_amdgcn_mfma_f32_16x16x32_bf16(afr[ks], cat22(lo, hi), acc, 0, 0, 0); }
#pragma unroll
                for (int k2 = 0; k2 < 2; ++k2) { const bf16x8_t pf = *(const LAS bf16x8_t*)(P_ + t * SC_VS + (32 * k2 + 8 * g) * 2); acc = __builtin_amdgcn_mfma_f32_16x16x32_bf16(vfr[k2], pf, acc, 0, 0, 0); }
                u32x2 ow; ow.x = pk2(acc[0], acc[1]); ow.y = pk2(acc[2], acc[3]);
                *(u32x2*)(IA + (t0 + t) * D + h * 128 + vh * 64 + vt * 16 + 4 * g) = ow;
                float sq = (acc[0] * acc[0] + acc[1] * acc[1]) + (acc[2] * acc[2] + acc[3] * acc[3]); sq += __shfl_xor(sq, 16); sq += __shfl_xor(sq, 32);
                if (g == 0) *(LAS float*)(lds + S3_ST + (vt * 64 + t) * 4) = sq; }
#pragma unroll
            for (int kt = 0; kt < 8; ++kt) {
#pragma unroll
                for (int k2 = 0; k2 < 2; ++k2) { LAS unsigned char* pa = K_ + (32 * k2 + 8 * g + q4) * SC_QS + (16 * kt + 4 * p4) * 2; const bf16x8_t ak = cat44(tr16(pa), tr16(pa + 4 * SC_QS));
                    S[kt] = __builtin_amdgcn_mfma_f32_16x16x32_bf16(ak, vfr[k2], S[kt], 0, 0, 0); }
                S[kt] = S[kt] * *(const LAS f32x4*)(Q_ + 44544 + (16 * kt + 4 * g) * 4); }
        }
        if (c + 1 < SEQ / 64) HG_COMMIT(S3_SET - sb);
        __syncthreads();
        if (tid < 64) { const LAS float* sp = (const LAS float*)(lds + S3_ST) + tid;
            ((float*)(ws + WS_STA2))[((size_t)b * SEQ + (size_t)c * 64 + tid) * 16 + h * 2 + vh] = (sp[0] + sp[64]) + (sp[128] + sp[192]); }
    }
#undef HG_FETCH
#undef HG_COMMIT
}
__device__ __forceinline__ void fscan3_mlstm(const Args& a, LAS unsigned char* lds, int b, int h, int vq) {
    unsigned char* ws = a.ws; const int tid = threadIdx.x, lane = tid & 63, w = tid >> 6, fr = lane & 15, g = lane >> 4, q4 = fr >> 2, p4 = fr & 3;
    const bf16* QK = (const bf16*)(ws + WS_QKB); bf16* VB = (bf16*)(ws + WS_VB); const f32x4* GT = (const f32x4*)(ws + WS_GATES);
    const int vt = w & 3, th = w >> 2, tt = w & 3, sh = w >> 2;
    f32x4 S[8], N[8];
    { const float* cm = (const float*)(ws + WS_CMETA) + (size_t)h * 128 * 256 + vq * 64 + vt * 16 + fr; const float* nm = (const float*)(ws + WS_NMETA) + h * 128;
#pragma unroll
      for (int kt = 0; kt < 8; ++kt)
#pragma unroll
          for (int r = 0; r < 4; ++r) { S[kt][r] = cm[(16 * kt + 4 * g + r) * 256]; N[kt][r] = nm[16 * kt + 4 * g + r]; } }
    const u32x4 onew = {0x3F803F80u, 0x3F803F80u, 0x3F803F80u, 0x3F803F80u}; const bf16x8_t ones = __builtin_bit_cast(bf16x8_t, onew);
    const int r0 = tid >> 4, c0 = tid & 15, rv = tid >> 3, cv = tid & 7;
    u32x4 pq0, pq1, pk0, pk1, pv; f32x4 pe;
#define ML_FETCH(c) do { const size_t t0 = (size_t)b * SEQ + (size_t)(c) * 64; \
        pq0 = *(const u32x4*)(QK + (t0 + r0) * D + h * 128 + c0 * 8); pq1 = *(const u32x4*)(QK + (t0 + r0 + 32) * D + h * 128 + c0 * 8); \
        pk0 = *(const u32x4*)(QK + (t0 + r0) * D + 512 + h * 128 + c0 * 8); pk1 = *(const u32x4*)(QK + (t0 + r0 + 32) * D + 512 + h * 128 + c0 * 8); \
        pv = *(const u32x4*)(VB + (t0 + rv) * D + h * 256 + vq * 64 + cv * 8); \
        if (tid < 64) pe = GT[(t0 + tid) * 4 + h]; } while (0)
#define ML_COMMIT(sb) do { LAS unsigned char* B_ = lds + (sb); *(LAS u32x4*)(B_ + r0 * SC_QS + c0 * 16) = pq0; *(LAS u32x4*)(B_ + (r0 + 32) * SC_QS + c0 * 16) = pq1; \
        *(LAS u32x4*)(B_ + 17408 + r0 * SC_QS + c0 * 16) = pk0; *(LAS u32x4*)(B_ + 17408 + (r0 + 32) * SC_QS + c0 * 16) = pk1; \
        *(LAS u32x4*)(B_ + 34816 + rv * SC_VS + cv * 16) = pv; \
        if (tid < 64) *(LAS f32x4*)(B_ + 44032 + tid * 16) = pe; } while (0)
    __syncthreads();
    ML_FETCH(0); ML_COMMIT(0);
    __syncthreads();
    for (int c = 0; c < SEQ / 64; ++c) {
        const int sb = (c & 1) * S3_SET;
        LAS unsigned char* Q_ = lds + sb; LAS unsigned char* K_ = Q_ + 17408; LAS unsigned char* V_ = Q_ + 34816; LAS unsigned char* G_ = Q_ + 44032; LAS unsigned char* P_ = lds + S3_P;
        if (c + 1 < SEQ / 64) ML_FETCH(c + 1);
        const float decay = (*(const LAS f32x4*)G_).w;
        {
            bf16x8_t bq[4];
#pragma unroll
            for (int ks = 0; ks < 4; ++ks) bq[ks] = *(const LAS bf16x8_t*)(Q_ + (tt * 16 + fr) * SC_QS + ks * 64 + g * 16);
#pragma unroll
            for (int si = 0; si < 2; ++si) { const int st = 2 * sh + si; f32x4 acc = {0.f, 0.f, 0.f, 0.f};
#pragma unroll
                for (int ks = 0; ks < 4; ++ks) { const bf16x8_t ak = *(const LAS bf16x8_t*)(K_ + (st * 16 + fr) * SC_QS + ks * 64 + g * 16); acc = __builtin_amdgcn_mfma_f32_16x16x32_bf16(ak, bq[ks], acc, 0, 0, 0); }
                const int t = tt * 16 + fr, s0 = st * 16 + 4 * g; u32x2 pw;
                pw.x = pk2(s0 + 0 <= t ? acc[0] : 0.f, s0 + 1 <= t ? acc[1] : 0.f); pw.y = pk2(s0 + 2 <= t ? acc[2] : 0.f, s0 + 3 <= t ? acc[3] : 0.f);
                *(LAS u32x2*)(P_ + t * SC_VS + s0 * 2) = pw; }
        }
        __syncthreads();
        {
            bf16x8_t vfr[2];
#pragma unroll
            for (int kt = 0; kt < 8; ++kt) { S[kt] = S[kt] * decay; N[kt] = N[kt] * decay; }
#pragma unroll
            for (int k2 = 0; k2 < 2; ++k2) { LAS unsigned char* pa = V_ + (32 * k2 + 8 * g + q4) * SC_VS + (vt * 16 + 4 * p4) * 2; vfr[k2] = cat44(tr16(pa), tr16(pa + 4 * SC_VS)); }
            const size_t t0 = (size_t)b * SEQ + (size_t)c * 64;
#pragma unroll 1
            for (int ti = 0; ti < 2; ++ti) { const int t = (2 * th + ti) * 16 + fr; f32x4 acc = {0.f, 0.f, 0.f, 0.f}, accd = {0.f, 0.f, 0.f, 0.f};
#pragma unroll
                for (int ks = 0; ks < 4; ++ks) { const bf16x8_t af = pack8(S[2 * ks], S[2 * ks + 1]), an = pack8(N[2 * ks], N[2 * ks + 1]);
                    const u32x2 lo = *(const LAS u32x2*)(Q_ + t * SC_QS + (32 * ks + 4 * g) * 2), hi = *(const LAS u32x2*)(Q_ + t * SC_QS + (32 * ks + 16 + 4 * g) * 2); const bf16x8_t qf = cat22(lo, hi);
                    acc = __builtin_amdgcn_mfma_f32_16x16x32_bf16(af, qf, acc, 0, 0, 0); accd = __builtin_amdgcn_mfma_f32_16x16x32_bf16(an, qf, accd, 0, 0, 0); }
#pragma unroll
                for (int k2 = 0; k2 < 2; ++k2) { const bf16x8_t pf = *(const LAS bf16x8_t*)(P_ + t * SC_VS + (32 * k2 + 8 * g) * 2);
                    acc = __builtin_amdgcn_mfma_f32_16x16x32_bf16(vfr[k2], pf, acc, 0, 0, 0); accd = __builtin_amdgcn_mfma_f32_16x16x32_bf16(ones, pf, accd, 0, 0, 0); }
                const float inv = __builtin_amdgcn_rcpf(fmaxf(fabsf(accd[0]), (*(const LAS f32x4*)(G_ + t * 16)).z));
                const float h0_ = acc[0] * inv, h1_ = acc[1] * inv, h2_ = acc[2] * inv, h3_ = acc[3] * inv;
                u32x2 ow; ow.x = pk2(h0_, h1_); ow.y = pk2(h2_, h3_);
                *(u32x2*)(VB + (t0 + t) * D + h * 256 + vq * 64 + vt * 16 + 4 * g) = ow;
                float s1 = (h0_ + h1_) + (h2_ + h3_), s2 = (h0_ * h0_ + h1_ * h1_) + (h2_ * h2_ + h3_ * h3_);
                s1 += __shfl_xor(s1, 16); s1 += __shfl_xor(s1, 32); s2 += __shfl_xor(s2, 16); s2 += __shfl_xor(s2, 32);
                if (g == 0) { *(LAS float*)(lds + S3_ST + (vt * 64 + t) * 4) = s1; *(LAS float*)(lds + S3_ST + 1024 + (vt * 64 + t) * 4) = s2; } }
#pragma unroll
            for (int kt = 0; kt < 8; ++kt) {
#pragma unroll
                for (int k2 = 0; k2 < 2; ++k2) { LAS unsigned char* pa = K_ + (32 * k2 + 8 * g + q4) * SC_QS + (16 * kt + 4 * p4) * 2; const bf16x8_t ak = cat44(tr16(pa), tr16(pa + 4 * SC_QS));
                    S[kt] = __builtin_amdgcn_mfma_f32_16x16x32_bf16(ak, vfr[k2], S[kt], 0, 0, 0); N[kt] = __builtin_amdgcn_mfma_f32_16x16x32_bf16(ak, ones, N[kt], 0, 0, 0); } }
        }
        if (c + 1 < SEQ / 64) ML_COMMIT(S3_SET - sb);
        __syncthreads();
        if (tid < 128) { const int tk = tid & 63, wh = tid >> 6; const LAS float* sp = (const LAS float*)(lds + S3_ST + wh * 1024) + tk;
            ((float*)(ws + WS_STB2))[(((size_t)b * SEQ + (size_t)c * 64 + tk) * 16 + h * 4 + vq) * 2 + wh] = (sp[0] + sp[64]) + (sp[128] + sp[192]); }
    }
#undef ML_FETCH
#undef ML_COMMIT
}

__device__ __forceinline__ void p_ln1_route(const Args& a, LAS unsigned char* lds) {
    unsigned char* ws = a.ws; const int tid = threadIdx.x, lane = tid & 63, wave = tid >> 6, fr = lane & 15, g = lane >> 4;
    LAS int* hist = (LAS int*)lds; LAS float* rbs = (LAS float*)(lds + 256);
    LAS unsigned char* hw = lds + 1024 + wave * 17408;
    LAS float* st = (LAS float*)(lds + 1024 + 8 * 17408 + wave * 256);
    const bf16* z = (const bf16*)(ws + WS_Z); const bf16* WT = (const bf16*)(ws + WS_WRT);
    bf16* h1 = (bf16*)(ws + WS_H0); float* lnst = (float*)(ws + WS_LNST1);
    int* eidx = (int*)(ws + WS_EIDX); float* gwp = (float*)(ws + WS_GW); int* lpos = (int*)(ws + WS_LPOS); int* wgbase = (int*)(ws + WS_WGBASE);
    unsigned* gcnt = (unsigned*)(ws + WS_CTL) + CW_GCNT;
    for (int tile = blockIdx.x; tile < T / 256; tile += gridDim.x) {
        const int half = tile / (T / 512), m0 = tile * 256 + wave * 32;
        __syncthreads();
        if (tid < 64) { hist[tid] = 0; rbs[tid] = a.in[18][tid]; }
        __syncthreads();
        {
            const f32x4* gp = (const f32x4*)a.in[15] + lane; const f32x4* bp = (const f32x4*)a.in[16] + lane;
            f32x4 gg[4], bb[4]; u32x2 zn[4];
#pragma unroll
            for (int j = 0; j < 4; ++j) { gg[j] = gp[64 * j]; bb[j] = bp[64 * j]; zn[j] = ((const u32x2*)(z + (size_t)m0 * D) + lane)[64 * j]; }
            for (int rr = 0; rr < 32; ++rr) {
                const int m = m0 + rr; f32x4 v[4]; float s = 0.f;
#pragma unroll
                for (int j = 0; j < 4; ++j) { const u32x2 zw = zn[j]; v[j] = (f32x4){bf2f(zw.x & 0xffffu), bf2f(zw.x >> 16), bf2f(zw.y & 0xffffu), bf2f(zw.y >> 16)}; s += (v[j].x + v[j].y) + (v[j].z + v[j].w); }
                if (rr + 1 < 32) {
#pragma unroll
                    for (int j = 0; j < 4; ++j) zn[j] = ((const u32x2*)(z + (size_t)(m + 1) * D) + lane)[64 * j]; }
                const float mean = wave_sum(s) * (1.f / D); float s2 = 0.f;
#pragma unroll
                for (int j = 0; j < 4; ++j) { v[j] = v[j] - mean; s2 += (v[j].x * v[j].x + v[j].y * v[j].y) + (v[j].z * v[j].z + v[j].w * v[j].w); }
                const float rstd = 1.f / sqrtf(wave_sum(s2) * (1.f / D) + EPS);
                unsigned long long* o8 = (unsigned long long*)(h1 + (size_t)m * D) + lane;
#pragma unroll
                for (int j = 0; j < 4; ++j) { const f32x4 h = v[j] * rstd * gg[j] + bb[j]; o8[64 * j] = (unsigned long long)pk2(h.x, h.y) | ((unsigned long long)pk2(h.z, h.w) << 32); }
                if (lane == 0) { lnst[2 * m] = mean; lnst[2 * m + 1] = rstd; st[2 * rr] = mean; st[2 * rr + 1] = rstd; }
            }
        }
        asm volatile("s_waitcnt lgkmcnt(0)" ::: "memory");
        f32x4 acc[2][4];
#pragma unroll
        for (int mt = 0; mt < 2; ++mt)
#pragma unroll
            for (int n = 0; n < 4; ++n) acc[mt][n] = (f32x4){0.f, 0.f, 0.f, 0.f};
        for (int kc = 0; kc < 8; ++kc) {
            { const int kk = (lane & 31) * 4; const f32x4 g4 = *(const f32x4*)(a.in[15] + kc * 128 + kk), b4 = *(const f32x4*)(a.in[16] + kc * 128 + kk);
#pragma unroll 4
              for (int i = 0; i < 16; ++i) { const int row = 2 * i + (lane >> 5); const u32x2 zw = *(const u32x2*)(z + (size_t)(m0 + row) * D + kc * 128 + kk);
                  const f32x4 z4 = {bf2f(zw.x & 0xffffu), bf2f(zw.x >> 16), bf2f(zw.y & 0xffffu), bf2f(zw.y >> 16)};
                  const float mean = st[2 * row], rstd = st[2 * row + 1]; const f32x4 h = (z4 - mean) * rstd * g4 + b4;
                  u32x2 hi; hi.x = pk2(h.x, h.y); hi.y = pk2(h.z, h.w);
                  const f32x4 hr = {bf2f(hi.x & 0xffffu), bf2f(hi.x >> 16), bf2f(hi.y & 0xffffu), bf2f(hi.y >> 16)}; const f32x4 l4 = h - hr;
                  u32x2 lo; lo.x = pk2(l4.x, l4.y); lo.y = pk2(l4.z, l4.w);
                  *(LAS u32x2*)(hw + row * 272 + kk * 2) = hi; *(LAS u32x2*)(hw + 8704 + row * 272 + kk * 2) = lo; } }
            asm volatile("s_waitcnt lgkmcnt(0)" ::: "memory");
#pragma unroll
            for (int ks = 0; ks < 4; ++ks) {
                bf16x8_t ah[2], al[2];
#pragma unroll
                for (int mt = 0; mt < 2; ++mt) { ah[mt] = *(const LAS bf16x8_t*)(hw + (16 * mt + fr) * 272 + ks * 64 + g * 16); al[mt] = *(const LAS bf16x8_t*)(hw + 8704 + (16 * mt + fr) * 272 + ks * 64 + g * 16); }
#pragma unroll
                for (int n = 0; n < 4; ++n) { const bf16* wp = WT + (size_t)(16 * n + fr) * 1024 + kc * 128 + ks * 32 + g * 8;
                    const bf16x8_t bh = *(const bf16x8_t*)wp, bl = *(const bf16x8_t*)(wp + 65536);
#pragma unroll
                    for (int mt = 0; mt < 2; ++mt) { acc[mt][n] = __builtin_amdgcn_mfma_f32_16x16x32_bf16(ah[mt], bh, acc[mt][n], 0, 0, 0);
                        acc[mt][n] = __builtin_amdgcn_mfma_f32_16x16x32_bf16(al[mt], bh, acc[mt][n], 0, 0, 0); acc[mt][n] = __builtin_amdgcn_mfma_f32_16x16x32_bf16(ah[mt], bl, acc[mt][n], 0, 0, 0); } }
            }
            asm volatile("s_waitcnt lgkmcnt(0)" ::: "memory");
        }
        { LAS float* lg = (LAS float*)hw;
#pragma unroll
          for (int mt = 0; mt < 2; ++mt)
#pragma unroll
              for (int n = 0; n < 4; ++n)
#pragma unroll
                  for (int r = 0; r < 4; ++r) lg[(16 * mt + 4 * g + r) * 65 + 16 * n + fr] = acc[mt][n][r]; }
        asm volatile("s_waitcnt lgkmcnt(0)" ::: "memory");
        if (lane < 32) {
            const LAS float* lg = (const LAS float*)hw + lane * 65; const int m = m0 + lane;
            float bsc[64];
#pragma unroll
            for (int e2 = 0; e2 < 64; ++e2) bsc[e2] = 1.0f / (1.0f + expf(-lg[e2])) + rbs[e2];
            float gs[8];
#pragma unroll
            for (int gi = 0; gi < 8; ++gi) { float m1 = -INFINITY, m2 = -INFINITY;
#pragma unroll
                for (int j = 0; j < 8; ++j) { const float v = bsc[8 * gi + j]; m2 = fmaxf(m2, fminf(m1, v)); m1 = fmaxf(m1, v); }
                gs[gi] = m1 + m2; }
            unsigned selmask = 0;
#pragma unroll
            for (int gi = 0; gi < 8; ++gi) { int rank = 0;
#pragma unroll
                for (int gj = 0; gj < 8; ++gj) rank += (gs[gj] > gs[gi] || (gs[gj] == gs[gi] && gj < gi)) ? 1 : 0;
                selmask |= (rank < 4) ? (1u << gi) : 0u; }
            float tv[8]; int te[8];
#pragma unroll
            for (int i = 0; i < 8; ++i) { tv[i] = -INFINITY; te[i] = 0; }
#pragma unroll
            for (int e2 = 0; e2 < 64; ++e2) { float v = ((selmask >> (e2 >> 3)) & 1u) ? bsc[e2] : -INFINITY; int id = e2;
#pragma unroll
                for (int i = 0; i < 8; ++i) { const bool sw = v > tv[i]; const float tvv = tv[i]; const int tee = te[i]; tv[i] = sw ? v : tvv; te[i] = sw ? id : tee; v = sw ? tvv : v; id = sw ? tee : id; } }
            float sc[8], ssum = 0.f;
#pragma unroll
            for (int i = 0; i < 8; ++i) { sc[i] = tv[i] - rbs[te[i]]; ssum += sc[i]; }
            const float scale = ROUTED_SCALE / ssum;
#pragma unroll
            for (int i = 0; i < 8; ++i) { eidx[(size_t)m * 8 + i] = te[i]; gwp[(size_t)m * 8 + i] = sc[i] * scale; lpos[(size_t)m * 8 + i] = atomicAdd((int*)&hist[te[i]], 1); }
        }
        __syncthreads();
        if (tid < 64) wgbase[tile * 64 + tid] = (int)atomicAdd(&gcnt[half * 64 + tid], (unsigned)hist[tid]);
    }
}
__device__ __forceinline__ void load_pstart(const Args& a, LAS int* ps) {
    const unsigned* gcnt = (const unsigned*)(a.ws + WS_CTL) + CW_GCNT;
    __syncthreads();
    if (threadIdx.x < 2) { const int hf = threadIdx.x; int acc = 0;
        for (int e = 0; e < 64; ++e) { ps[hf * 65 + e] = acc; const int c = (int)__hip_atomic_load(gcnt + hf * 64 + e, __ATOMIC_RELAXED, __HIP_MEMORY_SCOPE_AGENT); acc += (c + 255) / 256 * 256; }
        ps[hf * 65 + 64] = acc; }
    __syncthreads();
}
__device__ __forceinline__ void p_slots(const Args& a, LAS unsigned char* lds) {
    unsigned char* ws = a.ws; LAS int* ps = (LAS int*)lds; load_pstart(a, ps);
    const int* eidx = (const int*)(ws + WS_EIDX); const float* gwp = (const float*)(ws + WS_GW); const int* lpos = (const int*)(ws + WS_LPOS); const int* wgbase = (const int*)(ws + WS_WGBASE);
    int* slotof = (int*)(ws + WS_SLOTOF); int* tokslot = (int*)(ws + WS_TOKSLOT); float* wslot = (float*)(ws + WS_WSLOT);
    for (int tile = blockIdx.x; tile < T / 256; tile += gridDim.x) {
        const int half = tile / (T / 512);
        for (int i = threadIdx.x; i < 256 * 8; i += 512) { const size_t idx = (size_t)tile * 2048 + i; const int e = eidx[idx];
            const int slot = ps[half * 65 + e] + wgbase[tile * 64 + e] + lpos[idx];
            slotof[idx] = slot; tokslot[(size_t)half * NSLOTMAX + slot] = (int)(idx >> 3); wslot[(size_t)half * NSLOTMAX + slot] = gwp[idx]; }
    }
}
template <bool DOWN>
__device__ __forceinline__ void f_moe_gemm(const Args& a, LAS unsigned char* lds, int half) {
    unsigned char* ws = a.ws; LAS int* ps = (LAS int*)(lds + 131072); LAS int* te = (LAS int*)(lds + 131072 + 1024); load_pstart(a, ps);
    const int nrt = __builtin_amdgcn_readfirstlane(ps[half * 65 + 64] / 256);
    for (int rt = threadIdx.x; rt < nrt; rt += 512) { int e = 0; for (int j = 1; j < 64; ++j) if (ps[half * 65 + j] <= rt * 256) e = j; te[rt] = e; }
    __syncthreads();
    pg8::GroupedOrder S; S.te = te; S.nct = DOWN ? 4 : 2; S.nrt = nrt; S.nwg1 = nrt * S.nct; S.nwg2 = (HALF_T / 256) * S.nct; S.G = gridDim.x; S.c = blockIdx.x;
    S.idx = (const int*)(ws + WS_TOKSLOT) + (size_t)half * NSLOTMAX; S.ident = (const int*)(ws + WS_IDENT) + half * HALF_T;
    if (!DOWN) { S.K = 1024; S.A = (const char*)(ws + WS_H0); S.Bt = (const char*)(ws + WS_WGU); S.Bsh = (const char*)(ws + WS_WSGU); S.estride = (size_t)512 * 1024 * 2; S.gather = true;
        pg8::gemm_phase<true, false>(lds, 1024, S, EpiGU{(bf16*)(ws + WS_HH)}); }
    else { S.K = 256; S.A = (const char*)(ws + WS_HH); S.Bt = (const char*)(ws + WS_WD); S.Bsh = (const char*)(ws + WS_WSD); S.estride = (size_t)1024 * 256 * 2; S.gather = false;
        pg8::gemm_phase2<false, false>(lds, 256, S, EpiDown{(unsigned char*)(ws + WS_YH), (const float*)(ws + WS_WSLOT) + (size_t)half * NSLOTMAX}, EpiSD2{ws, a.out, a.in[15], a.in[16], half * HALF_T}); }
}
__device__ __forceinline__ void p_combine(const Args& a, int half) {
    unsigned char* ws = a.ws; const int lane = threadIdx.x & 63, gw = blockIdx.x * 8 + (threadIdx.x >> 6), NGW = gridDim.x * 8;
    const unsigned char* Y = (const unsigned char*)(ws + WS_YH); const int* slotof = (const int*)(ws + WS_SLOTOF);
    const f32x4* gp = (const f32x4*)a.in[25] + lane; const f32x4* bp = (const f32x4*)a.in[26] + lane;
    for (int mm = gw; mm < HALF_T; mm += NGW) {
        const int m = half * HALF_T + mm;
        f32x4* rr = (f32x4*)(a.out + (size_t)m * D) + lane; const u32x2* rb16 = (const u32x2*)((const bf16*)(ws + WS_H0) + (size_t)m * D) + lane;
        f32x4 v[4];
#pragma unroll
        for (int j = 0; j < 4; ++j) { const u32x2 rw = rb16[64 * j]; v[j] = (f32x4){bf2f(rw.x & 0xffffu), bf2f(rw.x >> 16), bf2f(rw.y & 0xffffu), bf2f(rw.y >> 16)}; }
        f32x4 ys[4];
#pragma unroll
        for (int j = 0; j < 4; ++j) ys[j] = (f32x4){0.f, 0.f, 0.f, 0.f};
        int sl[8];
#pragma unroll
        for (int k = 0; k < 8; ++k) sl[k] = slotof[(size_t)m * 8 + k];
#pragma unroll
        for (int k = 0; k < 8; ++k) { const unsigned* yr = (const unsigned*)(Y + (size_t)sl[k] * D) + lane;
#pragma unroll
            for (int j = 0; j < 4; ++j) { const int w = (int)yr[64 * j]; const f32x2_t lo = __builtin_amdgcn_cvt_pk_f32_fp8(w, false), hi = __builtin_amdgcn_cvt_pk_f32_fp8(w, true);
                ys[j].x += lo.x; ys[j].y += lo.y; ys[j].z += hi.x; ys[j].w += hi.y; } }
#pragma unroll
        for (int j = 0; j < 4; ++j) v[j] = v[j] + ys[j] * 0.03125f;
        float s = 0.f;
#pragma unroll
        for (int j = 0; j < 4; ++j) s += (v[j].x + v[j].y) + (v[j].z + v[j].w);
        const float mean = wave_sum(s) * (1.f / D); float s2 = 0.f;
#pragma unroll
        for (int j = 0; j < 4; ++j) { v[j] = v[j] - mean; s2 += (v[j].x * v[j].x + v[j].y * v[j].y) + (v[j].z * v[j].z + v[j].w * v[j].w); }
        const float rstd = 1.f / sqrtf(wave_sum(s2) * (1.f / D) + EPS);
#pragma unroll
        for (int j = 0; j < 4; ++j) rr[64 * j] = v[j] * rstd * gp[64 * j] + bp[64 * j];
    }
}

__global__ void __launch_bounds__(512, 2) fwd(Args a) {
    extern __shared__ __attribute__((aligned(16))) unsigned char lds_raw[];
    LAS unsigned char* lds = (LAS unsigned char*)lds_raw;
    unsigned char* ws = a.ws;
    const int lo = a.ph_lo, hi = a.ph_hi;
    volatile LAS unsigned* bst = (volatile LAS unsigned*)(lds + LDS_BYTES - 16);
    if (threadIdx.x == 0) { bst[0] = 0u; bst[1] = 0u; }
    __syncthreads();
    XcdBarrier bar = xcd_barrier_post((unsigned*)(ws + WS_CTL) + CW_BAR, bst);
#ifndef PH_MASK
#define PH_MASK 0xFFFFFFFFu
#endif
#define IN(k) ((((PH_MASK) >> (k)) & 1u) && lo <= (k) && (k) < hi)
#define SEAM(k) do { if (IN(k) && IN((k) + 1)) xcd_barrier(bar); } while (0)
    if (IN(0)) p0_prologue(a, lds);
    SEAM(0);
    if (IN(1)) { for (int u = blockIdx.x; u < 32; u += gridDim.x) s0_mlstm_gates(a, lds, u >> 2, u & 3); }
    if (IN(1)) fgemm_dense(lds, (const bf16*)(ws + WS_H0), (const bf16*)(ws + WS_WINT), T, 7168, 1024, EpiA{ws, (unsigned char*)a.out, a.in[5]});
    SEAM(1);
    if (IN(2)) s0_prepass(a, lds);
    SEAM(2);
    if (IN(3)) { for (int u = blockIdx.x; u < 256; u += gridDim.x) if (u < 128) fscan3_hgrn(a, lds, u >> 4, (u >> 1) & 7, u & 1); }
    asm volatile("" ::: "memory");
    if (IN(3)) { for (int u = blockIdx.x; u < 256; u += gridDim.x) if (u >= 128) fscan3_mlstm(a, lds, (u - 128) >> 4, ((u - 128) >> 2) & 3, (u - 128) & 3); }
    if (IN(3) && IN(5)) xcd_barrier(bar);
    if (IN(5)) fgemm_dense(lds, (const bf16*)(ws + WS_H0), (const bf16*)(ws + WS_WINT) + (size_t)7168 * 1024, T, 2048, 1024, EpiB{ws, a.in[6], a.in[11]});
    SEAM(5);
    if (IN(6)) fgemm_paired(lds, (const bf16*)(ws + WS_LFA), (const bf16*)(ws + WS_WAT), (const bf16*)(ws + WS_QKB), (const bf16*)(ws + WS_WBT), T, 1024, 1024, EpiC{ws, (const bf16*)a.out, (const bf16*)a.out + (size_t)T * D});
    SEAM(6);
    if (IN(7)) fgemm_dense(lds, (const bf16*)(ws + WS_IA), (const bf16*)(ws + WS_WOT), T, 1024, 1024, EpiD{ws, a.out, a.in[0], a.in[2], a.in[3]});
    SEAM(7);
    if (IN(8)) p_ln1_route(a, lds);
    SEAM(8);
    if (IN(9)) p_slots(a, lds);
    SEAM(9);
    if (IN(10)) f_moe_gemm<false>(a, lds, 0);
    SEAM(10);
    if (IN(11)) f_moe_gemm<true>(a, lds, 0);
    SEAM(11);
    if (IN(12)) p_combine(a, 0);
    __syncthreads();
    if (IN(13)) f_moe_gemm<false>(a, lds, 1);
    SEAM(13);
    if (IN(14)) f_moe_gemm<true>(a, lds, 1);
    SEAM(14);
    if (IN(15)) p_combine(a, 1);
#undef IN
#undef SEAM
}

extern "C" void kernel_launch(void* const* d_in, const int* in_sizes, int n_in, void* d_out, int out_size, void* d_ws, size_t ws_size, hipStream_t stream) {
    static int grid = 0;
    if (grid == 0) {
        if (n_in != 27 || out_size != T * D || ws_size < WS_END) { fprintf(stderr, "kernel_launch: unexpected shapes (n_in %d out %d ws %zu)\n", n_in, out_size, ws_size); grid = -1; return; }
        int dev = 0, cus = 0;
        if (hipGetDevice(&dev) != hipSuccess || hipDeviceGetAttribute(&cus, hipDeviceAttributeMultiprocessorCount, dev) != hipSuccess) { grid = -1; return; }
        if (hipFuncSetAttribute((const void*)fwd, hipFuncAttributeMaxDynamicSharedMemorySize, LDS_BYTES) != hipSuccess) { grid = -1; return; }
        int per_cu = 0; (void)hipOccupancyMaxActiveBlocksPerMultiprocessor(&per_cu, (const void*)fwd, 512, LDS_BYTES); (void)hipGetLastError();
        grid = cus;
    }
    if (grid < 0) return;
    (void)hipMemsetAsync((char*)d_ws + WS_CTL + CW_BAR * 4, 0, (CW_GCNT + 128 - CW_BAR) * 4, stream);
    Args a{};
    for (int i = 0; i < 27; ++i) a.in[i] = (const float*)d_in[i];
    a.out = (float*)d_out; a.ws = (unsigned char*)d_ws;
    a.ph_lo = 0; a.ph_hi = 16; hipLaunchKernelGGL(fwd, dim3(grid), dim3(512), LDS_BYTES, stream, a);
}
```

```cpp
#include <hip/hip_runtime.h>
#include <stdint.h>
#include <stdio.h>
#include <type_traits>

#define LAS __attribute__((address_space(3)))
typedef unsigned short bf16;
typedef float f32x4 __attribute__((ext_vector_type(4)));
typedef unsigned u32x4 __attribute__((ext_vector_type(4)));
typedef unsigned u32x2 __attribute__((ext_vector_type(2)));

constexpr int D = 1024, NB = 8, SEQ = 8192, T = NB * SEQ, NMETA = 16, INW = 9224;
constexpr int NEXP = 64, TOPK = 8, DEXP = 256;
constexpr float EPS = 1e-5f, DN_ALPHA = 1.189207115002721f, ROUTED_SCALE = 2.5f;
constexpr int HALF_T = T / 2;
constexpr int NSLOTMAX = HALF_T * TOPK + NEXP * 256;

constexpr size_t MiB = 1u << 20;
constexpr size_t WS_CTL = 0, CTL_ZERO_BYTES = 1 * MiB;
constexpr size_t WS_WINT = 1 * MiB;
constexpr size_t WS_WAT = 19 * MiB, WS_WBT = 21 * MiB, WS_WOT = 23 * MiB;
constexpr size_t WS_WSGU = 25 * MiB;
constexpr size_t WS_WSD = 26 * MiB;
constexpr size_t WS_META = 27 * MiB;
constexpr size_t WS_WRT = 27 * MiB + 512 * 1024;
constexpr size_t WS_IGFG = 28 * MiB;
constexpr size_t WS_LNST0 = 30 * MiB;
constexpr size_t WS_LNST1 = 30 * MiB + 512 * 1024;
constexpr size_t WS_STA = 31 * MiB;
constexpr size_t WS_STB = 33 * MiB;
constexpr size_t WS_EIDX = 35 * MiB, WS_GW = 37 * MiB, WS_LPOS = 39 * MiB, WS_SLOTOF = 41 * MiB;
constexpr size_t WS_TOKSLOT = 43 * MiB;
constexpr size_t WS_WSLOT = 46 * MiB;
constexpr size_t WS_WGBASE = 49 * MiB;
constexpr size_t WS_IDENT = 49 * MiB + 128 * 1024;
constexpr size_t WS_EM = 50 * MiB, WS_EL = 54 * MiB;
constexpr size_t WS_HALO = 58 * MiB;
constexpr size_t WS_GATES = 932 * MiB;
constexpr size_t WS_SMETA = 940 * MiB;
constexpr size_t WS_CMETA = 941 * MiB;
constexpr size_t WS_NMETA = 942 * MiB;
constexpr size_t WS_STA2 = 944 * MiB;
constexpr size_t WS_STB2 = 948 * MiB;
constexpr size_t WS_WGU = 64 * MiB;
constexpr size_t WS_WD = 128 * MiB;
constexpr size_t WS_H0 = 162 * MiB;
constexpr size_t WS_QA = 290 * MiB, WS_LFA = 418 * MiB, WS_IA = 546 * MiB, WS_QKB = 674 * MiB, WS_VB = 802 * MiB;
constexpr size_t WS_HH = 290 * MiB;
constexpr size_t WS_YH = 444 * MiB;
constexpr size_t WS_HS = 980 * MiB;
constexpr size_t WS_Z = 720 * MiB;
constexpr size_t WS_END = 1024 * MiB;
static_assert(WS_HH + (size_t)(NSLOTMAX + HALF_T) * 512 <= WS_YH && WS_YH + (size_t)NSLOTMAX * 1024 <= WS_Z && WS_Z + (size_t)T * D * 2 <= WS_GATES, "moe map");
constexpr int CW_BAR = 4096, CW_GCNT = 8192;

constexpr int LDS_BYTES = 147456;
constexpr int NPHASE = 20;

__device__ __forceinline__ unsigned f2bf(float f) { unsigned u = __float_as_uint(f); return (u + 0x7fffu + ((u >> 16) & 1u)) >> 16; }
__device__ __forceinline__ float bf2f(unsigned h) { return __uint_as_float(h << 16); }
typedef __bf16 hwbf16x2_t __attribute__((ext_vector_type(2)));
typedef float f32x2_t __attribute__((ext_vector_type(2)));
__device__ __forceinline__ unsigned pk2(float lo, float hi) { const f32x2_t f = {lo, hi}; const hwbf16x2_t b = __builtin_convertvector(f, hwbf16x2_t); return __builtin_bit_cast(unsigned, b); }
__device__ __forceinline__ unsigned f2h(float f) { _Float16 h = (_Float16)f; return (unsigned)__builtin_bit_cast(unsigned short, h); }
__device__ __forceinline__ float h2f(unsigned u) { return (float)__builtin_bit_cast(_Float16, (unsigned short)u); }
__device__ __forceinline__ float wave_sum(float v) {
#pragma unroll
    for (int o = 1; o < 64; o <<= 1) v += __shfl_xor(v, o);
    return v;
}
__device__ __forceinline__ void store8_bf16(bf16* p, const float (&v)[8]);
__device__ __forceinline__ float sigmoidf_(float x) { return __builtin_amdgcn_rcpf(1.0f + __expf(-x)); }
__device__ __forceinline__ float siluf_(float x) { return x * __builtin_amdgcn_rcpf(1.0f + __expf(-x)); }


#define XB_TMO      128
#define XB_XCNT(j)  (256  + 64 * (j))
#define XB_XSUB(j)  (1280 + 64 * (j))
#define XB_XGEN(j)  (2304 + 64 * (j))
#define XB_TOP      3328
#define XB_TOPGEN   3392
#define XCD_BAR_WORDS 3456
#define XB_SPIN_CAP (1u << 20)
__device__ __forceinline__ unsigned xb_ld(unsigned* p)              { return __hip_atomic_load(p, __ATOMIC_RELAXED, __HIP_MEMORY_SCOPE_AGENT); }
__device__ __forceinline__ unsigned xb_add(unsigned* p, unsigned v) { return __hip_atomic_fetch_add(p, v, __ATOMIC_RELAXED, __HIP_MEMORY_SCOPE_AGENT); }
__device__ __forceinline__ unsigned xb_xcc_id() { return (unsigned)__builtin_amdgcn_s_getreg((3 << 11) | 20) & 0xFu; }
#define XB_SPIN(cond, bar) do { unsigned _sp = 0; while (cond) { __builtin_amdgcn_s_sleep(1); \
    if ((++_sp & 255u) == 0u) { if (xb_ld(&(bar)[XB_TMO])) break; if (_sp > XB_SPIN_CAP) { atomicAdd(&(bar)[XB_TMO], 1u); break; } } } } while (0)
struct XcdBarrier { unsigned* bar; unsigned x; volatile LAS unsigned* st; };
__device__ __forceinline__ XcdBarrier xcd_barrier_post(unsigned* bar, volatile LAS unsigned* st) {
    XcdBarrier b; b.bar = bar; b.x = xb_xcc_id(); b.st = st;
    if (threadIdx.x == 0) (void)xb_add(&bar[XB_XCNT(b.x)], 1u);
    return b;
}
__device__ __forceinline__ void xcd_barrier_complete(unsigned* bar, unsigned x, unsigned& nloc, unsigned& nx) {
    const unsigned G = gridDim.x * gridDim.y * gridDim.z;
    unsigned sum, cnt, mine, sp = 0u;
    for (;;) {
        sum = 0u; cnt = 0u; mine = 0u;
#pragma unroll
        for (unsigned j = 0; j < 16; ++j) { const unsigned c = xb_ld(&bar[XB_XCNT(j)]); sum += c; cnt += (c > 0u) ? 1u : 0u; mine = (j == x) ? c : mine; }
        if (sum == G) break;
        __builtin_amdgcn_s_sleep(1);
        if ((++sp & 255u) == 0u) { if (xb_ld(&bar[XB_TMO])) break; if (sp > XB_SPIN_CAP) { atomicAdd(&bar[XB_TMO], 1u); break; } }
    }
    nloc = mine > 0u ? mine : 1u; nx = cnt > 0u ? cnt : 1u;
}
__device__ __forceinline__ void xcd_barrier(const XcdBarrier& b) {
    asm volatile("s_waitcnt vmcnt(0)" ::: "memory");
    __syncthreads();
    if (threadIdx.x == 0) {
        unsigned* bar = b.bar;
        __builtin_amdgcn_s_waitcnt(0);
        unsigned nloc = b.st[0], nx = b.st[1];
        if (nloc == 0u) { xcd_barrier_complete(bar, b.x, nloc, nx); b.st[0] = nloc; b.st[1] = nx; }
        const unsigned old = xb_add(&bar[XB_XSUB(b.x)], 1u);
        const unsigned gen = old / nloc;
        if (old + 1u == (gen + 1u) * nloc) {
            __builtin_amdgcn_fence(__ATOMIC_RELEASE, "agent");
            asm volatile("s_waitcnt vmcnt(0)" ::: "memory");
            const unsigned og = xb_add(&bar[XB_TOP], 1u);
            const unsigned tg = og / nx;
            if (og + 1u == (tg + 1u) * nx) xb_add(&bar[XB_TOPGEN], 1u);
            else XB_SPIN(xb_ld(&bar[XB_TOPGEN]) == tg, bar);
            __builtin_amdgcn_fence(__ATOMIC_ACQUIRE, "agent");
            xb_add(&bar[XB_XGEN(b.x)], 1u);
            asm volatile("s_waitcnt vmcnt(0)" ::: "memory");
        } else {
            XB_SPIN(xb_ld(&bar[XB_XGEN(b.x)]) == gen, bar);
            __builtin_amdgcn_fence(__ATOMIC_ACQUIRE, "agent");
            asm volatile("s_waitcnt vmcnt(0)" ::: "memory");
        }
    }
    __syncthreads();
}

struct Args { const float* in[27]; float* out; unsigned char* ws; int ph_lo, ph_hi; };

struct TrDesc { const float* W; bf16* WT; int ldw, K, nblk, item, mode; };
__device__ __forceinline__ void tr_load(const TrDesc& d, f32x4 (&t)[8], int lane) {
    const int kb = d.item / d.nblk, nb = d.item % d.nblk, k0 = 64 * kb, n0 = 32 * nb;
#pragma unroll
    for (int i = 0; i < 8; ++i) t[i] = *(const f32x4*)(d.W + (size_t)(k0 + 8 * i + (lane >> 3)) * d.ldw + n0 + 4 * (lane & 7));
}
__device__ __forceinline__ void tr_store(const TrDesc& d, const f32x4 (&t)[8], LAS float* scr, int lane) {
    const int kb = d.item / d.nblk, nb = d.item % d.nblk, k0 = 64 * kb, n0 = 32 * nb;
#pragma unroll
    for (int i = 0; i < 8; ++i) { LAS float* p = scr + (8 * i + (lane >> 3)) * 33 + 4 * (lane & 7); p[0] = t[i].x; p[1] = t[i].y; p[2] = t[i].z; p[3] = t[i].w; }
    asm volatile("s_waitcnt lgkmcnt(0)" ::: "memory");
    const int c = lane & 7;
#pragma unroll
    for (int j = 0; j < 4; ++j) { const int n = (lane >> 3) + 8 * j; const LAS float* s = scr + (8 * c) * 33 + n;
        u32x4 o; o.x = pk2(s[0 * 33], s[1 * 33]); o.y = pk2(s[2 * 33], s[3 * 33]); o.z = pk2(s[4 * 33], s[5 * 33]); o.w = pk2(s[6 * 33], s[7 * 33]);
        const int nn = n0 + n, row = d.mode == 0 ? nn : (nn >> 7) * 256 + (d.mode - 1) * 128 + (nn & 127);
        *(u32x4*)(d.WT + (size_t)row * d.K + k0 + 8 * c) = o; }
    asm volatile("s_waitcnt lgkmcnt(0)" ::: "memory");
}
__device__ __forceinline__ int win_src_off(int g) {
    switch (g) { case 0: return 0; case 1: return 1024; case 2: return 2048; case 3: return 4096; case 4: return 5120; case 5: return 7176; case 6: return 8200; case 7: return 3072; default: return 6144; }
}

__device__ __forceinline__ void p0_prologue(const Args& a, LAS unsigned char* lds) {
    const int tid = threadIdx.x, lane = tid & 63, wave = tid >> 6;
    unsigned char* ws = a.ws;
    const int gw = blockIdx.x * 8 + wave, NGW = gridDim.x * 8;
    {
        LAS float* scr = (LAS float*)(lds + 32768 + wave * 8704);
        constexpr int NA = 12 * 512, NBt = 130 * 128, NC = 65 * 128, NTOT = NA + NBt + NC;
        auto decode = [&](int it) -> TrDesc { TrDesc d;
            if (it < NA) { const int job = it / 512; d.item = it % 512; d.ldw = job < 9 ? INW : 1024; d.K = 1024; d.nblk = 32; d.mode = 0;
                if (job < 9) { d.W = a.in[4] + win_src_off(job); d.WT = (bf16*)(ws + WS_WINT) + (size_t)job * 1024 * 1024; }
                else { d.W = a.in[12 + (job - 9)]; d.WT = (bf16*)(ws + (job == 9 ? WS_WAT : job == 10 ? WS_WBT : WS_WOT)); } }
            else if (it < NA + NBt) { const int r = it - NA, job = r / 128; d.item = r % 128; d.ldw = 256; d.K = 1024; d.nblk = 8;
                if (job < 128) { const int e = job & 63, up = job >> 6; d.mode = 1 + up; d.W = a.in[19 + up] + (size_t)e * 1024 * 256; d.WT = (bf16*)(ws + WS_WGU) + (size_t)e * 512 * 1024; }
                else { const int up = job - 128; d.mode = 1 + up; d.W = a.in[22 + up]; d.WT = (bf16*)(ws + WS_WSGU); } }
            else { const int r = it - NA - NBt, job = r / 128; d.item = r % 128; d.ldw = 1024; d.K = 256; d.nblk = 32; d.mode = 0;
                if (job < 64) { d.W = a.in[21] + (size_t)job * 256 * 1024; d.WT = (bf16*)(ws + WS_WD) + (size_t)job * 1024 * 256; }
                else { d.W = a.in[24]; d.WT = (bf16*)(ws + WS_WSD); } }
            return d; };
        if (gw < NTOT) {
            TrDesc d0 = decode(gw); f32x4 t0[8]; tr_load(d0, t0, lane);
            for (int it = gw; it < NTOT; it += NGW) {
                TrDesc d1 = d0; f32x4 t1[8]; const bool more = it + NGW < NTOT;
                if (more) { d1 = decode(it + NGW); tr_load(d1, t1, lane); }
                tr_store(d0, t0, scr, lane);
                if (more) { d0 = d1;
#pragma unroll
                    for (int i = 0; i < 8; ++i) t0[i] = t1[i]; }
            }
        }
    }
    __syncthreads();
    LAS float* Wg8 = (LAS float*)lds;
    for (int i = tid; i < 1024 * 8; i += 512) Wg8[i] = a.in[4][(size_t)(i >> 3) * INW + 7168 + (i & 7)];
    __syncthreads();
    {
        const float* x = a.in[0]; const f32x4* gp = (const f32x4*)a.in[2] + lane; const f32x4* bp = (const f32x4*)a.in[3] + lane;
        f32x4 g[4], b[4];
#pragma unroll
        for (int j = 0; j < 4; ++j) { g[j] = gp[64 * j]; b[j] = bp[64 * j]; }
        bf16* h0 = (bf16*)(ws + WS_H0); float* lnst = (float*)(ws + WS_LNST0); float* igfg = (float*)(ws + WS_IGFG);
        f32x4 vn[4];
        if (gw < T) { const f32x4* xr = (const f32x4*)(x + (size_t)gw * D) + lane;
#pragma unroll
            for (int j = 0; j < 4; ++j) vn[j] = xr[64 * j]; }
        for (int m = gw; m < T; m += NGW) {
            f32x4 v[4]; float s = 0.f;
#pragma unroll
            for (int j = 0; j < 4; ++j) { v[j] = vn[j]; s += (v[j].x + v[j].y) + (v[j].z + v[j].w); }
            if (m + NGW < T) { const f32x4* xr = (const f32x4*)(x + (size_t)(m + NGW) * D) + lane;
#pragma unroll
                for (int j = 0; j < 4; ++j) vn[j] = xr[64 * j]; }
            const float mean = wave_sum(s) * (1.f / D); float s2 = 0.f;
#pragma unroll
            for (int j = 0; j < 4; ++j) { v[j] = v[j] - mean; s2 += (v[j].x * v[j].x + v[j].y * v[j].y) + (v[j].z * v[j].z + v[j].w * v[j].w); }
            const float rstd = 1.f / sqrtf(wave_sum(s2) * (1.f / D) + EPS);
            float acc[8];
#pragma unroll
            for (int c = 0; c < 8; ++c) acc[c] = 0.f;
            unsigned long long* o8 = (unsigned long long*)(h0 + (size_t)m * D) + lane;
#pragma unroll
            for (int j = 0; j < 4; ++j) {
                f32x4 h = v[j] * rstd * g[j] + b[j];
                o8[64 * j] = (unsigned long long)pk2(h.x, h.y) | ((unsigned long long)pk2(h.z, h.w) << 32);
#pragma unroll
                for (int i = 0; i < 4; ++i) { const int k = 4 * lane + i + 256 * j; const f32x4 w0 = *(const LAS f32x4*)(Wg8 + k * 8), w1 = *(const LAS f32x4*)(Wg8 + k * 8 + 4);
                    const float hv = h[i];
                    acc[0] += hv * w0.x; acc[1] += hv * w0.y; acc[2] += hv * w0.z; acc[3] += hv * w0.w; acc[4] += hv * w1.x; acc[5] += hv * w1.y; acc[6] += hv * w1.z; acc[7] += hv * w1.w; }
            }
            float r4[4], r2[2], r1;
            { const bool up = lane & 1;
#pragma unroll
              for (int c = 0; c < 4; ++c) { const float send = up ? acc[c] : acc[4 + c], keep = up ? acc[4 + c] : acc[c]; r4[c] = keep + __shfl_xor(send, 1); } }
            { const bool up = lane & 2;
#pragma unroll
              for (int c = 0; c < 2; ++c) { const float send = up ? r4[c] : r4[2 + c], keep = up ? r4[2 + c] : r4[c]; r2[c] = keep + __shfl_xor(send, 2); } }
            { const bool up = lane & 4; const float send = up ? r2[0] : r2[1], keep = up ? r2[1] : r2[0]; r1 = keep + __shfl_xor(send, 4); }
            r1 += __shfl_xor(r1, 8); r1 += __shfl_xor(r1, 16); r1 += __shfl_xor(r1, 32);
            if (lane < 8) igfg[(size_t)m * 8 + 4 * (lane & 1) + 2 * ((lane >> 1) & 1) + ((lane >> 2) & 1)] = r1;
            if (lane == 0) { lnst[2 * m] = mean; lnst[2 * m + 1] = rstd; }
        }
    }
    __syncthreads();
    for (int cgp = blockIdx.x; cgp < 81; cgp += gridDim.x) {
        LAS float* hm = (LAS float*)(lds + 32768);
        LAS float* part = (LAS float*)(lds + 32768 + 65536);
        __syncthreads();
        for (int r = wave * 2; r < wave * 2 + 2; ++r) {
            const f32x4* xr = (const f32x4*)(a.in[1] + (size_t)r * D) + lane; const f32x4* gp = (const f32x4*)a.in[2] + lane; const f32x4* bp = (const f32x4*)a.in[3] + lane;
            f32x4 v[4]; float s = 0.f;
#pragma unroll
            for (int j = 0; j < 4; ++j) { v[j] = xr[64 * j]; s += (v[j].x + v[j].y) + (v[j].z + v[j].w); }
            const float mean = wave_sum(s) * (1.f / D); float s2 = 0.f;
#pragma unroll
            for (int j = 0; j < 4; ++j) { v[j] = v[j] - mean; s2 += (v[j].x * v[j].x + v[j].y * v[j].y) + (v[j].z * v[j].z + v[j].w * v[j].w); }
            const float rstd = 1.f / sqrtf(wave_sum(s2) * (1.f / D) + EPS);
#pragma unroll
            for (int j = 0; j < 4; ++j) { const f32x4 h = v[j] * rstd * gp[64 * j] + bp[64 * j]; *(LAS f32x4*)(hm + r * 1024 + 4 * (lane + 64 * j)) = h; }
        }
        __syncthreads();
        const int c = cgp * 64 + lane;
        const int cc = c < 5128 ? c : 5127, g = cc >> 10, srccol = (cc < 5120) ? win_src_off(g) + (cc & 1023) : 7168 + (cc - 5120);
        float acc[16];
#pragma unroll
        for (int r = 0; r < 16; ++r) acc[r] = 0.f;
        const float* wp = a.in[4] + (size_t)(wave * 128) * INW + srccol;
#pragma unroll 4
        for (int k = 0; k < 128; ++k) { const float w = wp[(size_t)k * INW];
#pragma unroll
            for (int r = 0; r < 16; ++r) acc[r] += hm[r * 1024 + wave * 128 + k] * w; }
#pragma unroll
        for (int r = 0; r < 16; ++r) part[(wave * 16 + r) * 64 + lane] = acc[r];
        __syncthreads();
        if (c < 5128) {
            float* meta = (float*)(ws + WS_META);
            for (int r = wave * 2; r < wave * 2 + 2; ++r) { float v = 0.f;
#pragma unroll
                for (int w8 = 0; w8 < 8; ++w8) v += part[(w8 * 16 + r) * 64 + lane];
                if (c < 5120) { const int c1 = c & 1023;
                    if (g == 1) { const float lb = 1.0f / (1.0f + expf(a.in[5][1024 + c1] - a.in[5][c1])); v = logf(lb + (1.0f - lb) * sigmoidf_(v)); }
                    meta[(size_t)g * 16384 + r * 1024 + c1] = v; }
                else meta[5 * 16384 + r * 8 + (c - 5120)] = v; }
        }
    }
    for (int it = blockIdx.x * 512 + tid; it < 64 * 128; it += gridDim.x * 512) { const int e = it >> 7, k0 = (it & 127) * 8; float hi[8], lo[8];
#pragma unroll
        for (int j = 0; j < 8; ++j) { const float wv = a.in[17][(size_t)(k0 + j) * 64 + e]; const float h = bf2f(f2bf(wv)); hi[j] = h; lo[j] = wv - h; }
        store8_bf16((bf16*)(ws + WS_WRT) + (size_t)e * 1024 + k0, hi); store8_bf16((bf16*)(ws + WS_WRT) + 65536 + (size_t)e * 1024 + k0, lo); }
    {
        int* ts = (int*)(ws + WS_TOKSLOT); float* wsl = (float*)(ws + WS_WSLOT);
        for (int i = blockIdx.x * 512 + tid; i < 2 * NSLOTMAX; i += gridDim.x * 512) { ts[i] = 0; wsl[i] = 0.f; }
        int* ident = (int*)(ws + WS_IDENT);
        for (int i = blockIdx.x * 512 + tid; i < T; i += gridDim.x * 512) ident[i] = i;
    }
}

__device__ __forceinline__ void store8_bf16(bf16* p, const float (&v)[8]) { u32x4 w; w.x = pk2(v[0], v[1]); w.y = pk2(v[2], v[3]); w.z = pk2(v[4], v[5]); w.w = pk2(v[6], v[7]); *(u32x4*)p = w; }
__device__ __forceinline__ void load8_bf16(const bf16* p, float (&v)[8]) { const u32x4 w = *(const u32x4*)p;
    v[0] = bf2f(w.x & 0xffffu); v[1] = bf2f(w.x >> 16); v[2] = bf2f(w.y & 0xffffu); v[3] = bf2f(w.y >> 16); v[4] = bf2f(w.z & 0xffffu); v[5] = bf2f(w.z >> 16); v[6] = bf2f(w.w & 0xffffu); v[7] = bf2f(w.w >> 16); }

struct NoData {};
template <int K> struct KindTag { static constexpr int value = K; };
template <class T, class = void> struct epigroup { static constexpr int value = 4; };
template <class T> struct epigroup<T, typename std::enable_if<(T::GROUP > 0)>::type> { static constexpr int value = T::GROUP; };
template <class T, class = void> struct pairbj : std::false_type {};
template <class T> struct pairbj<T, typename std::enable_if<T::PAIRBJ>::type> : std::true_type {};
__device__ __forceinline__ void unpack8(const u32x4 w, float (&v)[8]) { v[0] = bf2f(w.x & 0xffffu); v[1] = bf2f(w.x >> 16); v[2] = bf2f(w.y & 0xffffu); v[3] = bf2f(w.y >> 16); v[4] = bf2f(w.z & 0xffffu); v[5] = bf2f(w.z >> 16); v[6] = bf2f(w.w & 0xffffu); v[7] = bf2f(w.w >> 16); }
struct EpiA {
    static constexpr bool PIPE = false; static constexpr int NKIND = 4;
    unsigned char* ws; unsigned char* dout; const float* lbl;
    struct Cl { float lb[8]; bf16* base; }; typedef NoData Ld;
    __device__ __forceinline__ int kind(int col0) const { const int g = col0 >> 10; return g == 1 ? 1 : g >= 5 ? 2 : g == 3 ? 3 : 0; }
    template <int K> __device__ __forceinline__ void colload(int col0, Cl& cl) const { const int g = col0 >> 10, c = col0 & 1023;
        if (K == 1) {
#pragma unroll
            for (int j = 0; j < 8; ++j) cl.lb[j] = __builtin_amdgcn_rcpf(1.0f + __expf(lbl[1024 + c + j] - lbl[c + j]));
            cl.base = (bf16*)(ws + WS_LFA) + c; }
        else if (K == 2) cl.base = (bf16*)dout + (size_t)(g - 5) * T * D + c;
        else if (K == 3) cl.base = (bf16*)(ws + WS_QKB) + c;
        else cl.base = (bf16*)(ws + (g == 0 ? WS_QA : g == 2 ? WS_IA : WS_VB)) + c; }
    template <int K> __device__ __forceinline__ void load(int, int, Ld&) const {}
    template <int K> __device__ __forceinline__ void apply(int row, int col0, int m, const float (&v)[8], const Ld&, const Cl& cl) const {
        if (K == 1) { float o[8];
#pragma unroll
            for (int j = 0; j < 8; ++j) o[j] = __logf(cl.lb[j] + (1.0f - cl.lb[j]) * sigmoidf_(v[j]));
            u32x4 w; w.x = f2h(o[0]) | (f2h(o[1]) << 16); w.y = f2h(o[2]) | (f2h(o[3]) << 16); w.z = f2h(o[4]) | (f2h(o[5]) << 16); w.w = f2h(o[6]) | (f2h(o[7]) << 16);
            *(u32x4*)(cl.base + (size_t)row * D) = w; }
        else if (K == 2) { float o[8];
#pragma unroll
            for (int j = 0; j < 8; ++j) o[j] = sigmoidf_(v[j]);
            store8_bf16(cl.base + (size_t)row * D, o); }
        else { store8_bf16(cl.base + (size_t)row * D, v);
            if (K == 3 && m == 3) { if ((row & 63) >= 61) store8_bf16((bf16*)(ws + WS_HALO) + ((size_t)(row >> 6) * 3 + ((row & 63) - 61)) * D + (col0 & 1023), v); } }
    }
};
struct EpiB {
    static constexpr bool PIPE = false; static constexpr int NKIND = 2; static constexpr int GROUP = 2;
    unsigned char* ws; const float* hg_g; const float* ml_g;
    struct Cl { float gn[8]; }; struct Ld { u32x4 x; float mean, rstd; };
    __device__ __forceinline__ int kind(int col0) const { return col0 >> 10; }
    template <int K> __device__ __forceinline__ void colload(int col0, Cl& cl) const { const int c = col0 & 1023; const float* gp = (K == 0 ? hg_g : ml_g) + c;
#pragma unroll
        for (int j = 0; j < 8; ++j) cl.gn[j] = gp[j]; }
    template <int K> __device__ __forceinline__ void load(int row, int col0, Ld& ld) const { const int c = col0 & 1023;
        if (K == 0) { ld.x = *(const u32x4*)((const bf16*)(ws + WS_IA) + (size_t)row * D + c); ld.mean = 0.f;
            const f32x2_t p = *(const f32x2_t*)((const float*)(ws + WS_STA2) + (size_t)row * 16 + (c >> 7) * 2); ld.rstd = __builtin_amdgcn_rsqf((p.x + p.y) * (1.f / 128.f) + EPS); }
        else { ld.x = *(const u32x4*)((const bf16*)(ws + WS_VB) + (size_t)row * D + c); const f32x4* st = (const f32x4*)((const float*)(ws + WS_STB2) + ((size_t)row * 16 + (c >> 8) * 4) * 2);
            const f32x4 a0 = st[0], a1 = st[1]; const float s1 = (a0.x + a0.z) + (a1.x + a1.z), s2 = (a0.y + a0.w) + (a1.y + a1.w);
            ld.mean = s1 * (1.f / 256.f); ld.rstd = __builtin_amdgcn_rsqf(fmaxf(s2 * (1.f / 256.f) - ld.mean * ld.mean, 0.f) + EPS); } }
    template <int K> __device__ __forceinline__ void apply(int row, int col0, int, const float (&v)[8], const Ld& ld, const Cl& cl) const {
        const int c = col0 & 1023; float x[8], o[8]; unpack8(ld.x, x);
        if (K == 0) {
#pragma unroll
            for (int j = 0; j < 8; ++j) o[j] = x[j] * ld.rstd * cl.gn[j] * siluf_(v[j]);
            store8_bf16((bf16*)(ws + WS_LFA) + (size_t)row * D + c, o);
        } else {
#pragma unroll
            for (int j = 0; j < 8; ++j) o[j] = (x[j] - ld.mean) * ld.rstd * cl.gn[j] * sigmoidf_(v[j]);
            store8_bf16((bf16*)(ws + WS_QKB) + (size_t)row * D + c, o);
        }
    }
};
struct EpiC {
    static constexpr bool PIPE = true; static constexpr int NKIND = 1;
    unsigned char* ws; const bf16* sga; const bf16* sgb;
    typedef NoData Cl; struct Ld { u32x4 a, b; };
    __device__ __forceinline__ int kind(int) const { return 0; }
    template <int K> __device__ __forceinline__ void colload(int, Cl&) const {}
    __device__ __forceinline__ void midload(int row, int col0, Ld& ld) const { ld.a = *(const u32x4*)(sga + (size_t)row * D + col0); ld.b = *(const u32x4*)(sgb + (size_t)row * D + col0); }
    __device__ __forceinline__ void mid(float (&v)[8], const Ld& ld) const { float sa[8], sb[8]; unpack8(ld.a, sa); unpack8(ld.b, sb);
#pragma unroll
        for (int j = 0; j < 8; ++j) v[j] *= sa[j] * __builtin_amdgcn_rcpf(sb[j]); }
    template <int K> __device__ __forceinline__ void load(int row, int col0, Ld& ld) const { ld.b = *(const u32x4*)(sgb + (size_t)row * D + col0); }
    template <int K> __device__ __forceinline__ void apply(int row, int col0, int, const float (&v)[8], const Ld& ld, const Cl&) const { float sb[8], o[8]; unpack8(ld.b, sb);
#pragma unroll
        for (int j = 0; j < 8; ++j) o[j] = sb[j] * v[j];
        store8_bf16((bf16*)(ws + WS_IA) + (size_t)row * D + col0, o); }
};
struct EpiD {
    static constexpr bool PIPE = false; static constexpr int NKIND = 1;
    unsigned char* ws; float* dout; const float* x; const float* g; const float* b;
    struct Cl { float g[8], b[8]; }; struct Ld { f32x4 x0, x1; float mean, rstd; };
    __device__ __forceinline__ int kind(int) const { return 0; }
    template <int K> __device__ __forceinline__ void colload(int col0, Cl& cl) const {
#pragma unroll
        for (int j = 0; j < 8; ++j) { cl.g[j] = g[col0 + j]; cl.b[j] = b[col0 + j]; } }
    template <int K> __device__ __forceinline__ void load(int row, int col0, Ld& ld) const { const float* st = (const float*)(ws + WS_LNST0) + 2 * (size_t)row; ld.mean = st[0]; ld.rstd = st[1];
        ld.x0 = *(const f32x4*)(x + (size_t)row * D + col0); ld.x1 = *(const f32x4*)(x + (size_t)row * D + col0 + 4); }
    template <int K> __device__ __forceinline__ void apply(int row, int col0, int, const float (&v)[8], const Ld& ld, const Cl& cl) const { float o[8];
#pragma unroll
        for (int j = 0; j < 4; ++j) { o[j] = DN_ALPHA * ((ld.x0[j] - ld.mean) * ld.rstd * cl.g[j] + cl.b[j]) + v[j]; o[4 + j] = DN_ALPHA * ((ld.x1[j] - ld.mean) * ld.rstd * cl.g[4 + j] + cl.b[4 + j]) + v[4 + j]; }
        store8_bf16((bf16*)(ws + WS_Z) + (size_t)row * D + col0, o); }
};
struct EpiGU {
    static constexpr bool PIPE = false; static constexpr int NKIND = 1; static constexpr bool PAIRBJ = true;
    bf16* H;
    typedef NoData Cl; typedef NoData Ld;
    __device__ __forceinline__ int kind(int) const { return 0; }
    __device__ __forceinline__ void apply_pair(int row, int col0, const float (&g)[8], const float (&u)[8]) const {
        float o[8];
#pragma unroll
        for (int j = 0; j < 8; ++j) o[j] = siluf_(g[j]) * u[j];
        store8_bf16(H + (size_t)row * DEXP + (col0 >> 8) * 128 + (col0 & 127), o); }
};
struct EpiDown {
    static constexpr bool PIPE = true; static constexpr int NKIND = 1;
    unsigned char* Y; const float* w;
    typedef NoData Cl; struct Ld { float s; };
    __device__ __forceinline__ int kind(int) const { return 0; }
    template <int K> __device__ __forceinline__ void colload(int, Cl&) const {}
    template <int K> __device__ __forceinline__ void load(int row, int, Ld& ld) const { ld.s = w[row]; }
    template <int K> __device__ __forceinline__ void apply(int row, int col0, int, const float (&v)[8], const Ld& ld, const Cl&) const { float o[8]; const float s = ld.s * 32.0f;
#pragma unroll
        for (int j = 0; j < 8; ++j) o[j] = fminf(fmaxf(s * v[j], -448.f), 448.f);
        int w0 = __builtin_amdgcn_cvt_pk_fp8_f32(o[0], o[1], 0, false); w0 = __builtin_amdgcn_cvt_pk_fp8_f32(o[2], o[3], w0, true);
        int w1 = __builtin_amdgcn_cvt_pk_fp8_f32(o[4], o[5], 0, false); w1 = __builtin_amdgcn_cvt_pk_fp8_f32(o[6], o[7], w1, true);
        *(u32x2*)(Y + (size_t)row * D + col0) = (u32x2){(unsigned)w0, (unsigned)w1}; }
};
struct EpiSD2 {
    static constexpr bool PIPE = false; static constexpr int NKIND = 1;
    unsigned char* ws; float* dout; const float* g; const float* b; int tokbase;
    struct Cl { float g[8], b[8]; }; struct Ld { u32x4 z; float mean, rstd; };
    __device__ __forceinline__ int kind(int) const { return 0; }
    template <int K> __device__ __forceinline__ void colload(int col0, Cl& cl) const {
#pragma unroll
        for (int j = 0; j < 8; ++j) { cl.g[j] = g[col0 + j]; cl.b[j] = b[col0 + j]; } }
    template <int K> __device__ __forceinline__ void load(int row, int col0, Ld& ld) const { const int tok = tokbase + row - NSLOTMAX; const float* st = (const float*)(ws + WS_LNST1) + 2 * (size_t)tok; ld.mean = st[0]; ld.rstd = st[1];
        ld.z = *(const u32x4*)((const bf16*)(ws + WS_Z) + (size_t)tok * D + col0); }
    template <int K> __device__ __forceinline__ void apply(int row, int col0, int, const float (&v)[8], const Ld& ld, const Cl& cl) const { const int tok = tokbase + row - NSLOTMAX; float z[8], o[8]; unpack8(ld.z, z);
#pragma unroll
        for (int j = 0; j < 8; ++j) o[j] = DN_ALPHA * ((z[j] - ld.mean) * ld.rstd * cl.g[j] + cl.b[j]) + v[j];
        store8_bf16((bf16*)(ws + WS_H0) + (size_t)tok * D + col0, o); }
};

namespace pg8 {
typedef short bf16x8 __attribute__((ext_vector_type(8)));
constexpr int BM = 256, BK = 64, HALF = 128, HTB = HALF * BK * 2, STAGE_BYTES = 8 * HTB, NXCD = 8, WGM = 8;
__device__ __forceinline__ int lds_byte(int r, int c) { const int st = (r >> 4) * 2 + (c >> 5), rr = r & 15, cc = c & 31, ob = rr * 64 + cc * 2; return st * 1024 + (ob ^ (((ob >> 9) & 1) << 5)); }
__device__ __forceinline__ void stage_rc(int b, int& R, int& C) { const int st = b / 1024, sb = b % 1024, swz = sb ^ (((sb >> 9) & 1) << 5); R = (st >> 1) * 16 + swz / 64; C = (st & 1) * 32 + (swz % 64) / 2; }
__device__ __forceinline__ int perm32(int rho) { const int n = rho >> 4, i = rho & 15; return 8 * (i >> 2) + 4 * n + (i & 3); }
struct Unit { int row0, col0; const char* A; const char* B; const int* idx; int mode; };
__device__ __forceinline__ int xcd_remap(int L, int nwg) { const int q = nwg / NXCD, r = nwg % NXCD, xcd = L % NXCD, off = L / NXCD; return (xcd < r ? xcd * (q + 1) : r * (q + 1) + (xcd - r) * q) + off; }
struct DenseOrder {
    int nM, nN, nwg, G, c, K; const char* A; const char* Bt;
    __device__ __forceinline__ void init(const bf16* A_, const bf16* Bt_, int M, int N, int K_) { A = (const char*)A_; Bt = (const char*)Bt_; K = K_; nM = M / BM; nN = N / BM; nwg = nM * nN; G = gridDim.x; c = blockIdx.x; }
    __device__ __forceinline__ bool next(int i, Unit& u) const {
        const long L = (long)i * G + c; if (L >= nwg) return false;
        const int wgid = xcd_remap((int)L, nwg);
        const int nig = WGM * nN, gid = wgid / nig, fm = gid * WGM, gsz = (nM - fm) < WGM ? (nM - fm) : WGM;
        const int pm = fm + ((wgid % nig) % gsz), pn = (wgid % nig) / gsz;
        u.row0 = pm * BM; u.col0 = pn * BM; u.A = A + (size_t)pm * BM * K * 2; u.B = Bt + (size_t)pn * BM * K * 2; u.idx = nullptr; u.mode = 0; return true;
    }
};
struct PairedOrder {
    DenseOrder d; const char* A2; const char* B2;
    __device__ __forceinline__ bool next(int i, Unit& u) const {
        if (!d.next(i >> 1, u)) return false;
        if (i & 1) { u.A = A2 + (size_t)u.row0 * d.K * 2; u.B = B2 + (size_t)u.col0 * d.K * 2; u.mode = 2; } else u.mode = 1;
        return true;
    }
};
struct GroupedOrder {
    const LAS int* te; int nct, nrt, nwg1, nwg2, G, c, K; const char* A; const int* idx; const int* ident; const char* Bt; const char* Bsh; size_t estride; bool gather;
    __device__ __forceinline__ bool next(int i, Unit& u) const {
        const int n1 = c < nwg1 ? (nwg1 - c + G - 1) / G : 0;
        if (i < n1) { const int wgid = xcd_remap(i * G + c, nwg1), rt = wgid / nct, ct = wgid % nct, row0 = rt * BM; const int e = __builtin_amdgcn_readfirstlane(te[rt]); u.mode = 0; u.col0 = ct * BM;
            u.row0 = row0; u.A = gather ? A : A + (size_t)row0 * K * 2; u.idx = idx + row0; u.B = Bt + (size_t)e * estride + (size_t)ct * BM * K * 2; return true; }
        const int L2 = (i - n1) * G + c; if (L2 >= nwg2) return false;
        const int wgid = xcd_remap(L2, nwg2), rt = wgid / nct, ct = wgid % nct, row0 = NSLOTMAX + rt * BM; u.mode = 3; u.col0 = ct * BM;
        u.row0 = row0; u.A = gather ? A : A + (size_t)row0 * K * 2; u.idx = ident + rt * BM; u.B = Bsh + (size_t)ct * BM * K * 2; return true;
    }
};

template <bool GATHER, bool PAIRED, class Epi, class Sched, class Epi2>
__device__ __forceinline__ void gemm_phase2(LAS unsigned char* lds, const int K, const Sched& S, const Epi& E, const Epi2& E2) {
    const int tid = threadIdx.x, wid = __builtin_amdgcn_readfirstlane(tid >> 6), lane = tid & 63, wr = wid >> 2, wc = wid & 3, fr = lane & 15, fq = lane >> 4;
    const int nt = K / BK;
    unsigned voffA[2], voffB[2]; int stR[2], stC[2];
#pragma unroll
    for (int i = 0; i < 2; ++i) { int R, C; stage_rc(tid * 16 + i * 8192, R, C); const int Rb = (R & ~31) + perm32(R & 31);
        voffA[i] = (unsigned)(R * K + C) * 2u; voffB[i] = (unsigned)(Rb * K + C) * 2u; stR[i] = R; stC[i] = C; }
    const size_t kstep = (size_t)(BK * 2);
    const size_t hstep = (size_t)HALF * K * 2;
    const unsigned ldsw = (unsigned)wid * 1024u;
    const int aoff = lds_byte(wr * 64 + fr, fq * 8), boff = lds_byte(wc * 32 + fr, fq * 8);
    unsigned cvA[2][2], nvA[2][2];
#define PG8_SA(b, h) (((b) * 2 + (h)) * HTB)
#define PG8_SB(b, h) ((4 + (b) * 2 + (h)) * HTB)
#define PG8_STAGE(bufoff, gbase, voff) do { _Pragma("unroll") for (int _i = 0; _i < 2; ++_i) \
        __builtin_amdgcn_global_load_lds((const unsigned*)((const char*)(gbase) + (voff)[_i]), (LAS unsigned*)(lds + (bufoff) + ldsw + _i * 8192), 16, 0, 0); } while (0)
#define PG8_STAGE_A(bufoff, kbase, h, usenext) do { if constexpr (GATHER) { unsigned _o[2]; _o[0] = (usenext) ? nvA[h][0] : cvA[h][0]; _o[1] = (usenext) ? nvA[h][1] : cvA[h][1]; PG8_STAGE(bufoff, kbase, _o); } \
        else { PG8_STAGE(bufoff, (kbase) + (h) * hstep, voffA); } } while (0)
#define PG8_LOADIDX(dst, un) do { _Pragma("unroll") for (int _h = 0; _h < 2; ++_h) _Pragma("unroll") for (int _i = 0; _i < 2; ++_i) \
        dst[_h][_i] = ((unsigned)(un).idx[_h * HALF + stR[_i]] * (unsigned)K + (unsigned)stC[_i]) * 2u; } while (0)
#define PG8_LDA(dst, b, h) do { _Pragma("unroll") for (int m = 0; m < 4; ++m) _Pragma("unroll") for (int k = 0; k < 2; ++k) dst[m][k] = *(const LAS bf16x8*)(lds + PG8_SA(b, h) + aoff + m * 2048 + k * 1024); } while (0)
#define PG8_LDB(dst, b, h) do { _Pragma("unroll") for (int n = 0; n < 2; ++n) _Pragma("unroll") for (int k = 0; k < 2; ++k) dst[n][k] = *(const LAS bf16x8*)(lds + PG8_SB(b, h) + boff + n * 2048 + k * 1024); } while (0)
#define PG8_MMA(ai, bj, At, Bt) do { __builtin_amdgcn_s_setprio(1); _Pragma("unroll") for (int m = 0; m < 4; ++m) _Pragma("unroll") for (int n = 0; n < 2; ++n) _Pragma("unroll") for (int k = 0; k < 2; ++k) \
        acc[ai][bj][m][n] = __builtin_amdgcn_mfma_f32_16x16x32_bf16(Bt[n][k], At[m][k], acc[ai][bj][m][n], 0, 0, 0); __builtin_amdgcn_s_setprio(0); } while (0)
#define PG8_WAIT_V(n) asm volatile("s_waitcnt vmcnt(" #n ")" ::: "memory")
#define PG8_WAIT_L(n) asm volatile("s_waitcnt lgkmcnt(" #n ")" ::: "memory")
#define PG8_BAR __builtin_amdgcn_s_barrier()
#define PG8_SCHED __builtin_amdgcn_sched_barrier(0)
    Unit cur, nxt; int ui = 0;
    if (!S.next(0, cur)) return;
    f32x4 acc[2][2][4][2];
#pragma unroll
    for (int a = 0; a < 2; ++a)
#pragma unroll
        for (int b = 0; b < 2; ++b)
#pragma unroll
            for (int m = 0; m < 4; ++m)
#pragma unroll
                for (int n = 0; n < 2; ++n) acc[a][b][m][n] = (f32x4){0.f, 0.f, 0.f, 0.f};
    bf16x8 At[4][2], B0[2][2], B1[2][2];
    const char* cA = cur.A; const char* cB = cur.B;
    if constexpr (GATHER) { PG8_LOADIDX(cvA, cur);
#pragma unroll
        for (int h = 0; h < 2; ++h) { nvA[h][0] = cvA[h][0]; nvA[h][1] = cvA[h][1]; } }
    PG8_STAGE(PG8_SB(0, 0), cB, voffB); PG8_STAGE(PG8_SB(0, 1), cB + hstep, voffB); PG8_STAGE_A(PG8_SA(0, 0), cA, 0, false); PG8_STAGE_A(PG8_SA(0, 1), cA, 1, false);
    if (wr == 1) PG8_BAR;
    PG8_WAIT_V(2); PG8_BAR;
    PG8_STAGE(PG8_SB(1, 0), cB + kstep, voffB); PG8_STAGE_A(PG8_SA(1, 0), cA + kstep, 0, false); PG8_STAGE(PG8_SB(1, 1), cB + hstep + kstep, voffB);
    PG8_WAIT_V(6); PG8_BAR;
    for (;;) {
        const bool has_next = S.next(ui + 1, nxt);
        const char* nA = has_next ? nxt.A : cA; const char* nB = has_next ? nxt.B : cB;
#pragma unroll 1
        for (int t = 0; t < nt; t += 2) {
            const bool last = (t == nt - 2);
            const char* a1 = cA + (size_t)(t + 1) * kstep;
            const char* a2 = last ? nA : cA + (size_t)(t + 2) * kstep; const char* b2 = last ? nB : cB + (size_t)(t + 2) * kstep;
            const char* a3 = a2 + kstep; const char* b3 = b2 + kstep;
            if constexpr (GATHER) { if (last && has_next) PG8_LOADIDX(nvA, nxt); }
            PG8_LDB(B0, 0, 0); PG8_LDB(B1, 0, 1); PG8_SCHED; PG8_LDA(At, 0, 0); PG8_STAGE_A(PG8_SA(1, 1), a1, 1, false);
            PG8_WAIT_V(8);
            PG8_WAIT_L(0); PG8_BAR; PG8_MMA(0, 0, At, B0); PG8_MMA(0, 1, At, B1); PG8_BAR; PG8_SCHED;
            PG8_LDA(At, 0, 1); PG8_STAGE(PG8_SB(0, 0), b2, voffB); PG8_STAGE(PG8_SB(0, 1), b2 + hstep, voffB); PG8_STAGE_A(PG8_SA(0, 0), a2, 0, last);
            PG8_WAIT_V(8);
            PG8_WAIT_L(0); PG8_BAR; PG8_MMA(1, 0, At, B0); PG8_MMA(1, 1, At, B1); PG8_BAR; PG8_SCHED;
            PG8_LDB(B0, 1, 0); PG8_LDB(B1, 1, 1); PG8_SCHED; PG8_LDA(At, 1, 0); PG8_STAGE_A(PG8_SA(0, 1), a2, 1, last);
            PG8_WAIT_V(8); PG8_WAIT_L(0); PG8_BAR; PG8_MMA(0, 0, At, B0); PG8_MMA(0, 1, At, B1); PG8_BAR; PG8_SCHED;
            PG8_LDA(At, 1, 1); PG8_STAGE(PG8_SB(1, 0), b3, voffB); PG8_STAGE(PG8_SB(1, 1), b3 + hstep, voffB); PG8_STAGE_A(PG8_SA(1, 0), a3, 0, last);
            PG8_WAIT_V(8); PG8_WAIT_L(0); PG8_BAR; PG8_MMA(1, 0, At, B0); PG8_MMA(1, 1, At, B1); PG8_BAR; PG8_SCHED;
        }
        if (wr == 0) PG8_BAR;
        {
            const int erow = cur.row0 + wr * 64 + fr, ecol = cur.col0 + wc * 32 + 8 * fq;
#define PG8_V8(ai, bj, m) { acc[ai][bj][m][0][0], acc[ai][bj][m][0][1], acc[ai][bj][m][0][2], acc[ai][bj][m][0][3], acc[ai][bj][m][1][0], acc[ai][bj][m][1][1], acc[ai][bj][m][1][2], acc[ai][bj][m][1][3] }
            auto run = [&](const auto& EE, auto KT) {
                typedef typename std::remove_cv<typename std::remove_reference<decltype(EE)>::type>::type EP; constexpr int KIND = decltype(KT)::value;
                if constexpr (pairbj<EP>::value) {
#pragma unroll
                    for (int ai = 0; ai < 2; ++ai)
#pragma unroll
                        for (int m = 0; m < 4; ++m) { const float vg[8] = PG8_V8(ai, 0, m); const float vu[8] = PG8_V8(ai, 1, m); EE.apply_pair(erow + ai * HALF + m * 16, ecol, vg, vu); }
                } else if constexpr (EP::PIPE) {
                    typename EP::Cl cl[2]; EE.template colload<KIND>(ecol, cl[0]); EE.template colload<KIND>(ecol + HALF, cl[1]);
                    typename EP::Ld ld[2][4];
#pragma unroll
                    for (int m = 0; m < 4; ++m) EE.template load<KIND>(erow + m * 16, ecol, ld[0][m]);
#pragma unroll
                    for (int gi = 0; gi < 4; ++gi) { const int ai = gi >> 1, bj = gi & 1;
                        if (gi < 3) { const int ai2 = (gi + 1) >> 1, bj2 = (gi + 1) & 1;
#pragma unroll
                            for (int m = 0; m < 4; ++m) EE.template load<KIND>(erow + ai2 * HALF + m * 16, ecol + bj2 * HALF, ld[(gi + 1) & 1][m]); }
#pragma unroll
                        for (int m = 0; m < 4; ++m) { const float v[8] = PG8_V8(ai, bj, m); EE.template apply<KIND>(erow + ai * HALF + m * 16, ecol + bj * HALF, m, v, ld[gi & 1][m], cl[bj]); } }
                } else {
#pragma unroll
                    for (int bj = 0; bj < 2; ++bj) { typename EP::Cl cl; EE.template colload<KIND>(ecol + bj * HALF, cl);
#pragma unroll
                        for (int ai = 0; ai < 2; ++ai)
#pragma unroll
                            for (int mg = 0; mg < 4; mg += epigroup<EP>::value) { typename EP::Ld ld[4];
#pragma unroll
                                for (int m = mg; m < mg + epigroup<EP>::value; ++m) EE.template load<KIND>(erow + ai * HALF + m * 16, ecol + bj * HALF, ld[m]);
#pragma unroll
                                for (int m = mg; m < mg + epigroup<EP>::value; ++m) { const float v[8] = PG8_V8(ai, bj, m); EE.template apply<KIND>(erow + ai * HALF + m * 16, ecol + bj * HALF, m, v, ld[m], cl); } } }
                }
            };
            if (cur.mode == 3) run(E2, KindTag<0>{});
            else if (PAIRED && cur.mode == 1) {
                if constexpr (PAIRED) {
#pragma unroll
                for (int bj = 0; bj < 2; ++bj)
#pragma unroll
                    for (int ai = 0; ai < 2; ++ai) { typename Epi::Ld ld[4];
#pragma unroll
                        for (int m = 0; m < 4; ++m) E.midload(erow + ai * HALF + m * 16, ecol + bj * HALF, ld[m]);
#pragma unroll
                        for (int m = 0; m < 4; ++m) { float v[8] = PG8_V8(ai, bj, m); E.mid(v, ld[m]);
                            acc[ai][bj][m][0] = (f32x4){v[0], v[1], v[2], v[3]}; acc[ai][bj][m][1] = (f32x4){v[4], v[5], v[6], v[7]}; } }
                }
            } else if constexpr (Epi::NKIND == 1) run(E, KindTag<0>{});
            else { const int kd = __builtin_amdgcn_readfirstlane(E.kind(cur.col0));
                if (kd == 0) run(E, KindTag<0>{}); else if (kd == 1) run(E, KindTag<1>{});
                else if constexpr (Epi::NKIND > 2) { if (kd == 2) run(E, KindTag<2>{}); else run(E, KindTag<3>{}); } }
#undef PG8_V8
        }
        if (!has_next) break;
        if (!PAIRED || cur.mode != 1) {
#pragma unroll
        for (int a = 0; a < 2; ++a)
#pragma unroll
            for (int b = 0; b < 2; ++b)
#pragma unroll
                for (int m = 0; m < 4; ++m)
#pragma unroll
                    for (int n = 0; n < 2; ++n) acc[a][b][m][n] = (f32x4){0.f, 0.f, 0.f, 0.f};
        }
        cur = nxt; cA = nA; cB = nB; ++ui;
        if constexpr (GATHER) {
#pragma unroll
            for (int h = 0; h < 2; ++h) { cvA[h][0] = nvA[h][0]; cvA[h][1] = nvA[h][1]; } }
        if (wr == 1) PG8_BAR;
    }
    PG8_WAIT_V(0);
    PG8_BAR;
#undef PG8_SA
#undef PG8_SB
#undef PG8_STAGE
#undef PG8_STAGE_A
#undef PG8_LOADIDX
#undef PG8_LDA
#undef PG8_LDB
#undef PG8_MMA
#undef PG8_WAIT_V
#undef PG8_WAIT_L
#undef PG8_BAR
#undef PG8_SCHED
}
template <bool GATHER, bool PAIRED, class Epi, class Sched>
__device__ __forceinline__ void gemm_phase(LAS unsigned char* lds, const int K, const Sched& S, const Epi& E) { gemm_phase2<GATHER, PAIRED>(lds, K, S, E, E); }
}
template <class Epi>
__device__ __forceinline__ void fgemm_dense(LAS unsigned char* lds, const bf16* A, const bf16* Bt, int M, int N, int K, const Epi& epi) {
    pg8::DenseOrder S; S.init(A, Bt, M, N, K);
    pg8::gemm_phase<false, false>(lds, K, S, epi);
}
template <class Epi>
__device__ __forceinline__ void fgemm_paired(LAS unsigned char* lds, const bf16* A1, const bf16* B1, const bf16* A2, const bf16* B2, int M, int N, int K, const Epi& epi) {
    pg8::PairedOrder S; S.d.init(A1, B1, M, N, K); S.A2 = (const char*)A2; S.B2 = (const char*)B2;
    pg8::gemm_phase<false, true>(lds, K, S, epi);
}

__device__ __forceinline__ void scan_hgrn(const Args& a, LAS unsigned char* lds, int b, int h, bool meta_only) {
    unsigned char* ws = a.ws; const int tid = threadIdx.x, v = tid >> 2, kq = tid & 3;
    LAS float* qs = (LAS float*)lds; LAS float* fs = qs + 16 * 128;
    const float* meta = (const float*)(ws + WS_META);
    bf16* QA = (bf16*)(ws + WS_QA); const bf16* LFA = (const bf16*)(ws + WS_LFA); const bf16* IA = (const bf16*)(ws + WS_IA);
    float S[32];
#pragma unroll
    for (int j = 0; j < 32; ++j) S[j] = 0.f;
    for (int blk = -1; blk < SEQ / 16; ++blk) {
        __syncthreads();
        for (int i = tid; i < 16 * 128; i += 512) { const int s = i >> 7, k = i & 127;
            if (blk < 0) { qs[i] = meta[0 * 16384 + s * 1024 + h * 128 + k]; fs[i] = __expf(meta[1 * 16384 + s * 1024 + h * 128 + k]); }
            else { const size_t t = (size_t)b * SEQ + blk * 16 + s; qs[i] = bf2f(QA[t * D + h * 128 + k]); fs[i] = __expf(h2f(LFA[t * D + h * 128 + k])); } }
        __syncthreads();
        for (int s = 0; s < 16; ++s) {
            float vt; size_t t = 0;
            if (blk < 0) vt = meta[2 * 16384 + s * 1024 + h * 128 + v]; else { t = (size_t)b * SEQ + blk * 16 + s; vt = bf2f(IA[t * D + h * 128 + v]); }
            float o = 0.f;
#pragma unroll
            for (int j = 0; j < 32; ++j) { const float f = fs[s * 128 + kq * 32 + j], q = qs[s * 128 + kq * 32 + j]; S[j] = f * S[j] + (1.0f - f) * vt; o += S[j] * q; }
            o += __shfl_xor(o, 1); o += __shfl_xor(o, 2);
            if (blk >= 0 && kq == 0) QA[t * D + h * 128 + v] = (bf16)f2bf(o);
        }
        if (meta_only) { float* sm = (float*)(ws + WS_SMETA) + (size_t)h * 128 * 128;
#pragma unroll
            for (int j = 0; j < 32; ++j) sm[(kq * 32 + j) * 128 + v] = S[j];
            break; }
    }
}
__device__ __forceinline__ void scan_mlstm(const Args& a, LAS unsigned char* lds, int b, int h, bool meta_only) {
    unsigned char* ws = a.ws; const int tid = threadIdx.x, v = tid >> 1, kh = tid & 1;
    LAS float* qs = (LAS float*)lds; LAS float* ks = qs + 16 * 128; LAS float* raw = ks + 16 * 128; LAS float* sc = raw + 19 * 256;
    const float* meta = (const float*)(ws + WS_META); const float* igfg = (const float*)(ws + WS_IGFG);
    const bf16* QKB = (const bf16*)(ws + WS_QKB); bf16* VB = (bf16*)(ws + WS_VB);
    const float* cw = a.in[7]; const float* cb = a.in[8]; const float igb = a.in[9][h], fgb = a.in[10][h];
    float C[64], n[64];
#pragma unroll
    for (int j = 0; j < 64; ++j) { C[j] = 0.f; n[j] = 0.f; }
    float M = 0.f;
    for (int blk = -1; blk < SEQ / 16; ++blk) {
        __syncthreads();
        for (int i = tid; i < 19 * 256; i += 512) { const int r = i >> 8, c = i & 255; const int ch = (c < 128) ? h * 128 + c : 512 + h * 128 + (c - 128);
            float val;
            if (blk < 0) { const int mr = r - 3; val = mr >= 0 ? meta[3 * 16384 + mr * 1024 + ch] : 0.f; }
            else { const int tt = blk * 16 + r - 3; val = tt >= 0 ? bf2f(QKB[((size_t)b * SEQ + tt) * D + ch]) : meta[3 * 16384 + (16 + tt) * 1024 + ch]; }
            raw[i] = val; }
        if (tid < 16) { float ig, fg;
            if (blk < 0) { ig = meta[5 * 16384 + tid * 8 + h]; fg = meta[5 * 16384 + tid * 8 + 4 + h]; }
            else { const size_t t = (size_t)b * SEQ + blk * 16 + tid; ig = igfg[t * 8 + h]; fg = igfg[t * 8 + 4 + h]; }
            ig += igb; fg += fgb;
            sc[tid] = ig; sc[16 + tid] = fminf(fg, 0.f) - log1pf(__expf(-fabsf(fg))); }
        __syncthreads();
        for (int i = tid; i < 16 * 256; i += 512) { const int s = i >> 8, c = i & 255; const int ch = (c < 128) ? h * 128 + c : 512 + h * 128 + (c - 128);
            float y = cb[ch];
#pragma unroll
            for (int j = 0; j < 4; ++j) y += cw[j * 1024 + ch] * raw[(s + j) * 256 + c];
            y = siluf_(y);
            if (c < 128) qs[s * 128 + c] = y * 0.08838834764831845f; else ks[s * 128 + c - 128] = y; }
        __syncthreads();
        for (int s = 0; s < 16; ++s) {
            float vt; size_t t = 0;
            if (blk < 0) vt = meta[4 * 16384 + s * 1024 + h * 256 + v]; else { t = (size_t)b * SEQ + blk * 16 + s; vt = bf2f(VB[t * D + h * 256 + v]); }
            const float ig = sc[s], lf = sc[16 + s]; const float Mn = fmaxf(lf + M, ig), fd = __expf(lf + M - Mn), iw = __expf(ig - Mn); M = Mn;
            float num = 0.f, den = 0.f; const float iv = iw * vt;
#pragma unroll
            for (int j = 0; j < 64; ++j) { const float kv = ks[s * 128 + kh * 64 + j], q = qs[s * 128 + kh * 64 + j]; C[j] = fd * C[j] + iv * kv; n[j] = fd * n[j] + iw * kv; num += C[j] * q; den += n[j] * q; }
            num += __shfl_xor(num, 1); den += __shfl_xor(den, 1);
            const float hv = num / fmaxf(fabsf(den), __expf(-M));
            if (blk >= 0 && kh == 0) VB[t * D + h * 256 + v] = (bf16)f2bf(hv);
        }
        if (meta_only) { float* cm = (float*)(ws + WS_CMETA) + (size_t)h * 128 * 256; float* nm = (float*)(ws + WS_NMETA);
#pragma unroll
            for (int j = 0; j < 64; ++j) { cm[(kh * 64 + j) * 256 + v] = C[j]; if (v == 0) nm[h * 128 + kh * 64 + j] = n[j]; }
            if (tid == 0) nm[1024 + h] = M;
            break; }
    }
}

__device__ __forceinline__ void s0_hgrn_prep(const Args& a) {
    unsigned char* ws = a.ws;
    for (int it = blockIdx.x * 512 + threadIdx.x; it < 1024 * 128; it += gridDim.x * 512) {
        const int oct = it & 127, cg = it >> 7; const size_t base = (size_t)cg * 64 * D + oct * 8;
        bf16* Q = (bf16*)(ws + WS_QA) + base; bf16* L = (bf16*)(ws + WS_LFA) + base;
        float r[8], bc[8];
#pragma unroll
        for (int j = 0; j < 8; ++j) { r[j] = 0.f; bc[j] = 0.f; }
#pragma unroll 4
        for (int s = 0; s < 32; ++s) { const u32x4 w = *(const u32x4*)(L + (size_t)s * D);
#pragma unroll
            for (int i = 0; i < 4; ++i) { r[2 * i] += h2f(w[i] & 0xffffu); r[2 * i + 1] += h2f(w[i] >> 16); } }
#pragma unroll 2
        for (int s = 0; s < 64; ++s) { const u32x4 wl = *(const u32x4*)(L + (size_t)s * D), wq = *(const u32x4*)(Q + (size_t)s * D); float qt[8], kt[8];
#pragma unroll
            for (int i = 0; i < 4; ++i) {
#pragma unroll
                for (int hh = 0; hh < 2; ++hh) { const int j = 2 * i + hh; const float lf = h2f(hh ? (wl[i] >> 16) : (wl[i] & 0xffffu)), q = bf2f(hh ? (wq[i] >> 16) : (wq[i] & 0xffffu));
                    bc[j] += lf; qt[j] = q * __expf(fminf(bc[j] - r[j], 80.f)); kt[j] = -expm1f(lf) * __expf(fminf(r[j] - bc[j], 80.f)); } }
            store8_bf16(Q + (size_t)s * D, qt); store8_bf16(L + (size_t)s * D, kt); }
        float* em = (float*)(ws + WS_EM) + (size_t)cg * 1024 + oct * 8; float* el = (float*)(ws + WS_EL) + (size_t)cg * 1024 + oct * 8;
        *(f32x4*)em = (f32x4){__expf(r[0]), __expf(r[1]), __expf(r[2]), __expf(r[3])}; *(f32x4*)(em + 4) = (f32x4){__expf(r[4]), __expf(r[5]), __expf(r[6]), __expf(r[7])};
        *(f32x4*)el = (f32x4){__expf(bc[0] - r[0]), __expf(bc[1] - r[1]), __expf(bc[2] - r[2]), __expf(bc[3] - r[3])}; *(f32x4*)(el + 4) = (f32x4){__expf(bc[4] - r[4]), __expf(bc[5] - r[5]), __expf(bc[6] - r[6]), __expf(bc[7] - r[7])};
    }
}
__device__ __forceinline__ void s0_mlstm_conv(const Args& a) {
    unsigned char* ws = a.ws; const float* cw = a.in[7]; const float* cb = a.in[8]; const float* meta = (const float*)(ws + WS_META);
    for (int it = blockIdx.x * 512 + threadIdx.x; it < 1024 * 128; it += gridDim.x * 512) {
        const int oct = it & 127, cg = it >> 7, ch = oct * 8; bf16* X = (bf16*)(ws + WS_QKB) + (size_t)cg * 64 * D + ch;
        float w0[8], w1[8], w2[8], c0[8], c1[8], c2[8], c3[8], bb[8];
#pragma unroll
        for (int j = 0; j < 8; ++j) { c0[j] = cw[ch + j]; c1[j] = cw[1024 + ch + j]; c2[j] = cw[2048 + ch + j]; c3[j] = cw[3072 + ch + j]; bb[j] = cb[ch + j]; }
        if ((cg & 127) == 0) {
#pragma unroll
            for (int j = 0; j < 8; ++j) { w0[j] = meta[3 * 16384 + 13 * 1024 + ch + j]; w1[j] = meta[3 * 16384 + 14 * 1024 + ch + j]; w2[j] = meta[3 * 16384 + 15 * 1024 + ch + j]; }
        } else { const bf16* hp = (const bf16*)(ws + WS_HALO) + (size_t)(cg - 1) * 3 * D + ch; load8_bf16(hp, w0); load8_bf16(hp + D, w1); load8_bf16(hp + 2 * D, w2); }
        const bool isq = ch < 512; const int hh = (ch & 511) >> 7; const f32x4* gates = (const f32x4*)(ws + WS_GATES);
        const float scale = isq ? 0.08838834764831845f : 1.0f;
#pragma unroll 2
        for (int s = 0; s < 64; ++s) { float x[8], y[8]; load8_bf16(X + (size_t)s * D, x);
            const f32x4 gt = gates[((size_t)cg * 64 + s) * 4 + hh]; const float rs_ = scale * (isq ? gt.x : gt.y);
#pragma unroll
            for (int j = 0; j < 8; ++j) { const float t = bb[j] + c0[j] * w0[j] + c1[j] * w1[j] + c2[j] * w2[j] + c3[j] * x[j]; y[j] = siluf_(t) * rs_; w0[j] = w1[j]; w1[j] = w2[j]; w2[j] = x[j]; }
            store8_bf16(X + (size_t)s * D, y); }
    }
}
__device__ __forceinline__ float logsigmoidf_(float x) { return fminf(x, 0.f) - log1pf(__expf(-fabsf(x))); }
__device__ __forceinline__ void s0_mlstm_gates(const Args& a, LAS unsigned char* lds, int b, int h) {
    unsigned char* ws = a.ws; const int tid = threadIdx.x, lane = tid & 63, wave = tid >> 6; const float igb = a.in[9][h], fgb = a.in[10][h];
    const float* meta = (const float*)(ws + WS_META); const float* igfg = (const float*)(ws + WS_IGFG); f32x4* gates = (f32x4*)(ws + WS_GATES);
    LAS float* sum = (LAS float*)lds;
    LAS float* mc = sum + 256;
    float bcv[16], pmv[16], igv[16];
    __syncthreads();
#pragma unroll
    for (int i = 0; i < 16; ++i) {
        const int c = wave * 16 + i; const size_t t = (size_t)b * SEQ + c * 64 + lane;
        const float ig = igfg[t * 8 + h] + igb, lf = logsigmoidf_(igfg[t * 8 + 4 + h] + fgb);
        float bc = lf;
#pragma unroll
        for (int o = 1; o < 64; o <<= 1) { const float u = __shfl_up(bc, o); if (lane >= o) bc += u; }
        float pm = ig - bc;
#pragma unroll
        for (int o = 1; o < 64; o <<= 1) { const float u = __shfl_up(pm, o); if (lane >= o) pm = fmaxf(pm, u); }
        bcv[i] = bc; pmv[i] = pm; igv[i] = ig;
        if (lane == 63) { sum[2 * c] = bc; sum[2 * c + 1] = pm; }
    }
    __syncthreads();
    if (tid == 0) { float Mc = 0.f;
        for (int s = 0; s < 16; ++s) { const float ig = meta[5 * 16384 + s * 8 + h] + igb, lf = logsigmoidf_(meta[5 * 16384 + s * 8 + 4 + h] + fgb); Mc = fmaxf(lf + Mc, ig); }
        for (int c = 0; c < 128; ++c) { mc[c] = Mc; Mc = sum[2 * c] + fmaxf(Mc, sum[2 * c + 1]); } }
    __syncthreads();
#pragma unroll
    for (int i = 0; i < 16; ++i) { const int c = wave * 16 + i; const size_t t = (size_t)b * SEQ + c * 64 + lane;
        const float Mt = bcv[i] + fmaxf(mc[c], pmv[i]), bL = __shfl(bcv[i], 63), ML = __shfl(Mt, 63);
        gates[t * 4 + h] = (f32x4){__expf(bcv[i] - Mt - bL + ML), __expf(igv[i] - bcv[i] + bL - ML), __expf(-Mt), __expf(bL + mc[c] - ML)}; }
    __syncthreads();
}
__device__ __forceinline__ void s0_prepass(const Args& a, LAS unsigned char* lds) {
    s0_hgrn_prep(a);
    s0_mlstm_conv(a);
    for (int u = blockIdx.x; u < 12; u += gridDim.x) {
        if (u < 8) scan_hgrn(a, lds, 0, u, true);
        else scan_mlstm(a, lds, 0, u - 8, true); }
}

typedef short v4i16_t __attribute__((ext_vector_type(4)));
typedef short bf16x8_t __attribute__((ext_vector_type(8)));
__device__ __forceinline__ v4i16_t tr16(LAS unsigned char* p) { return __builtin_amdgcn_ds_read_tr16_b64_v4i16((LAS v4i16_t*)p); }
__device__ __forceinline__ bf16x8_t cat44(v4i16_t a, v4i16_t b) { return (bf16x8_t){a[0], a[1], a[2], a[3], b[0], b[1], b[2], b[3]}; }
__device__ __forceinline__ bf16x8_t pack8(f32x4 a, f32x4 b) { const u32x4 w = {pk2(a.x, a.y), pk2(a.z, a.w), pk2(b.x, b.y), pk2(b.z, b.w)}; return __builtin_bit_cast(bf16x8_t, w); }
__device__ __forceinline__ bf16x8_t cat22(u32x2 a, u32x2 b) { const u32x4 w = {a.x, a.y, b.x, b.y}; return __builtin_bit_cast(bf16x8_t, w); }
constexpr int SC_QT = 0, SC_KT = 17408, SC_VT = 34816, SC_PT = 44032, SC_EM = 53248, SC_EL = 53760, SC_QS = 272, SC_VS = 144;

constexpr int S3_SET = 45056, S3_P = 90112, S3_ST = 99328;
__device__ __forceinline__ void fscan3_hgrn(const Args& a, LAS unsigned char* lds, int b, int h, int vh) {
    unsigned char* ws = a.ws; const int tid = threadIdx.x, lane = tid & 63, w = tid >> 6, fr = lane & 15, g = lane >> 4, q4 = fr >> 2, p4 = fr & 3;
    const bf16* QA = (const bf16*)(ws + WS_QA); const bf16* KA = (const bf16*)(ws + WS_LFA); bf16* IA = (bf16*)(ws + WS_IA);
    const float* EMg = (const float*)(ws + WS_EM); const float* ELg = (const float*)(ws + WS_EL);
    const int vt = w & 3, th = w >> 2, tt = w & 3, sh = w >> 2;
    f32x4 S[8];
    { const float* sm = (const float*)(ws + WS_SMETA) + (size_t)h * 128 * 128 + vh * 64 + vt * 16 + fr;
#pragma unroll
      for (int kt = 0; kt < 8; ++kt)
#pragma unroll
          for (int r = 0; r < 4; ++r) S[kt][r] = sm[(16 * kt + 4 * g + r) * 128]; }
    const int r0 = tid >> 4, c0 = tid & 15, rv = tid >> 3, cv = tid & 7;
    u32x4 pq0, pq1, pk0, pk1, pv; f32x4 pe;
#define HG_FETCH(c) do { const size_t t0 = (size_t)b * SEQ + (size_t)(c) * 64; \
        pq0 = *(const u32x4*)(QA + (t0 + r0) * D + h * 128 + c0 * 8); pq1 = *(const u32x4*)(QA + (t0 + r0 + 32) * D + h * 128 + c0 * 8); \
        pk0 = *(const u32x4*)(KA + (t0 + r0) * D + h * 128 + c0 * 8); pk1 = *(const u32x4*)(KA + (t0 + r0 + 32) * D + h * 128 + c0 * 8); \
        pv = *(const u32x4*)(IA + (t0 + rv) * D + h * 128 + vh * 64 + cv * 8); \
        if (tid < 64) { const size_t cgi = ((size_t)b * 128 + (c)) * 1024 + h * 128; pe = *(const f32x4*)((tid < 32 ? EMg : ELg) + cgi + (tid & 31) * 4); } } while (0)
#define HG_COMMIT(sb) do { LAS unsigned char* B_ = lds + (sb); *(LAS u32x4*)(B_ + r0 * SC_QS + c0 * 16) = pq0; *(LAS u32x4*)(B_ + (r0 + 32) * SC_QS + c0 * 16) = pq1; \
        *(LAS u32x4*)(B_ + 17408 + r0 * SC_QS + c0 * 16) = pk0; *(LAS u32x4*)(B_ + 17408 + (r0 + 32) * SC_QS + c0 * 16) = pk1; \
        *(LAS u32x4*)(B_ + 34816 + rv * SC_VS + cv * 16) = pv; \
        if (tid < 64) *(LAS f32x4*)(B_ + (tid < 32 ? 44032 : 44544) + (tid & 31) * 16) = pe; } while (0)
    __syncthreads();
    HG_FETCH(0); HG_COMMIT(0);
    __syncthreads();
    for (int c = 0; c < SEQ / 64; ++c) {
        const int sb = (c & 1) * S3_SET;
        LAS unsigned char* Q_ = lds + sb; LAS unsigned char* K_ = Q_ + 17408; LAS unsigned char* V_ = Q_ + 34816; LAS unsigned char* P_ = lds + S3_P;
        if (c + 1 < SEQ / 64) HG_FETCH(c + 1);
        {
            bf16x8_t bq[4];
#pragma unroll
            for (int ks = 0; ks < 4; ++ks) bq[ks] = *(const LAS bf16x8_t*)(Q_ + (tt * 16 + fr) * SC_QS + ks * 64 + g * 16);
#pragma unroll
            for (int si = 0; si < 2; ++si) { const int st = 2 * sh + si; f32x4 acc = {0.f, 0.f, 0.f, 0.f};
#pragma unroll
                for (int ks = 0; ks < 4; ++ks) { const bf16x8_t ak = *(const LAS bf16x8_t*)(K_ + (st * 16 + fr) * SC_QS + ks * 64 + g * 16); acc = __builtin_amdgcn_mfma_f32_16x16x32_bf16(ak, bq[ks], acc, 0, 0, 0); }
                const int t = tt * 16 + fr, s0 = st * 16 + 4 * g; u32x2 pw;
                pw.x = pk2(s0 + 0 <= t ? acc[0] : 0.f, s0 + 1 <= t ? acc[1] : 0.f); pw.y = pk2(s0 + 2 <= t ? acc[2] : 0.f, s0 + 3 <= t ? acc[3] : 0.f);
                *(LAS u32x2*)(P_ + t * SC_VS + s0 * 2) = pw; }
        }
        __syncthreads();
        {
            bf16x8_t afr[4], vfr[2];
#pragma unroll
            for (int kt = 0; kt < 8; ++kt) S[kt] = S[kt] * *(const LAS f32x4*)(Q_ + 44032 + (16 * kt + 4 * g) * 4);
#pragma unroll
            for (int ks = 0; ks < 4; ++ks) afr[ks] = pack8(S[2 * ks], S[2 * ks + 1]);
#pragma unroll
            for (int k2 = 0; k2 < 2; ++k2) { LAS unsigned char* pa = V_ + (32 * k2 + 8 * g + q4) * SC_VS + (vt * 16 + 4 * p4) * 2; vfr[k2] = cat44(tr16(pa), tr16(pa + 4 * SC_VS)); }
            const size_t t0 = (size_t)b * SEQ + (size_t)c * 64;
#pragma unroll
            for (int ti = 0; ti < 2; ++ti) { const int t = (2 * th + ti) * 16 + fr; f32x4 acc = {0.f, 0.f, 0.f, 0.f};
#pragma unroll
                for (int ks = 0; ks < 4; ++ks) { const u32x2 lo = *(const LAS u32x2*)(Q_ + t * SC_QS + (32 * ks + 4 * g) * 2), hi = *(const LAS u32x2*)(Q_ + t * SC_QS + (32 * ks + 16 + 4 * g) * 2);
                    acc = __builtin_amdgcn_mfma_f32_16x16x32_bf16(afr[ks], cat22(lo, hi), acc, 0, 0, 0); }
#pragma unroll
                for (int k2 = 0; k2 < 2; ++k2) { const bf16x8_t pf = *(const LAS bf16x8_t*)(P_ + t * SC_VS + (32 * k2 + 8 * g) * 2); acc = __builtin_amdgcn_mfma_f32_16x16x32_bf16(vfr[k2], pf, acc, 0, 0, 0); }
                u32x2 ow; ow.x = pk2(acc[0], acc[1]); ow.y = pk2(acc[2], acc[3]);
                *(u32x2*)(IA + (t0 + t) * D + h * 128 + vh * 64 + vt * 16 + 4 * g) = ow;
                float sq = (acc[0] * acc[0] + acc[1] * acc[1]) + (acc[2] * acc[2] + acc[3] * acc[3]); sq += __shfl_xor(sq, 16); sq += __shfl_xor(sq, 32);
                if (g == 0) *(LAS float*)(lds + S3_ST + (vt * 64 + t) * 4) = sq; }
#pragma unroll
            for (int kt = 0; kt < 8; ++kt) {
#pragma unroll
                for (int k2 = 0; k2 < 2; ++k2) { LAS unsigned char* pa = K_ + (32 * k2 + 8 * g + q4) * SC_QS + (16 * kt + 4 * p4) * 2; const bf16x8_t ak = cat44(tr16(pa), tr16(pa + 4 * SC_QS));
                    S[kt] = __builtin_amdgcn_mfma_f32_16x16x32_bf16(ak, vfr[k2], S[kt], 0, 0, 0); }
                S[kt] = S[kt] * *(const LAS f32x4*)(Q_ + 44544 + (16 * kt + 4 * g) * 4); }
        }
        if (c + 1 < SEQ / 64) HG_COMMIT(S3_SET - sb);
        __syncthreads();
        if (tid < 64) { const LAS float* sp = (const LAS float*)(lds + S3_ST) + tid;
            ((float*)(ws + WS_STA2))[((size_t)b * SEQ + (size_t)c * 64 + tid) * 16 + h * 2 + vh] = (sp[0] + sp[64]) + (sp[128] + sp[192]); }
    }
#undef HG_FETCH
#undef HG_COMMIT
}
__device__ __forceinline__ void fscan3_mlstm(const Args& a, LAS unsigned char* lds, int b, int h, int vq) {
    unsigned char* ws = a.ws; const int tid = threadIdx.x, lane = tid & 63, w = tid >> 6, fr = lane & 15, g = lane >> 4, q4 = fr >> 2, p4 = fr & 3;
    const bf16* QK = (const bf16*)(ws + WS_QKB); bf16* VB = (bf16*)(ws + WS_VB); const f32x4* GT = (const f32x4*)(ws + WS_GATES);
    const int vt = w & 3, th = w >> 2, tt = w & 3, sh = w >> 2;
    f32x4 S[8], N[8];
    { const float* cm = (const float*)(ws + WS_CMETA) + (size_t)h * 128 * 256 + vq * 64 + vt * 16 + fr; const float* nm = (const float*)(ws + WS_NMETA) + h * 128;
#pragma unroll
      for (int kt = 0; kt < 8; ++kt)
#pragma unroll
          for (int r = 0; r < 4; ++r) { S[kt][r] = cm[(16 * kt + 4 * g + r) * 256]; N[kt][r] = nm[16 * kt + 4 * g + r]; } }
    const u32x4 onew = {0x3F803F80u, 0x3F803F80u, 0x3F803F80u, 0x3F803F80u}; const bf16x8_t ones = __builtin_bit_cast(bf16x8_t, onew);
    const int r0 = tid >> 4, c0 = tid & 15, rv = tid >> 3, cv = tid & 7;
    u32x4 pq0, pq1, pk0, pk1, pv; f32x4 pe;
#define ML_FETCH(c) do { const size_t t0 = (size_t)b * SEQ + (size_t)(c) * 64; \
        pq0 = *(const u32x4*)(QK + (t0 + r0) * D + h * 128 + c0 * 8); pq1 = *(const u32x4*)(QK + (t0 + r0 + 32) * D + h * 128 + c0 * 8); \
        pk0 = *(const u32x4*)(QK + (t0 + r0) * D + 512 + h * 128 + c0 * 8); pk1 = *(const u32x4*)(QK + (t0 + r0 + 32) * D + 512 + h * 128 + c0 * 8); \
        pv = *(const u32x4*)(VB + (t0 + rv) * D + h * 256 + vq * 64 + cv * 8); \
        if (tid < 64) pe = GT[(t0 + tid) * 4 + h]; } while (0)
#define ML_COMMIT(sb) do { LAS unsigned char* B_ = lds + (sb); *(LAS u32x4*)(B_ + r0 * SC_QS + c0 * 16) = pq0; *(LAS u32x4*)(B_ + (r0 + 32) * SC_QS + c0 * 16) = pq1; \
        *(LAS u32x4*)(B_ + 17408 + r0 * SC_QS + c0 * 16) = pk0; *(LAS u32x4*)(B_ + 17408 + (r0 + 32) * SC_QS + c0 * 16) = pk1; \
        *(LAS u32x4*)(B_ + 34816 + rv * SC_VS + cv * 16) = pv; \
        if (tid < 64) *(LAS f32x4*)(B_ + 44032 + tid * 16) = pe; } while (0)
    __syncthreads();
    ML_FETCH(0); ML_COMMIT(0);
    __syncthreads();
    for (int c = 0; c < SEQ / 64; ++c) {
        const int sb = (c & 1) * S3_SET;
        LAS unsigned char* Q_ = lds + sb; LAS unsigned char* K_ = Q_ + 17408; LAS unsigned char* V_ = Q_ + 34816; LAS unsigned char* G_ = Q_ + 44032; LAS unsigned char* P_ = lds + S3_P;
        if (c + 1 < SEQ / 64) ML_FETCH(c + 1);
        const float decay = (*(const LAS f32x4*)G_).w;
        {
            bf16x8_t bq[4];
#pragma unroll
            for (int ks = 0; ks < 4; ++ks) bq[ks] = *(const LAS bf16x8_t*)(Q_ + (tt * 16 + fr) * SC_QS + ks * 64 + g * 16);
#pragma unroll
            for (int si = 0; si < 2; ++si) { const int st = 2 * sh + si; f32x4 acc = {0.f, 0.f, 0.f, 0.f};
#pragma unroll
                for (int ks = 0; ks < 4; ++ks) { const bf16x8_t ak = *(const LAS bf16x8_t*)(K_ + (st * 16 + fr) * SC_QS + ks * 64 + g * 16); acc = __builtin_amdgcn_mfma_f32_16x16x32_bf16(ak, bq[ks], acc, 0, 0, 0); }
                const int t = tt * 16 + fr, s0 = st * 16 + 4 * g; u32x2 pw;
                pw.x = pk2(s0 + 0 <= t ? acc[0] : 0.f, s0 + 1 <= t ? acc[1] : 0.f); pw.y = pk2(s0 + 2 <= t ? acc[2] : 0.f, s0 + 3 <= t ? acc[3] : 0.f);
                *(LAS u32x2*)(P_ + t * SC_VS + s0 * 2) = pw; }
        }
        __syncthreads();
        {
            bf16x8_t vfr[2];
#pragma unroll
            for (int kt = 0; kt < 8; ++kt) { S[kt] = S[kt] * decay; N[kt] = N[kt] * decay; }
#pragma unroll
            for (int k2 = 0; k2 < 2; ++k2) { LAS unsigned char* pa = V_ + (32 * k2 + 8 * g + q4) * SC_VS + (vt * 16 + 4 * p4) * 2; vfr[k2] = cat44(tr16(pa), tr16(pa + 4 * SC_VS)); }
            const size_t t0 = (size_t)b * SEQ + (size_t)c * 64;
#pragma unroll 1
            for (int ti = 0; ti < 2; ++ti) { const int t = (2 * th + ti) * 16 + fr; f32x4 acc = {0.f, 0.f, 0.f, 0.f}, accd = {0.f, 0.f, 0.f, 0.f};
#pragma unroll
                for (int ks = 0; ks < 4; ++ks) { const bf16x8_t af = pack8(S[2 * ks], S[2 * ks + 1]), an = pack8(N[2 * ks], N[2 * ks + 1]);
                    const u32x2 lo = *(const LAS u32x2*)(Q_ + t * SC_QS + (32 * ks + 4 * g) * 2), hi = *(const LAS u32x2*)(Q_ + t * SC_QS + (32 * ks + 16 + 4 * g) * 2); const bf16x8_t qf = cat22(lo, hi);
                    acc = __builtin_amdgcn_mfma_f32_16x16x32_bf16(af, qf, acc, 0, 0, 0); accd = __builtin_amdgcn_mfma_f32_16x16x32_bf16(an, qf, accd, 0, 0, 0); }
#pragma unroll
                for (int k2 = 0; k2 < 2; ++k2) { const bf16x8_t pf = *(const LAS bf16x8_t*)(P_ + t * SC_VS + (32 * k2 + 8 * g) * 2);
                    acc = __builtin_amdgcn_mfma_f32_16x16x32_bf16(vfr[k2], pf, acc, 0, 0, 0); accd = __builtin_amdgcn_mfma_f32_16x16x32_bf16(ones, pf, accd, 0, 0, 0); }
                const float inv = __builtin_amdgcn_rcpf(fmaxf(fabsf(accd[0]), (*(const LAS f32x4*)(G_ + t * 16)).z));
                const float h0_ = acc[0] * inv, h1_ = acc[1] * inv, h2_ = acc[2] * inv, h3_ = acc[3] * inv;
                u32x2 ow; ow.x = pk2(h0_, h1_); ow.y = pk2(h2_, h3_);
                *(u32x2*)(VB + (t0 + t) * D + h * 256 + vq * 64 + vt * 16 + 4 * g) = ow;
                float s1 = (h0_ + h1_) + (h2_ + h3_), s2 = (h0_ * h0_ + h1_ * h1_) + (h2_ * h2_ + h3_ * h3_);
                s1 += __shfl_xor(s1, 16); s1 += __shfl_xor(s1, 32); s2 += __shfl_xor(s2, 16); s2 += __shfl_xor(s2, 32);
                if (g == 0) { *(LAS float*)(lds + S3_ST + (vt * 64 + t) * 4) = s1; *(LAS float*)(lds + S3_ST + 1024 + (vt * 64 + t) * 4) = s2; } }
#pragma unroll
            for (int kt = 0; kt < 8; ++kt) {
#pragma unroll
                for (int k2 = 0; k2 < 2; ++k2) { LAS unsigned char* pa = K_ + (32 * k2 + 8 * g + q4) * SC_QS + (16 * kt + 4 * p4) * 2; const bf16x8_t ak = cat44(tr16(pa), tr16(pa + 4 * SC_QS));
                    S[kt] = __builtin_amdgcn_mfma_f32_16x16x32_bf16(ak, vfr[k2], S[kt], 0, 0, 0); N[kt] = __builtin_amdgcn_mfma_f32_16x16x32_bf16(ak, ones, N[kt], 0, 0, 0); } }
        }
        if (c + 1 < SEQ / 64) ML_COMMIT(S3_SET - sb);
        __syncthreads();
        if (tid < 128) { const int tk = tid & 63, wh = tid >> 6; const LAS float* sp = (const LAS float*)(lds + S3_ST + wh * 1024) + tk;
            ((float*)(ws + WS_STB2))[(((size_t)b * SEQ + (size_t)c * 64 + tk) * 16 + h * 4 + vq) * 2 + wh] = (sp[0] + sp[64]) + (sp[128] + sp[192]); }
    }
#undef ML_FETCH
#undef ML_COMMIT
}

__device__ __forceinline__ void p_ln1_route(const Args& a, LAS unsigned char* lds) {
    unsigned char* ws = a.ws; const int tid = threadIdx.x, lane = tid & 63, wave = tid >> 6, fr = lane & 15, g = lane >> 4;
    LAS int* hist = (LAS int*)lds; LAS float* rbs = (LAS float*)(lds + 256);
    LAS unsigned char* hw = lds + 1024 + wave * 17408;
    LAS float* st = (LAS float*)(lds + 1024 + 8 * 17408 + wave * 256);
    const bf16* z = (const bf16*)(ws + WS_Z); const bf16* WT = (const bf16*)(ws + WS_WRT);
    bf16* h1 = (bf16*)(ws + WS_H0); float* lnst = (float*)(ws + WS_LNST1);
    int* eidx = (int*)(ws + WS_EIDX); float* gwp = (float*)(ws + WS_GW); int* lpos = (int*)(ws + WS_LPOS); int* wgbase = (int*)(ws + WS_WGBASE);
    unsigned* gcnt = (unsigned*)(ws + WS_CTL) + CW_GCNT;
    for (int tile = blockIdx.x; tile < T / 256; tile += gridDim.x) {
        const int half = tile / (T / 512), m0 = tile * 256 + wave * 32;
        __syncthreads();
        if (tid < 64) { hist[tid] = 0; rbs[tid] = a.in[18][tid]; }
        __syncthreads();
        {
            const f32x4* gp = (const f32x4*)a.in[15] + lane; const f32x4* bp = (const f32x4*)a.in[16] + lane;
            f32x4 gg[4], bb[4]; u32x2 zn[4];
#pragma unroll
            for (int j = 0; j < 4; ++j) { gg[j] = gp[64 * j]; bb[j] = bp[64 * j]; zn[j] = ((const u32x2*)(z + (size_t)m0 * D) + lane)[64 * j]; }
            for (int rr = 0; rr < 32; ++rr) {
                const int m = m0 + rr; f32x4 v[4]; float s = 0.f;
#pragma unroll
                for (int j = 0; j < 4; ++j) { const u32x2 zw = zn[j]; v[j] = (f32x4){bf2f(zw.x & 0xffffu), bf2f(zw.x >> 16), bf2f(zw.y & 0xffffu), bf2f(zw.y >> 16)}; s += (v[j].x + v[j].y) + (v[j].z + v[j].w); }
                if (rr + 1 < 32) {
#pragma unroll
                    for (int j = 0; j < 4; ++j) zn[j] = ((const u32x2*)(z + (size_t)(m + 1) * D) + lane)[64 * j]; }
                const float mean = wave_sum(s) * (1.f / D); float s2 = 0.f;
#pragma unroll
                for (int j = 0; j < 4; ++j) { v[j] = v[j] - mean; s2 += (v[j].x * v[j].x + v[j].y * v[j].y) + (v[j].z * v[j].z + v[j].w * v[j].w); }
                const float rstd = 1.f / sqrtf(wave_sum(s2) * (1.f / D) + EPS);
                unsigned long long* o8 = (unsigned long long*)(h1 + (size_t)m * D) + lane;
#pragma unroll
                for (int j = 0; j < 4; ++j) { const f32x4 h = v[j] * rstd * gg[j] + bb[j]; o8[64 * j] = (unsigned long long)pk2(h.x, h.y) | ((unsigned long long)pk2(h.z, h.w) << 32); }
                if (lane == 0) { lnst[2 * m] = mean; lnst[2 * m + 1] = rstd; st[2 * rr] = mean; st[2 * rr + 1] = rstd; }
            }
        }
        asm volatile("s_waitcnt lgkmcnt(0)" ::: "memory");
        f32x4 acc[2][4];
#pragma unroll
        for (int mt = 0; mt < 2; ++mt)
#pragma unroll
            for (int n = 0; n < 4; ++n) acc[mt][n] = (f32x4){0.f, 0.f, 0.f, 0.f};
        for (int kc = 0; kc < 8; ++kc) {
            { const int kk = (lane & 31) * 4; const f32x4 g4 = *(const f32x4*)(a.in[15] + kc * 128 + kk), b4 = *(const f32x4*)(a.in[16] + kc * 128 + kk);
#pragma unroll 4
              for (int i = 0; i < 16; ++i) { const int row = 2 * i + (lane >> 5); const u32x2 zw = *(const u32x2*)(z + (size_t)(m0 + row) * D + kc * 128 + kk);
                  const f32x4 z4 = {bf2f(zw.x & 0xffffu), bf2f(zw.x >> 16), bf2f(zw.y & 0xffffu), bf2f(zw.y >> 16)};
                  const float mean = st[2 * row], rstd = st[2 * row + 1]; const f32x4 h = (z4 - mean) * rstd * g4 + b4;
                  u32x2 hi; hi.x = pk2(h.x, h.y); hi.y = pk2(h.z, h.w);
                  const f32x4 hr = {bf2f(hi.x & 0xffffu), bf2f(hi.x >> 16), bf2f(hi.y & 0xffffu), bf2f(hi.y >> 16)}; const f32x4 l4 = h - hr;
                  u32x2 lo; lo.x = pk2(l4.x, l4.y); lo.y = pk2(l4.z, l4.w);
                  *(LAS u32x2*)(hw + row * 272 + kk * 2) = hi; *(LAS u32x2*)(hw + 8704 + row * 272 + kk * 2) = lo; } }
            asm volatile("s_waitcnt lgkmcnt(0)" ::: "memory");
#pragma unroll
            for (int ks = 0; ks < 4; ++ks) {
                bf16x8_t ah[2], al[2];
#pragma unroll
                for (int mt = 0; mt < 2; ++mt) { ah[mt] = *(const LAS bf16x8_t*)(hw + (16 * mt + fr) * 272 + ks * 64 + g * 16); al[mt] = *(const LAS bf16x8_t*)(hw + 8704 + (16 * mt + fr) * 272 + ks * 64 + g * 16); }
#pragma unroll
                for (int n = 0; n < 4; ++n) { const bf16* wp = WT + (size_t)(16 * n + fr) * 1024 + kc * 128 + ks * 32 + g * 8;
                    const bf16x8_t bh = *(const bf16x8_t*)wp, bl = *(const bf16x8_t*)(wp + 65536);
#pragma unroll
                    for (int mt = 0; mt < 2; ++mt) { acc[mt][n] = __builtin_amdgcn_mfma_f32_16x16x32_bf16(ah[mt], bh, acc[mt][n], 0, 0, 0);
                        acc[mt][n] = __builtin_amdgcn_mfma_f32_16x16x32_bf16(al[mt], bh, acc[mt][n], 0, 0, 0); acc[mt][n] = __builtin_amdgcn_mfma_f32_16x16x32_bf16(ah[mt], bl, acc[mt][n], 0, 0, 0); } }
            }
            asm volatile("s_waitcnt lgkmcnt(0)" ::: "memory");
        }
        { LAS float* lg = (LAS float*)hw;
#pragma unroll
          for (int mt = 0; mt < 2; ++mt)
#pragma unroll
              for (int n = 0; n < 4; ++n)
#pragma unroll
                  for (int r = 0; r < 4; ++r) lg[(16 * mt + 4 * g + r) * 65 + 16 * n + fr] = acc[mt][n][r]; }
        asm volatile("s_waitcnt lgkmcnt(0)" ::: "memory");
        if (lane < 32) {
            const LAS float* lg = (const LAS float*)hw + lane * 65; const int m = m0 + lane;
            float bsc[64];
#pragma unroll
            for (int e2 = 0; e2 < 64; ++e2) bsc[e2] = 1.0f / (1.0f + expf(-lg[e2])) + rbs[e2];
            float gs[8];
#pragma unroll
            for (int gi = 0; gi < 8; ++gi) { float m1 = -INFINITY, m2 = -INFINITY;
#pragma unroll
                for (int j = 0; j < 8; ++j) { const float v = bsc[8 * gi + j]; m2 = fmaxf(m2, fminf(m1, v)); m1 = fmaxf(m1, v); }
                gs[gi] = m1 + m2; }
            unsigned selmask = 0;
#pragma unroll
            for (int gi = 0; gi < 8; ++gi) { int rank = 0;
#pragma unroll
                for (int gj = 0; gj < 8; ++gj) rank += (gs[gj] > gs[gi] || (gs[gj] == gs[gi] && gj < gi)) ? 1 : 0;
                selmask |= (rank < 4) ? (1u << gi) : 0u; }
            float tv[8]; int te[8];
#pragma unroll
            for (int i = 0; i < 8; ++i) { tv[i] = -INFINITY; te[i] = 0; }
#pragma unroll
            for (int e2 = 0; e2 < 64; ++e2) { float v = ((selmask >> (e2 >> 3)) & 1u) ? bsc[e2] : -INFINITY; int id = e2;
#pragma unroll
                for (int i = 0; i < 8; ++i) { const bool sw = v > tv[i]; const float tvv = tv[i]; const int tee = te[i]; tv[i] = sw ? v : tvv; te[i] = sw ? id : tee; v = sw ? tvv : v; id = sw ? tee : id; } }
            float sc[8], ssum = 0.f;
#pragma unroll
            for (int i = 0; i < 8; ++i) { sc[i] = tv[i] - rbs[te[i]]; ssum += sc[i]; }
            const float scale = ROUTED_SCALE / ssum;
#pragma unroll
            for (int i = 0; i < 8; ++i) { eidx[(size_t)m * 8 + i] = te[i]; gwp[(size_t)m * 8 + i] = sc[i] * scale; lpos[(size_t)m * 8 + i] = atomicAdd((int*)&hist[te[i]], 1); }
        }
        __syncthreads();
        if (tid < 64) wgbase[tile * 64 + tid] = (int)atomicAdd(&gcnt[half * 64 + tid], (unsigned)hist[tid]);
    }
}
__device__ __forceinline__ void load_pstart(const Args& a, LAS int* ps) {
    const unsigned* gcnt = (const unsigned*)(a.ws + WS_CTL) + CW_GCNT;
    __syncthreads();
    if (threadIdx.x < 2) { const int hf = threadIdx.x; int acc = 0;
        for (int e = 0; e < 64; ++e) { ps[hf * 65 + e] = acc; const int c = (int)__hip_atomic_load(gcnt + hf * 64 + e, __ATOMIC_RELAXED, __HIP_MEMORY_SCOPE_AGENT); acc += (c + 255) / 256 * 256; }
        ps[hf * 65 + 64] = acc; }
    __syncthreads();
}
__device__ __forceinline__ void p_slots(const Args& a, LAS unsigned char* lds) {
    unsigned char* ws = a.ws; LAS int* ps = (LAS int*)lds; load_pstart(a, ps);
    const int* eidx = (const int*)(ws + WS_EIDX); const float* gwp = (const float*)(ws + WS_GW); const int* lpos = (const int*)(ws + WS_LPOS); const int* wgbase = (const int*)(ws + WS_WGBASE);
    int* slotof = (int*)(ws + WS_SLOTOF); int* tokslot = (int*)(ws + WS_TOKSLOT); float* wslot = (float*)(ws + WS_WSLOT);
    for (int tile = blockIdx.x; tile < T / 256; tile += gridDim.x) {
        const int half = tile / (T / 512);
        for (int i = threadIdx.x; i < 256 * 8; i += 512) { const size_t idx = (size_t)tile * 2048 + i; const int e = eidx[idx];
            const int slot = ps[half * 65 + e] + wgbase[tile * 64 + e] + lpos[idx];
            slotof[idx] = slot; tokslot[(size_t)half * NSLOTMAX + slot] = (int)(idx >> 3); wslot[(size_t)half * NSLOTMAX + slot] = gwp[idx]; }
    }
}
template <bool DOWN>
__device__ __forceinline__ void f_moe_gemm(const Args& a, LAS unsigned char* lds, int half) {
    unsigned char* ws = a.ws; LAS int* ps = (LAS int*)(lds + 131072); LAS int* te = (LAS int*)(lds + 131072 + 1024); load_pstart(a, ps);
    const int nrt = __builtin_amdgcn_readfirstlane(ps[half * 65 + 64] / 256);
    for (int rt = threadIdx.x; rt < nrt; rt += 512) { int e = 0; for (int j = 1; j < 64; ++j) if (ps[half * 65 + j] <= rt * 256) e = j; te[rt] = e; }
    __syncthreads();
    pg8::GroupedOrder S; S.te = te; S.nct = DOWN ? 4 : 2; S.nrt = nrt; S.nwg1 = nrt * S.nct; S.nwg2 = (HALF_T / 256) * S.nct; S.G = gridDim.x; S.c = blockIdx.x;
    S.idx = (const int*)(ws + WS_TOKSLOT) + (size_t)half * NSLOTMAX; S.ident = (const int*)(ws + WS_IDENT) + half * HALF_T;
    if (!DOWN) { S.K = 1024; S.A = (const char*)(ws + WS_H0); S.Bt = (const char*)(ws + WS_WGU); S.Bsh = (const char*)(ws + WS_WSGU); S.estride = (size_t)512 * 1024 * 2; S.gather = true;
        pg8::gemm_phase<true, false>(lds, 1024, S, EpiGU{(bf16*)(ws + WS_HH)}); }
    else { S.K = 256; S.A = (const char*)(ws + WS_HH); S.Bt = (const char*)(ws + WS_WD); S.Bsh = (const char*)(ws + WS_WSD); S.estride = (size_t)1024 * 256 * 2; S.gather = false;
        pg8::gemm_phase2<false, false>(lds, 256, S, EpiDown{(unsigned char*)(ws + WS_YH), (const float*)(ws + WS_WSLOT) + (size_t)half * NSLOTMAX}, EpiSD2{ws, a.out, a.in[15], a.in[16], half * HALF_T}); }
}
__device__ __forceinline__ void p_combine(const Args& a, int half) {
    unsigned char* ws = a.ws; const int lane = threadIdx.x & 63, gw = blockIdx.x * 8 + (threadIdx.x >> 6), NGW = gridDim.x * 8;
    const unsigned char* Y = (const unsigned char*)(ws + WS_YH); const int* slotof = (const int*)(ws + WS_SLOTOF);
    const f32x4* gp = (const f32x4*)a.in[25] + lane; const f32x4* bp = (const f32x4*)a.in[26] + lane;
    for (int mm = gw; mm < HALF_T; mm += NGW) {
        const int m = half * HALF_T + mm;
        f32x4* rr = (f32x4*)(a.out + (size_t)m * D) + lane; const u32x2* rb16 = (const u32x2*)((const bf16*)(ws + WS_H0) + (size_t)m * D) + lane;
        f32x4 v[4];
#pragma unroll
        for (int j = 0; j < 4; ++j) { const u32x2 rw = rb16[64 * j]; v[j] = (f32x4){bf2f(rw.x & 0xffffu), bf2f(rw.x >> 16), bf2f(rw.y & 0xffffu), bf2f(rw.y >> 16)}; }
        f32x4 ys[4];
#pragma unroll
        for (int j = 0; j < 4; ++j) ys[j] = (f32x4){0.f, 0.f, 0.f, 0.f};
        int sl[8];
#pragma unroll
        for (int k = 0; k < 8; ++k) sl[k] = slotof[(size_t)m * 8 + k];
#pragma unroll
        for (int k = 0; k < 8; ++k) { const unsigned* yr = (const unsigned*)(Y + (size_t)sl[k] * D) + lane;
#pragma unroll
            for (int j = 0; j < 4; ++j) { const int w = (int)yr[64 * j]; const f32x2_t lo = __builtin_amdgcn_cvt_pk_f32_fp8(w, false), hi = __builtin_amdgcn_cvt_pk_f32_fp8(w, true);
                ys[j].x += lo.x; ys[j].y += lo.y; ys[j].z += hi.x; ys[j].w += hi.y; } }
#pragma unroll
        for (int j = 0; j < 4; ++j) v[j] = v[j] + ys[j] * 0.03125f;
        float s = 0.f;
#pragma unroll
        for (int j = 0; j < 4; ++j) s += (v[j].x + v[j].y) + (v[j].z + v[j].w);
        const float mean = wave_sum(s) * (1.f / D); float s2 = 0.f;
#pragma unroll
        for (int j = 0; j < 4; ++j) { v[j] = v[j] - mean; s2 += (v[j].x * v[j].x + v[j].y * v[j].y) + (v[j].z * v[j].z + v[j].w * v[j].w); }
        const float rstd = 1.f / sqrtf(wave_sum(s2) * (1.f / D) + EPS);
#pragma unroll
        for (int j = 0; j < 4; ++j) rr[64 * j] = v[j] * rstd * gp[64 * j] + bp[64 * j];
    }
}

__global__ void __launch_bounds__(512, 2) fwd(Args a) {
    extern __shared__ __attribute__((aligned(16))) unsigned char lds_raw[];
    LAS unsigned char* lds = (LAS unsigned char*)lds_raw;
    unsigned char* ws = a.ws;
    const int lo = a.ph_lo, hi = a.ph_hi;
    volatile LAS unsigned* bst = (volatile LAS unsigned*)(lds + LDS_BYTES - 16);
    if (threadIdx.x == 0) { bst[0] = 0u; bst[1] = 0u; }
    __syncthreads();
    XcdBarrier bar = xcd_barrier_post((unsigned*)(ws + WS_CTL) + CW_BAR, bst);
#ifndef PH_MASK
#define PH_MASK 0xFFFFFFFFu
#endif
#define IN(k) ((((PH_MASK) >> (k)) & 1u) && lo <= (k) && (k) < hi)
#define SEAM(k) do { if (IN(k) && IN((k) + 1)) xcd_barrier(bar); } while (0)
    if (IN(0)) p0_prologue(a, lds);
    SEAM(0);
    if (IN(1)) { for (int u = blockIdx.x; u < 32; u += gridDim.x) s0_mlstm_gates(a, lds, u >> 2, u & 3); }
    if (IN(1)) fgemm_dense(lds, (const bf16*)(ws + WS_H0), (const bf16*)(ws + WS_WINT), T, 7168, 1024, EpiA{ws, (unsigned char*)a.out, a.in[5]});
    SEAM(1);
    if (IN(2)) s0_prepass(a, lds);
    SEAM(2);
    if (IN(3)) { for (int u = blockIdx.x; u < 256; u += gridDim.x) if (u < 128) fscan3_hgrn(a, lds, u >> 4, (u >> 1) & 7, u & 1); }
    asm volatile("" ::: "memory");
    if (IN(3)) { for (int u = blockIdx.x; u < 256; u += gridDim.x) if (u >= 128) fscan3_mlstm(a, lds, (u - 128) >> 4, ((u - 128) >> 2) & 3, (u - 128) & 3); }
    if (IN(3) && IN(5)) xcd_barrier(bar);
    if (IN(5)) fgemm_dense(lds, (const bf16*)(ws + WS_H0), (const bf16*)(ws + WS_WINT) + (size_t)7168 * 1024, T, 2048, 1024, EpiB{ws, a.in[6], a.in[11]});
    SEAM(5);
    if (IN(6)) fgemm_paired(lds, (const bf16*)(ws + WS_LFA), (const bf16*)(ws + WS_WAT), (const bf16*)(ws + WS_QKB), (const bf16*)(ws + WS_WBT), T, 1024, 1024, EpiC{ws, (const bf16*)a.out, (const bf16*)a.out + (size_t)T * D});
    SEAM(6);
    if (IN(7)) fgemm_dense(lds, (const bf16*)(ws + WS_IA), (const bf16*)(ws + WS_WOT), T, 1024, 1024, EpiD{ws, a.out, a.in[0], a.in[2], a.in[3]});
    SEAM(7);
    if (IN(8)) p_ln1_route(a, lds);
    SEAM(8);
    if (IN(9)) p_slots(a, lds);
    SEAM(9);
    if (IN(10)) f_moe_gemm<false>(a, lds, 0);
    SEAM(10);
    if (IN(11)) f_moe_gemm<true>(a, lds, 0);
    SEAM(11);
    if (IN(12)) p_combine(a, 0);
    __syncthreads();
    if (IN(13)) f_moe_gemm<false>(a, lds, 1);
    SEAM(13);
    if (IN(14)) f_moe_gemm<true>(a, lds, 1);
    SEAM(14);
    if (IN(15)) p_combine(a, 1);
#undef IN
#undef SEAM
}

extern "C" void kernel_launch(void* const* d_in, const int* in_sizes, int n_in, void* d_out, int out_size, void* d_ws, size_t ws_size, hipStream_t stream) {
    static int grid = 0;
    if (grid == 0) {
        if (n_in != 27 || out_size != T * D || ws_size < WS_END) { fprintf(stderr, "kernel_launch: unexpected shapes (n_in %d out %d ws %zu)\n", n_in, out_size, ws_size); grid = -1; return; }
        int dev = 0, cus = 0;
        if (hipGetDevice(&dev) != hipSuccess || hipDeviceGetAttribute(&cus, hipDeviceAttributeMultiprocessorCount, dev) != hipSuccess) { grid = -1; return; }
        if (hipFuncSetAttribute((const void*)fwd, hipFuncAttributeMaxDynamicSharedMemorySize, LDS_BYTES) != hipSuccess) { grid = -1; return; }
        int per_cu = 0; (void)hipOccupancyMaxActiveBlocksPerMultiprocessor(&per_cu, (const void*)fwd, 512, LDS_BYTES); (void)hipGetLastError();
        grid = cus;
    }
    if (grid < 0) return;
    (void)hipMemsetAsync((char*)d_ws + WS_CTL + CW_BAR * 4, 0, (CW_GCNT + 128 - CW_BAR) * 4, stream);
    Args a{};
    for (int i = 0; i < 27; ++i) a.in[i] = (const float*)d_in[i];
    a.out = (float*)d_out; a.ws = (unsigned char*)d_ws;
    a.ph_lo = 0; a.ph_hi = 16; hipLaunchKernelGGL(fwd, dim3(grid), dim3(512), LDS_BYTES, stream, a);
}
```

```cpp
#include <hip/hip_runtime.h>
#include <stdint.h>
#include <stdio.h>
#include <type_traits>

#define LAS __attribute__((address_space(3)))
typedef unsigned short bf16;
typedef float f32x4 __attribute__((ext_vector_type(4)));
typedef unsigned u32x4 __attribute__((ext_vector_type(4)));
typedef unsigned u32x2 __attribute__((ext_vector_type(2)));

constexpr int D = 1024, NB = 8, SEQ = 8192, T = NB * SEQ, NMETA = 16, INW = 9224;
constexpr int NEXP = 64, TOPK = 8, DEXP = 256;
constexpr float EPS = 1e-5f, DN_ALPHA = 1.189207115002721f, ROUTED_SCALE = 2.5f;
constexpr int HALF_T = T / 2;
constexpr int NSLOTMAX = HALF_T * TOPK + NEXP * 256;

constexpr size_t MiB = 1u << 20;
constexpr size_t WS_CTL = 0, CTL_ZERO_BYTES = 1 * MiB;
constexpr size_t WS_WINT = 1 * MiB;
constexpr size_t WS_WAT = 19 * MiB, WS_WBT = 21 * MiB, WS_WOT = 23 * MiB;
constexpr size_t WS_WSGU = 25 * MiB;
constexpr size_t WS_WSD = 26 * MiB;
constexpr size_t WS_META = 27 * MiB;
constexpr size_t WS_WRT = 27 * MiB + 512 * 1024;
constexpr size_t WS_IGFG = 28 * MiB;
constexpr size_t WS_LNST0 = 30 * MiB;
constexpr size_t WS_LNST1 = 30 * MiB + 512 * 1024;
constexpr size_t WS_STA = 31 * MiB;
constexpr size_t WS_STB = 33 * MiB;
constexpr size_t WS_EIDX = 35 * MiB, WS_GW = 37 * MiB, WS_LPOS = 39 * MiB, WS_SLOTOF = 41 * MiB;
constexpr size_t WS_TOKSLOT = 43 * MiB;
constexpr size_t WS_WSLOT = 46 * MiB;
constexpr size_t WS_WGBASE = 49 * MiB;
constexpr size_t WS_IDENT = 49 * MiB + 128 * 1024;
constexpr size_t WS_EM = 50 * MiB, WS_EL = 54 * MiB;
constexpr size_t WS_HALO = 58 * MiB;
constexpr size_t WS_GATES = 932 * MiB;
constexpr size_t WS_SMETA = 940 * MiB;
constexpr size_t WS_CMETA = 941 * MiB;
constexpr size_t WS_NMETA = 942 * MiB;
constexpr size_t WS_STA2 = 944 * MiB;
constexpr size_t WS_STB2 = 948 * MiB;
constexpr size_t WS_WGU = 64 * MiB;
constexpr size_t WS_WD = 128 * MiB;
constexpr size_t WS_H0 = 162 * MiB;
constexpr size_t WS_QA = 290 * MiB, WS_LFA = 418 * MiB, WS_IA = 546 * MiB, WS_QKB = 674 * MiB, WS_VB = 802 * MiB;
constexpr size_t WS_HH = 290 * MiB;
constexpr size_t WS_YH = 444 * MiB;
constexpr size_t WS_HS = 980 * MiB;
constexpr size_t WS_Z = 720 * MiB;
constexpr size_t WS_H8 = 850 * MiB;
constexpr size_t WS_END = 1024 * MiB;
static_assert(WS_HH + (size_t)(NSLOTMAX + HALF_T) * 512 <= WS_YH && WS_YH + (size_t)NSLOTMAX * 1024 <= WS_Z && WS_Z + (size_t)T * D * 2 <= WS_GATES, "moe map");
constexpr int CW_BAR = 4096, CW_GCNT = 8192;

constexpr int LDS_BYTES = 147456;
constexpr int NPHASE = 20;

__device__ __forceinline__ unsigned f2bf(float f) { unsigned u = __float_as_uint(f); return (u + 0x7fffu + ((u >> 16) & 1u)) >> 16; }
__device__ __forceinline__ float bf2f(unsigned h) { return __uint_as_float(h << 16); }
typedef __bf16 hwbf16x2_t __attribute__((ext_vector_type(2)));
typedef float f32x2_t __attribute__((ext_vector_type(2)));
__device__ __forceinline__ unsigned pk2(float lo, float hi) { const f32x2_t f = {lo, hi}; const hwbf16x2_t b = __builtin_convertvector(f, hwbf16x2_t); return __builtin_bit_cast(unsigned, b); }
__device__ __forceinline__ unsigned f2h(float f) { _Float16 h = (_Float16)f; return (unsigned)__builtin_bit_cast(unsigned short, h); }
__device__ __forceinline__ float h2f(unsigned u) { return (float)__builtin_bit_cast(_Float16, (unsigned short)u); }
__device__ __forceinline__ float wave_sum(float v) {
#pragma unroll
    for (int o = 1; o < 64; o <<= 1) v += __shfl_xor(v, o);
    return v;
}
__device__ __forceinline__ void store8_bf16(bf16* p, const float (&v)[8]);
__device__ __forceinline__ float sigmoidf_(float x) { return __builtin_amdgcn_rcpf(1.0f + __expf(-x)); }
__device__ __forceinline__ float siluf_(float x) { return x * __builtin_amdgcn_rcpf(1.0f + __expf(-x)); }


#define XB_TMO      128
#define XB_XCNT(j)  (256  + 64 * (j))
#define XB_XSUB(j)  (1280 + 64 * (j))
#define XB_XGEN(j)  (2304 + 64 * (j))
#define XB_TOP      3328
#define XB_TOPGEN   3392
#define XCD_BAR_WORDS 3456
#define XB_SPIN_CAP (1u << 20)
__device__ __forceinline__ unsigned xb_ld(unsigned* p)              { return __hip_atomic_load(p, __ATOMIC_RELAXED, __HIP_MEMORY_SCOPE_AGENT); }
__device__ __forceinline__ unsigned xb_add(unsigned* p, unsigned v) { return __hip_atomic_fetch_add(p, v, __ATOMIC_RELAXED, __HIP_MEMORY_SCOPE_AGENT); }
__device__ __forceinline__ unsigned xb_xcc_id() { return (unsigned)__builtin_amdgcn_s_getreg((3 << 11) | 20) & 0xFu; }
#define XB_SPIN(cond, bar) do { unsigned _sp = 0; while (cond) { __builtin_amdgcn_s_sleep(1); \
    if ((++_sp & 255u) == 0u) { if (xb_ld(&(bar)[XB_TMO])) break; if (_sp > XB_SPIN_CAP) { atomicAdd(&(bar)[XB_TMO], 1u); break; } } } } while (0)
struct XcdBarrier { unsigned* bar; unsigned x; volatile LAS unsigned* st; };
__device__ __forceinline__ XcdBarrier xcd_barrier_post(unsigned* bar, volatile LAS unsigned* st) {
    XcdBarrier b; b.bar = bar; b.x = xb_xcc_id(); b.st = st;
    if (threadIdx.x == 0) (void)xb_add(&bar[XB_XCNT(b.x)], 1u);
    return b;
}
__device__ __forceinline__ void xcd_barrier_complete(unsigned* bar, unsigned x, unsigned& nloc, unsigned& nx) {
    const unsigned G = gridDim.x * gridDim.y * gridDim.z;
    unsigned sum, cnt, mine, sp = 0u;
    for (;;) {
        sum = 0u; cnt = 0u; mine = 0u;
#pragma unroll
        for (unsigned j = 0; j < 16; ++j) { const unsigned c = xb_ld(&bar[XB_XCNT(j)]); sum += c; cnt += (c > 0u) ? 1u : 0u; mine = (j == x) ? c : mine; }
        if (sum == G) break;
        __builtin_amdgcn_s_sleep(1);
        if ((++sp & 255u) == 0u) { if (xb_ld(&bar[XB_TMO])) break; if (sp > XB_SPIN_CAP) { atomicAdd(&bar[XB_TMO], 1u); break; } }
    }
    nloc = mine > 0u ? mine : 1u; nx = cnt > 0u ? cnt : 1u;
}
__device__ __forceinline__ void xcd_barrier(const XcdBarrier& b) {
    asm volatile("s_waitcnt vmcnt(0)" ::: "memory");
    __syncthreads();
    if (threadIdx.x == 0) {
        unsigned* bar = b.bar;
        __builtin_amdgcn_s_waitcnt(0);
        unsigned nloc = b.st[0], nx = b.st[1];
        if (nloc == 0u) { xcd_barrier_complete(bar, b.x, nloc, nx); b.st[0] = nloc; b.st[1] = nx; }
        const unsigned old = xb_add(&bar[XB_XSUB(b.x)], 1u);
        const unsigned gen = old / nloc;
        if (old + 1u == (gen + 1u) * nloc) {
            __builtin_amdgcn_fence(__ATOMIC_RELEASE, "agent");
            asm volatile("s_waitcnt vmcnt(0)" ::: "memory");
            const unsigned og = xb_add(&bar[XB_TOP], 1u);
            const unsigned tg = og / nx;
            if (og + 1u == (tg + 1u) * nx) xb_add(&bar[XB_TOPGEN], 1u);
            else XB_SPIN(xb_ld(&bar[XB_TOPGEN]) == tg, bar);
            __builtin_amdgcn_fence(__ATOMIC_ACQUIRE, "agent");
            xb_add(&bar[XB_XGEN(b.x)], 1u);
            asm volatile("s_waitcnt vmcnt(0)" ::: "memory");
        } else {
            XB_SPIN(xb_ld(&bar[XB_XGEN(b.x)]) == gen, bar);
            __builtin_amdgcn_fence(__ATOMIC_ACQUIRE, "agent");
            asm volatile("s_waitcnt vmcnt(0)" ::: "memory");
        }
    }
    __syncthreads();
}

struct Args { const float* in[27]; float* out; unsigned char* ws; int ph_lo, ph_hi; };

struct TrDesc { const float* W; bf16* WT; int ldw, K, nblk, item, mode, f8; };
__device__ __forceinline__ void tr_load(const TrDesc& d, f32x4 (&t)[8], int lane) {
    const int kb = d.item / d.nblk, nb = d.item % d.nblk, k0 = 64 * kb, n0 = 32 * nb;
#pragma unroll
    for (int i = 0; i < 8; ++i) t[i] = *(const f32x4*)(d.W + (size_t)(k0 + 8 * i + (lane >> 3)) * d.ldw + n0 + 4 * (lane & 7));
}
__device__ __forceinline__ void tr_store(const TrDesc& d, const f32x4 (&t)[8], LAS float* scr, int lane) {
    const int kb = d.item / d.nblk, nb = d.item % d.nblk, k0 = 64 * kb, n0 = 32 * nb;
#pragma unroll
    for (int i = 0; i < 8; ++i) { LAS float* p = scr + (8 * i + (lane >> 3)) * 33 + 4 * (lane & 7); p[0] = t[i].x; p[1] = t[i].y; p[2] = t[i].z; p[3] = t[i].w; }
    asm volatile("s_waitcnt lgkmcnt(0)" ::: "memory");
    const int c = lane & 7;
#pragma unroll
    for (int j = 0; j < 4; ++j) { const int n = (lane >> 3) + 8 * j; const LAS float* s = scr + (8 * c) * 33 + n;
        u32x4 o; o.x = pk2(s[0 * 33], s[1 * 33]); o.y = pk2(s[2 * 33], s[3 * 33]); o.z = pk2(s[4 * 33], s[5 * 33]); o.w = pk2(s[6 * 33], s[7 * 33]);
        const int nn = n0 + n, row = d.mode == 0 ? nn : (nn >> 7) * 256 + (d.mode - 1) * 128 + (nn & 127);
        if (d.f8) {
            int w0 = __builtin_amdgcn_cvt_pk_fp8_f32(64.f * s[0 * 33], 64.f * s[1 * 33], 0, false); w0 = __builtin_amdgcn_cvt_pk_fp8_f32(64.f * s[2 * 33], 64.f * s[3 * 33], w0, true);
            int w1 = __builtin_amdgcn_cvt_pk_fp8_f32(64.f * s[4 * 33], 64.f * s[5 * 33], 0, false); w1 = __builtin_amdgcn_cvt_pk_fp8_f32(64.f * s[6 * 33], 64.f * s[7 * 33], w1, true);
            *(u32x2*)((unsigned char*)d.WT + (size_t)row * d.K + k0 + 8 * c) = (u32x2){(unsigned)w0, (unsigned)w1}; }
        else *(u32x4*)(d.WT + (size_t)row * d.K + k0 + 8 * c) = o; }
    asm volatile("s_waitcnt lgkmcnt(0)" ::: "memory");
}
__device__ __forceinline__ int win_src_off(int g) {
    switch (g) { case 0: return 0; case 1: return 1024; case 2: return 2048; case 3: return 4096; case 4: return 5120; case 5: return 7176; case 6: return 8200; case 7: return 3072; default: return 6144; }
}

__device__ __forceinline__ void p0_prologue(const Args& a, LAS unsigned char* lds) {
    const int tid = threadIdx.x, lane = tid & 63, wave = tid >> 6;
    unsigned char* ws = a.ws;
    const int gw = blockIdx.x * 8 + wave, NGW = gridDim.x * 8;
    {
        LAS float* scr = (LAS float*)(lds + 32768 + wave * 8704);
        constexpr int NA = 12 * 512, NBt = 130 * 128, NC = 65 * 128, NTOT = NA + NBt + NC;
        auto decode = [&](int it) -> TrDesc { TrDesc d; d.f8 = 0;
            if (it < NA) { const int job = it / 512; d.item = it % 512; d.ldw = job < 9 ? INW : 1024; d.K = 1024; d.nblk = 32; d.mode = 0;
                if (job < 9) { d.W = a.in[4] + win_src_off(job); d.WT = (bf16*)(ws + WS_WINT) + (size_t)job * 1024 * 1024; }
                else { d.W = a.in[12 + (job - 9)]; d.WT = (bf16*)(ws + (job == 9 ? WS_WAT : job == 10 ? WS_WBT : WS_WOT)); } }
            else if (it < NA + NBt) { const int r = it - NA, job = r / 128; d.item = r % 128; d.ldw = 256; d.K = 1024; d.nblk = 8;
                d.f8 = 1;
                if (job < 128) { const int e = job & 63, up = job >> 6; d.mode = 1 + up; d.W = a.in[19 + up] + (size_t)e * 1024 * 256; d.WT = (bf16*)(ws + WS_WGU + (size_t)e * 512 * 1024); }
                else { const int up = job - 128; d.mode = 1 + up; d.W = a.in[22 + up]; d.WT = (bf16*)(ws + WS_WSGU); } }
            else { const int r = it - NA - NBt, job = r / 128; d.item = r % 128; d.ldw = 1024; d.K = 256; d.nblk = 32; d.mode = 0;
                if (job < 64) { d.W = a.in[21] + (size_t)job * 256 * 1024; d.WT = (bf16*)(ws + WS_WD) + (size_t)job * 1024 * 256; }
                else { d.W = a.in[24]; d.WT = (bf16*)(ws + WS_WSD); } }
            return d; };
        if (gw < NTOT) {
            TrDesc d0 = decode(gw); f32x4 t0[8]; tr_load(d0, t0, lane);
            for (int it = gw; it < NTOT; it += NGW) {
                TrDesc d1 = d0; f32x4 t1[8]; const bool more = it + NGW < NTOT;
                if (more) { d1 = decode(it + NGW); tr_load(d1, t1, lane); }
                tr_store(d0, t0, scr, lane);
                if (more) { d0 = d1;
#pragma unroll
                    for (int i = 0; i < 8; ++i) t0[i] = t1[i]; }
            }
        }
    }
    __syncthreads();
    LAS float* Wg8 = (LAS float*)lds;
    for (int i = tid; i < 1024 * 8; i += 512) Wg8[i] = a.in[4][(size_t)(i >> 3) * INW + 7168 + (i & 7)];
    __syncthreads();
    {
        const float* x = a.in[0]; const f32x4* gp = (const f32x4*)a.in[2] + lane; const f32x4* bp = (const f32x4*)a.in[3] + lane;
        f32x4 g[4], b[4];
#pragma unroll
        for (int j = 0; j < 4; ++j) { g[j] = gp[64 * j]; b[j] = bp[64 * j]; }
        bf16* h0 = (bf16*)(ws + WS_H0); float* lnst = (float*)(ws + WS_LNST0); float* igfg = (float*)(ws + WS_IGFG);
        f32x4 vn[4];
        if (gw < T) { const f32x4* xr = (const f32x4*)(x + (size_t)gw * D) + lane;
#pragma unroll
            for (int j = 0; j < 4; ++j) vn[j] = xr[64 * j]; }
        for (int m = gw; m < T; m += NGW) {
            f32x4 v[4]; float s = 0.f;
#pragma unroll
            for (int j = 0; j < 4; ++j) { v[j] = vn[j]; s += (v[j].x + v[j].y) + (v[j].z + v[j].w); }
            if (m + NGW < T) { const f32x4* xr = (const f32x4*)(x + (size_t)(m + NGW) * D) + lane;
#pragma unroll
                for (int j = 0; j < 4; ++j) vn[j] = xr[64 * j]; }
            const float mean = wave_sum(s) * (1.f / D); float s2 = 0.f;
#pragma unroll
            for (int j = 0; j < 4; ++j) { v[j] = v[j] - mean; s2 += (v[j].x * v[j].x + v[j].y * v[j].y) + (v[j].z * v[j].z + v[j].w * v[j].w); }
            const float rstd = 1.f / sqrtf(wave_sum(s2) * (1.f / D) + EPS);
            float acc[8];
#pragma unroll
            for (int c = 0; c < 8; ++c) acc[c] = 0.f;
            unsigned long long* o8 = (unsigned long long*)(h0 + (size_t)m * D) + lane;
#pragma unroll
            for (int j = 0; j < 4; ++j) {
                f32x4 h = v[j] * rstd * g[j] + b[j];
                o8[64 * j] = (unsigned long long)pk2(h.x, h.y) | ((unsigned long long)pk2(h.z, h.w) << 32);
#pragma unroll
                for (int i = 0; i < 4; ++i) { const int k = 4 * lane + i + 256 * j; const f32x4 w0 = *(const LAS f32x4*)(Wg8 + k * 8), w1 = *(const LAS f32x4*)(Wg8 + k * 8 + 4);
                    const float hv = h[i];
                    acc[0] += hv * w0.x; acc[1] += hv * w0.y; acc[2] += hv * w0.z; acc[3] += hv * w0.w; acc[4] += hv * w1.x; acc[5] += hv * w1.y; acc[6] += hv * w1.z; acc[7] += hv * w1.w; }
            }
            float r4[4], r2[2], r1;
            { const bool up = lane & 1;
#pragma unroll
              for (int c = 0; c < 4; ++c) { const float send = up ? acc[c] : acc[4 + c], keep = up ? acc[4 + c] : acc[c]; r4[c] = keep + __shfl_xor(send, 1); } }
            { const bool up = lane & 2;
#pragma unroll
              for (int c = 0; c < 2; ++c) { const float send = up ? r4[c] : r4[2 + c], keep = up ? r4[2 + c] : r4[c]; r2[c] = keep + __shfl_xor(send, 2); } }
            { const bool up = lane & 4; const float send = up ? r2[0] : r2[1], keep = up ? r2[1] : r2[0]; r1 = keep + __shfl_xor(send, 4); }
            r1 += __shfl_xor(r1, 8); r1 += __shfl_xor(r1, 16); r1 += __shfl_xor(r1, 32);
            if (lane < 8) igfg[(size_t)m * 8 + 4 * (lane & 1) + 2 * ((lane >> 1) & 1) + ((lane >> 2) & 1)] = r1;
            if (lane == 0) { lnst[2 * m] = mean; lnst[2 * m + 1] = rstd; }
        }
    }
    __syncthreads();
    for (int cgp = blockIdx.x; cgp < 81; cgp += gridDim.x) {
        LAS float* hm = (LAS float*)(lds + 32768);
        LAS float* part = (LAS float*)(lds + 32768 + 65536);
        __syncthreads();
        for (int r = wave * 2; r < wave * 2 + 2; ++r) {
            const f32x4* xr = (const f32x4*)(a.in[1] + (size_t)r * D) + lane; const f32x4* gp = (const f32x4*)a.in[2] + lane; const f32x4* bp = (const f32x4*)a.in[3] + lane;
            f32x4 v[4]; float s = 0.f;
#pragma unroll
            for (int j = 0; j < 4; ++j) { v[j] = xr[64 * j]; s += (v[j].x + v[j].y) + (v[j].z + v[j].w); }
            const float mean = wave_sum(s) * (1.f / D); float s2 = 0.f;
#pragma unroll
            for (int j = 0; j < 4; ++j) { v[j] = v[j] - mean; s2 += (v[j].x * v[j].x + v[j].y * v[j].y) + (v[j].z * v[j].z + v[j].w * v[j].w); }
            const float rstd = 1.f / sqrtf(wave_sum(s2) * (1.f / D) + EPS);
#pragma unroll
            for (int j = 0; j < 4; ++j) { const f32x4 h = v[j] * rstd * gp[64 * j] + bp[64 * j]; *(LAS f32x4*)(hm + r * 1024 + 4 * (lane + 64 * j)) = h; }
        }
        __syncthreads();
        const int c = cgp * 64 + lane;
        const int cc = c < 5128 ? c : 5127, g = cc >> 10, srccol = (cc < 5120) ? win_src_off(g) + (cc & 1023) : 7168 + (cc - 5120);
        float acc[16];
#pragma unroll
        for (int r = 0; r < 16; ++r) acc[r] = 0.f;
        const float* wp = a.in[4] + (size_t)(wave * 128) * INW + srccol;
#pragma unroll 4
        for (int k = 0; k < 128; ++k) { const float w = wp[(size_t)k * INW];
#pragma unroll
            for (int r = 0; r < 16; ++r) acc[r] += hm[r * 1024 + wave * 128 + k] * w; }
#pragma unroll
        for (int r = 0; r < 16; ++r) part[(wave * 16 + r) * 64 + lane] = acc[r];
        __syncthreads();
        if (c < 5128) {
            float* meta = (float*)(ws + WS_META);
            for (int r = wave * 2; r < wave * 2 + 2; ++r) { float v = 0.f;
#pragma unroll
                for (int w8 = 0; w8 < 8; ++w8) v += part[(w8 * 16 + r) * 64 + lane];
                if (c < 5120) { const int c1 = c & 1023;
                    if (g == 1) { const float lb = 1.0f / (1.0f + expf(a.in[5][1024 + c1] - a.in[5][c1])); v = logf(lb + (1.0f - lb) * sigmoidf_(v)); }
                    meta[(size_t)g * 16384 + r * 1024 + c1] = v; }
                else meta[5 * 16384 + r * 8 + (c - 5120)] = v; }
        }
    }
    for (int it = blockIdx.x * 512 + tid; it < 64 * 128; it += gridDim.x * 512) { const int e = it >> 7, k0 = (it & 127) * 8; float hi[8], lo[8];
#pragma unroll
        for (int j = 0; j < 8; ++j) { const float wv = a.in[17][(size_t)(k0 + j) * 64 + e]; const float h = bf2f(f2bf(wv)); hi[j] = h; lo[j] = wv - h; }
        store8_bf16((bf16*)(ws + WS_WRT) + (size_t)e * 1024 + k0, hi); store8_bf16((bf16*)(ws + WS_WRT) + 65536 + (size_t)e * 1024 + k0, lo); }
    {
        int* ts = (int*)(ws + WS_TOKSLOT); float* wsl = (float*)(ws + WS_WSLOT);
        for (int i = blockIdx.x * 512 + tid; i < 2 * NSLOTMAX; i += gridDim.x * 512) { ts[i] = 0; wsl[i] = 0.f; }
        int* ident = (int*)(ws + WS_IDENT);
        for (int i = blockIdx.x * 512 + tid; i < T; i += gridDim.x * 512) ident[i] = i;
    }
}

__device__ __forceinline__ void store8_bf16(bf16* p, const float (&v)[8]) { u32x4 w; w.x = pk2(v[0], v[1]); w.y = pk2(v[2], v[3]); w.z = pk2(v[4], v[5]); w.w = pk2(v[6], v[7]); *(u32x4*)p = w; }
__device__ __forceinline__ void load8_bf16(const bf16* p, float (&v)[8]) { const u32x4 w = *(const u32x4*)p;
    v[0] = bf2f(w.x & 0xffffu); v[1] = bf2f(w.x >> 16); v[2] = bf2f(w.y & 0xffffu); v[3] = bf2f(w.y >> 16); v[4] = bf2f(w.z & 0xffffu); v[5] = bf2f(w.z >> 16); v[6] = bf2f(w.w & 0xffffu); v[7] = bf2f(w.w >> 16); }

struct NoData {};
template <int K> struct KindTag { static constexpr int value = K; };
template <class T, class = void> struct epigroup { static constexpr int value = 4; };
template <class T> struct epigroup<T, typename std::enable_if<(T::GROUP > 0)>::type> { static constexpr int value = T::GROUP; };
template <class T, class = void> struct pairbj : std::false_type {};
template <class T> struct pairbj<T, typename std::enable_if<T::PAIRBJ>::type> : std::true_type {};
__device__ __forceinline__ void unpack8(const u32x4 w, float (&v)[8]) { v[0] = bf2f(w.x & 0xffffu); v[1] = bf2f(w.x >> 16); v[2] = bf2f(w.y & 0xffffu); v[3] = bf2f(w.y >> 16); v[4] = bf2f(w.z & 0xffffu); v[5] = bf2f(w.z >> 16); v[6] = bf2f(w.w & 0xffffu); v[7] = bf2f(w.w >> 16); }
struct EpiA {
    static constexpr bool PIPE = false; static constexpr int NKIND = 4;
    unsigned char* ws; unsigned char* dout; const float* lbl;
    struct Cl { float lb[8]; bf16* base; }; typedef NoData Ld;
    __device__ __forceinline__ int kind(int col0) const { const int g = col0 >> 10; return g == 1 ? 1 : g >= 5 ? 2 : g == 3 ? 3 : 0; }
    template <int K> __device__ __forceinline__ void colload(int col0, Cl& cl) const { const int g = col0 >> 10, c = col0 & 1023;
        if (K == 1) {
#pragma unroll
            for (int j = 0; j < 8; ++j) cl.lb[j] = __builtin_amdgcn_rcpf(1.0f + __expf(lbl[1024 + c + j] - lbl[c + j]));
            cl.base = (bf16*)(ws + WS_LFA) + c; }
        else if (K == 2) cl.base = (bf16*)dout + (size_t)(g - 5) * T * D + c;
        else if (K == 3) cl.base = (bf16*)(ws + WS_QKB) + c;
        else cl.base = (bf16*)(ws + (g == 0 ? WS_QA : g == 2 ? WS_IA : WS_VB)) + c; }
    template <int K> __device__ __forceinline__ void load(int, int, Ld&) const {}
    template <int K> __device__ __forceinline__ void apply(int row, int col0, int m, const float (&v)[8], const Ld&, const Cl& cl) const {
        if (K == 1) { float o[8];
#pragma unroll
            for (int j = 0; j < 8; ++j) o[j] = __logf(cl.lb[j] + (1.0f - cl.lb[j]) * sigmoidf_(v[j]));
            u32x4 w; w.x = f2h(o[0]) | (f2h(o[1]) << 16); w.y = f2h(o[2]) | (f2h(o[3]) << 16); w.z = f2h(o[4]) | (f2h(o[5]) << 16); w.w = f2h(o[6]) | (f2h(o[7]) << 16);
            *(u32x4*)(cl.base + (size_t)row * D) = w; }
        else if (K == 2) { float o[8];
#pragma unroll
            for (int j = 0; j < 8; ++j) o[j] = sigmoidf_(v[j]);
            store8_bf16(cl.base + (size_t)row * D, o); }
        else { store8_bf16(cl.base + (size_t)row * D, v);
            if (K == 3 && m == 3) { if ((row & 63) >= 61) store8_bf16((bf16*)(ws + WS_HALO) + ((size_t)(row >> 6) * 3 + ((row & 63) - 61)) * D + (col0 & 1023), v); } }
    }
};
struct EpiB {
    static constexpr bool PIPE = false; static constexpr int NKIND = 2; static constexpr int GROUP = 2;
    unsigned char* ws; const float* hg_g; const float* ml_g;
    struct Cl { float gn[8]; }; struct Ld { u32x4 x; float mean, rstd; };
    __device__ __forceinline__ int kind(int col0) const { return col0 >> 10; }
    template <int K> __device__ __forceinline__ void colload(int col0, Cl& cl) const { const int c = col0 & 1023; const float* gp = (K == 0 ? hg_g : ml_g) + c;
#pragma unroll
        for (int j = 0; j < 8; ++j) cl.gn[j] = gp[j]; }
    template <int K> __device__ __forceinline__ void load(int row, int col0, Ld& ld) const { const int c = col0 & 1023;
        if (K == 0) { ld.x = *(const u32x4*)((const bf16*)(ws + WS_IA) + (size_t)row * D + c); ld.mean = 0.f;
            const f32x2_t p = *(const f32x2_t*)((const float*)(ws + WS_STA2) + (size_t)row * 16 + (c >> 7) * 2); ld.rstd = __builtin_amdgcn_rsqf((p.x + p.y) * (1.f / 128.f) + EPS); }
        else { ld.x = *(const u32x4*)((const bf16*)(ws + WS_VB) + (size_t)row * D + c); const f32x4* st = (const f32x4*)((const float*)(ws + WS_STB2) + ((size_t)row * 16 + (c >> 8) * 4) * 2);
            const f32x4 a0 = st[0], a1 = st[1]; const float s1 = (a0.x + a0.z) + (a1.x + a1.z), s2 = (a0.y + a0.w) + (a1.y + a1.w);
            ld.mean = s1 * (1.f / 256.f); ld.rstd = __builtin_amdgcn_rsqf(fmaxf(s2 * (1.f / 256.f) - ld.mean * ld.mean, 0.f) + EPS); } }
    template <int K> __device__ __forceinline__ void apply(int row, int col0, int, const float (&v)[8], const Ld& ld, const Cl& cl) const {
        const int c = col0 & 1023; float x[8], o[8]; unpack8(ld.x, x);
        if (K == 0) {
#pragma unroll
            for (int j = 0; j < 8; ++j) o[j] = x[j] * ld.rstd * cl.gn[j] * siluf_(v[j]);
            store8_bf16((bf16*)(ws + WS_LFA) + (size_t)row * D + c, o);
        } else {
#pragma unroll
            for (int j = 0; j < 8; ++j) o[j] = (x[j] - ld.mean) * ld.rstd * cl.gn[j] * sigmoidf_(v[j]);
            store8_bf16((bf16*)(ws + WS_QKB) + (size_t)row * D + c, o);
        }
    }
};
struct EpiC {
    static constexpr bool PIPE = true; static constexpr int NKIND = 1;
    unsigned char* ws; const bf16* sga; const bf16* sgb;
    typedef NoData Cl; struct Ld { u32x4 a, b; };
    __device__ __forceinline__ int kind(int) const { return 0; }
    template <int K> __device__ __forceinline__ void colload(int, Cl&) const {}
    __device__ __forceinline__ void midload(int row, int col0, Ld& ld) const { ld.a = *(const u32x4*)(sga + (size_t)row * D + col0); ld.b = *(const u32x4*)(sgb + (size_t)row * D + col0); }
    __device__ __forceinline__ void mid(float (&v)[8], const Ld& ld) const { float sa[8], sb[8]; unpack8(ld.a, sa); unpack8(ld.b, sb);
#pragma unroll
        for (int j = 0; j < 8; ++j) v[j] *= sa[j] * __builtin_amdgcn_rcpf(sb[j]); }
    template <int K> __device__ __forceinline__ void load(int row, int col0, Ld& ld) const { ld.b = *(const u32x4*)(sgb + (size_t)row * D + col0); }
    template <int K> __device__ __forceinline__ void apply(int row, int col0, int, const float (&v)[8], const Ld& ld, const Cl&) const { float sb[8], o[8]; unpack8(ld.b, sb);
#pragma unroll
        for (int j = 0; j < 8; ++j) o[j] = sb[j] * v[j];
        store8_bf16((bf16*)(ws + WS_IA) + (size_t)row * D + col0, o); }
};
struct EpiD {
    static constexpr bool PIPE = false; static constexpr int NKIND = 1;
    unsigned char* ws; float* dout; const float* x; const float* g; const float* b;
    struct Cl { float g[8], b[8]; }; struct Ld { f32x4 x0, x1; float mean, rstd; };
    __device__ __forceinline__ int kind(int) const { return 0; }
    template <int K> __device__ __forceinline__ void colload(int col0, Cl& cl) const {
#pragma unroll
        for (int j = 0; j < 8; ++j) { cl.g[j] = g[col0 + j]; cl.b[j] = b[col0 + j]; } }
    template <int K> __device__ __forceinline__ void load(int row, int col0, Ld& ld) const { const float* st = (const float*)(ws + WS_LNST0) + 2 * (size_t)row; ld.mean = st[0]; ld.rstd = st[1];
        ld.x0 = *(const f32x4*)(x + (size_t)row * D + col0); ld.x1 = *(const f32x4*)(x + (size_t)row * D + col0 + 4); }
    template <int K> __device__ __forceinline__ void apply(int row, int col0, int, const float (&v)[8], const Ld& ld, const Cl& cl) const { float o[8];
#pragma unroll
        for (int j = 0; j < 4; ++j) { o[j] = DN_ALPHA * ((ld.x0[j] - ld.mean) * ld.rstd * cl.g[j] + cl.b[j]) + v[j]; o[4 + j] = DN_ALPHA * ((ld.x1[j] - ld.mean) * ld.rstd * cl.g[4 + j] + cl.b[4 + j]) + v[4 + j]; }
        store8_bf16((bf16*)(ws + WS_Z) + (size_t)row * D + col0, o); }
};
struct EpiGU {
    static constexpr bool PIPE = false; static constexpr int NKIND = 1; static constexpr bool PAIRBJ = true;
    bf16* H;
    typedef NoData Cl; typedef NoData Ld;
    __device__ __forceinline__ int kind(int) const { return 0; }
    __device__ __forceinline__ void apply_pair(int row, int col0, const float (&g)[8], const float (&u)[8]) const {
        float o[8];
#pragma unroll
        for (int j = 0; j < 8; ++j) o[j] = siluf_(g[j] * 0.015625f) * (u[j] * 0.015625f);
        store8_bf16(H + (size_t)row * DEXP + (col0 >> 8) * 128 + (col0 & 127), o); }
};
struct EpiDown {
    static constexpr bool PIPE = true; static constexpr int NKIND = 1;
    unsigned char* Y; const float* w;
    typedef NoData Cl; struct Ld { float s; };
    __device__ __forceinline__ int kind(int) const { return 0; }
    template <int K> __device__ __forceinline__ void colload(int, Cl&) const {}
    template <int K> __device__ __forceinline__ void load(int row, int, Ld& ld) const { ld.s = w[row]; }
    template <int K> __device__ __forceinline__ void apply(int row, int col0, int, const float (&v)[8], const Ld& ld, const Cl&) const { float o[8]; const float s = ld.s * 32.0f;
#pragma unroll
        for (int j = 0; j < 8; ++j) o[j] = fminf(fmaxf(s * v[j], -448.f), 448.f);
        int w0 = __builtin_amdgcn_cvt_pk_fp8_f32(o[0], o[1], 0, false); w0 = __builtin_amdgcn_cvt_pk_fp8_f32(o[2], o[3], w0, true);
        int w1 = __builtin_amdgcn_cvt_pk_fp8_f32(o[4], o[5], 0, false); w1 = __builtin_amdgcn_cvt_pk_fp8_f32(o[6], o[7], w1, true);
        *(u32x2*)(Y + (size_t)row * D + col0) = (u32x2){(unsigned)w0, (unsigned)w1}; }
};
struct EpiSD2 {
    static constexpr bool PIPE = false; static constexpr int NKIND = 1;
    unsigned char* ws; float* dout; const float* g; const float* b; int tokbase;
    struct Cl { float g[8], b[8]; }; struct Ld { u32x4 z; float mean, rstd; };
    __device__ __forceinline__ int kind(int) const { return 0; }
    template <int K> __device__ __forceinline__ void colload(int col0, Cl& cl) const {
#pragma unroll
        for (int j = 0; j < 8; ++j) { cl.g[j] = g[col0 + j]; cl.b[j] = b[col0 + j]; } }
    template <int K> __device__ __forceinline__ void load(int row, int col0, Ld& ld) const { const int tok = tokbase + row - NSLOTMAX; const float* st = (const float*)(ws + WS_LNST1) + 2 * (size_t)tok; ld.mean = st[0]; ld.rstd = st[1];
        ld.z = *(const u32x4*)((const bf16*)(ws + WS_Z) + (size_t)tok * D + col0); }
    template <int K> __device__ __forceinline__ void apply(int row, int col0, int, const float (&v)[8], const Ld& ld, const Cl& cl) const { const int tok = tokbase + row - NSLOTMAX; float z[8], o[8]; unpack8(ld.z, z);
#pragma unroll
        for (int j = 0; j < 8; ++j) o[j] = DN_ALPHA * ((z[j] - ld.mean) * ld.rstd * cl.g[j] + cl.b[j]) + v[j];
        store8_bf16((bf16*)(ws + WS_H0) + (size_t)tok * D + col0, o); }
};

namespace pg8 {
typedef short bf16x8 __attribute__((ext_vector_type(8)));
constexpr int BM = 256, BK = 64, HALF = 128, HTB = HALF * BK * 2, STAGE_BYTES = 8 * HTB, NXCD = 8, WGM = 8;
__device__ __forceinline__ int lds_byte(int r, int c) { const int st = (r >> 4) * 2 + (c >> 5), rr = r & 15, cc = c & 31, ob = rr * 64 + cc * 2; return st * 1024 + (ob ^ (((ob >> 9) & 1) << 5)); }
__device__ __forceinline__ void stage_rc(int b, int& R, int& C) { const int st = b / 1024, sb = b % 1024, swz = sb ^ (((sb >> 9) & 1) << 5); R = (st >> 1) * 16 + swz / 64; C = (st & 1) * 32 + (swz % 64) / 2; }
__device__ __forceinline__ int perm32(int rho) { const int n = rho >> 4, i = rho & 15; return 8 * (i >> 2) + 4 * n + (i & 3); }
typedef int v8i32_t __attribute__((ext_vector_type(8)));
typedef int v4i32_t __attribute__((ext_vector_type(4)));
__device__ __forceinline__ v8i32_t cat88(bf16x8 a, bf16x8 b) { const u32x4 x = __builtin_bit_cast(u32x4, a), y = __builtin_bit_cast(u32x4, b); return (v8i32_t){(int)x.x, (int)x.y, (int)x.z, (int)x.w, (int)y.x, (int)y.y, (int)y.z, (int)y.w}; }
struct Unit { int row0, col0; const char* A; const char* B; const int* idx; int mode; };
__device__ __forceinline__ int xcd_remap(int L, int nwg) { const int q = nwg / NXCD, r = nwg % NXCD, xcd = L % NXCD, off = L / NXCD; return (xcd < r ? xcd * (q + 1) : r * (q + 1) + (xcd - r) * q) + off; }
struct DenseOrder {
    int nM, nN, nwg, G, c, K; const char* A; const char* Bt;
    __device__ __forceinline__ void init(const bf16* A_, const bf16* Bt_, int M, int N, int K_) { A = (const char*)A_; Bt = (const char*)Bt_; K = K_; nM = M / BM; nN = N / BM; nwg = nM * nN; G = gridDim.x; c = blockIdx.x; }
    __device__ __forceinline__ bool next(int i, Unit& u) const {
        const long L = (long)i * G + c; if (L >= nwg) return false;
        const int wgid = xcd_remap((int)L, nwg);
        const int nig = WGM * nN, gid = wgid / nig, fm = gid * WGM, gsz = (nM - fm) < WGM ? (nM - fm) : WGM;
        const int pm = fm + ((wgid % nig) % gsz), pn = (wgid % nig) / gsz;
        u.row0 = pm * BM; u.col0 = pn * BM; u.A = A + (size_t)pm * BM * K * 2; u.B = Bt + (size_t)pn * BM * K * 2; u.idx = nullptr; u.mode = 0; return true;
    }
};
struct PairedOrder {
    DenseOrder d; const char* A2; const char* B2;
    __device__ __forceinline__ bool next(int i, Unit& u) const {
        if (!d.next(i >> 1, u)) return false;
        if (i & 1) { u.A = A2 + (size_t)u.row0 * d.K * 2; u.B = B2 + (size_t)u.col0 * d.K * 2; u.mode = 2; } else u.mode = 1;
        return true;
    }
};
struct GroupedOrder {
    const LAS int* te; int nct, nrt, nwg1, nwg2, G, c, K; const char* A; const int* idx; const int* ident; const char* Bt; const char* Bsh; size_t estride; bool gather;
    __device__ __forceinline__ bool next(int i, Unit& u) const {
        const int n1 = c < nwg1 ? (nwg1 - c + G - 1) / G : 0;
        if (i < n1) { const int wgid = xcd_remap(i * G + c, nwg1), rt = wgid / nct, ct = wgid % nct, row0 = rt * BM; const int e = __builtin_amdgcn_readfirstlane(te[rt]); u.mode = 0; u.col0 = ct * BM;
            u.row0 = row0; u.A = gather ? A : A + (size_t)row0 * K * 2; u.idx = idx + row0; u.B = Bt + (size_t)e * estride + (size_t)ct * BM * K * 2; return true; }
        const int L2 = (i - n1) * G + c; if (L2 >= nwg2) return false;
        const int wgid = xcd_remap(L2, nwg2), rt = wgid / nct, ct = wgid % nct, row0 = NSLOTMAX + rt * BM; u.mode = 3; u.col0 = ct * BM;
        u.row0 = row0; u.A = gather ? A : A + (size_t)row0 * K * 2; u.idx = ident + rt * BM; u.B = Bsh + (size_t)ct * BM * K * 2; return true;
    }
};

template <bool GATHER, bool PAIRED, bool FP8, class Epi, class Sched, class Epi2>
__device__ __forceinline__ void gemm_phase2(LAS unsigned char* lds, const int K, const Sched& S, const Epi& E, const Epi2& E2) {
    const int tid = threadIdx.x, wid = __builtin_amdgcn_readfirstlane(tid >> 6), lane = tid & 63, wr = wid >> 2, wc = wid & 3, fr = lane & 15, fq = lane >> 4;
    const int nt = K / BK;
    unsigned voffA[2], voffB[2];
#pragma unroll
    for (int i = 0; i < 2; ++i) { int R, C; stage_rc(tid * 16 + i * 8192, R, C); const int Rb = (R & ~31) + perm32(R & 31);
        voffA[i] = (unsigned)(R * K + C) * 2u; voffB[i] = (unsigned)(Rb * K + C) * 2u; }
    const size_t kstep = (size_t)(BK * 2);
    const size_t hstep = (size_t)HALF * K * 2;
    const unsigned ldsw = (unsigned)wid * 1024u;
    const int aoffk[2] = { FP8 ? lds_byte(wr * 64 + fr, fq * 16) : lds_byte(wr * 64 + fr, fq * 8), FP8 ? lds_byte(wr * 64 + fr, fq * 16 + 8) : lds_byte(wr * 64 + fr, fq * 8) + 1024 };
    const int boffk[2] = { FP8 ? lds_byte(wc * 32 + fr, fq * 16) : lds_byte(wc * 32 + fr, fq * 8), FP8 ? lds_byte(wc * 32 + fr, fq * 16 + 8) : lds_byte(wc * 32 + fr, fq * 8) + 1024 };
    unsigned cvA[2][2];
#define PG8_SA(b, h) (((b) * 2 + (h)) * HTB)
#define PG8_SB(b, h) ((4 + (b) * 2 + (h)) * HTB)
#define PG8_STAGE(bufoff, gbase, voff) do { _Pragma("unroll") for (int _i = 0; _i < 2; ++_i) \
        __builtin_amdgcn_global_load_lds((const unsigned*)((const char*)(gbase) + (voff)[_i]), (LAS unsigned*)(lds + (bufoff) + ldsw + _i * 8192), 16, 0, 0); } while (0)
#define PG8_STAGE_A(bufoff, kbase, h, usenext) do { if constexpr (GATHER) { PG8_STAGE(bufoff, kbase, cvA[h]); } \
        else { PG8_STAGE(bufoff, (kbase) + (h) * hstep, voffA); } } while (0)
#define PG8_LOADIDX(dst, un) do { _Pragma("unroll") for (int _i = 0; _i < 2; ++_i) { int _R, _C; stage_rc(tid * 16 + _i * 8192, _R, _C); _Pragma("unroll") for (int _h = 0; _h < 2; ++_h) \
        dst[_h][_i] = ((unsigned)(un).idx[_h * HALF + _R] * (unsigned)K + (unsigned)_C) * 2u; } } while (0)
#define PG8_LDA(dst, b, h) do { _Pragma("unroll") for (int m = 0; m < 4; ++m) { if constexpr (FP8) { dst##8[m].lo = *(const LAS v4i32_t*)(lds + PG8_SA(b, h) + aoffk[0] + m * 2048); dst##8[m].hi = *(const LAS v4i32_t*)(lds + PG8_SA(b, h) + aoffk[1] + m * 2048); } \
        else { _Pragma("unroll") for (int k = 0; k < 2; ++k) dst[m][k] = *(const LAS bf16x8*)(lds + PG8_SA(b, h) + aoffk[k] + m * 2048); } } } while (0)
#define PG8_LDB(dst, b, h) do { _Pragma("unroll") for (int n = 0; n < 2; ++n) { if constexpr (FP8) { dst##8[n].lo = *(const LAS v4i32_t*)(lds + PG8_SB(b, h) + boffk[0] + n * 2048); dst##8[n].hi = *(const LAS v4i32_t*)(lds + PG8_SB(b, h) + boffk[1] + n * 2048); } \
        else { _Pragma("unroll") for (int k = 0; k < 2; ++k) dst[n][k] = *(const LAS bf16x8*)(lds + PG8_SB(b, h) + boffk[k] + n * 2048); } } } while (0)
#define PG8_MMA(ai, bj, At, Bt) do { __builtin_amdgcn_s_setprio(1); _Pragma("unroll") for (int m = 0; m < 4; ++m) _Pragma("unroll") for (int n = 0; n < 2; ++n) { \
        if constexpr (FP8) acc[ai][bj][m][n] = __builtin_amdgcn_mfma_scale_f32_16x16x128_f8f6f4(Bt##8[n], At##8[m], acc[ai][bj][m][n], 0, 0, 0, 0x7F7F7F7F, 0, 0x7F7F7F7F); \
        else { _Pragma("unroll") for (int k = 0; k < 2; ++k) acc[ai][bj][m][n] = __builtin_amdgcn_mfma_f32_16x16x32_bf16(Bt[n][k], At[m][k], acc[ai][bj][m][n], 0, 0, 0); } } \
        __builtin_amdgcn_s_setprio(0); } while (0)
#define PG8_WAIT_V(n) asm volatile("s_waitcnt vmcnt(" #n ")" ::: "memory")
#define PG8_WAIT_L(n) asm volatile("s_waitcnt lgkmcnt(" #n ")" ::: "memory")
#define PG8_BAR __builtin_amdgcn_s_barrier()
#define PG8_SCHED __builtin_amdgcn_sched_barrier(0)
    Unit cur, nxt; int ui = 0;
    if (!S.next(0, cur)) return;
    f32x4 acc[2][2][4][2];
#pragma unroll
    for (int a = 0; a < 2; ++a)
#pragma unroll
        for (int b = 0; b < 2; ++b)
#pragma unroll
            for (int m = 0; m < 4; ++m)
#pragma unroll
                for (int n = 0; n < 2; ++n) acc[a][b][m][n] = (f32x4){0.f, 0.f, 0.f, 0.f};
    bf16x8 At[4][2], B0[2][2], B1[2][2]; v8i32_t At8[4], B08[2], B18[2];
    const char* cA = cur.A; const char* cB = cur.B;
    if constexpr (GATHER) { PG8_LOADIDX(cvA, cur); }
    PG8_STAGE(PG8_SB(0, 0), cB, voffB); PG8_STAGE(PG8_SB(0, 1), cB + hstep, voffB); PG8_STAGE_A(PG8_SA(0, 0), cA, 0, false); PG8_STAGE_A(PG8_SA(0, 1), cA, 1, false);
    if (wr == 1) PG8_BAR;
    PG8_WAIT_V(2); PG8_BAR;
    PG8_STAGE(PG8_SB(1, 0), cB + kstep, voffB); PG8_STAGE_A(PG8_SA(1, 0), cA + kstep, 0, false); PG8_STAGE(PG8_SB(1, 1), cB + hstep + kstep, voffB);
    PG8_WAIT_V(6); PG8_BAR;
    for (;;) {
        const bool has_next = S.next(ui + 1, nxt);
        const char* nA = has_next ? nxt.A : cA; const char* nB = has_next ? nxt.B : cB;
#pragma unroll 1
        for (int t = 0; t < nt; t += 2) {
            const bool last = (t == nt - 2);
            const char* a1 = cA + (size_t)(t + 1) * kstep;
            const char* a2 = last ? nA : cA + (size_t)(t + 2) * kstep; const char* b2 = last ? nB : cB + (size_t)(t + 2) * kstep;
            const char* a3 = a2 + kstep; const char* b3 = b2 + kstep;
            PG8_LDB(B0, 0, 0); PG8_LDB(B1, 0, 1); PG8_SCHED; PG8_LDA(At, 0, 0); PG8_STAGE_A(PG8_SA(1, 1), a1, 1, false);
            if constexpr (GATHER) { if (last && has_next) PG8_LOADIDX(cvA, nxt); }
            PG8_WAIT_V(8);
            PG8_WAIT_L(0); PG8_BAR; PG8_MMA(0, 0, At, B0); PG8_MMA(0, 1, At, B1); PG8_BAR; PG8_SCHED;
            PG8_LDA(At, 0, 1); PG8_STAGE(PG8_SB(0, 0), b2, voffB); PG8_STAGE(PG8_SB(0, 1), b2 + hstep, voffB); PG8_STAGE_A(PG8_SA(0, 0), a2, 0, last);
            PG8_WAIT_V(8);
            PG8_WAIT_L(0); PG8_BAR; PG8_MMA(1, 0, At, B0); PG8_MMA(1, 1, At, B1); PG8_BAR; PG8_SCHED;
            PG8_LDB(B0, 1, 0); PG8_LDB(B1, 1, 1); PG8_SCHED; PG8_LDA(At, 1, 0); PG8_STAGE_A(PG8_SA(0, 1), a2, 1, last);
            PG8_WAIT_V(8); PG8_WAIT_L(0); PG8_BAR; PG8_MMA(0, 0, At, B0); PG8_MMA(0, 1, At, B1); PG8_BAR; PG8_SCHED;
            PG8_LDA(At, 1, 1); PG8_STAGE(PG8_SB(1, 0), b3, voffB); PG8_STAGE(PG8_SB(1, 1), b3 + hstep, voffB); PG8_STAGE_A(PG8_SA(1, 0), a3, 0, last);
            PG8_WAIT_V(8); PG8_WAIT_L(0); PG8_BAR; PG8_MMA(1, 0, At, B0); PG8_MMA(1, 1, At, B1); PG8_BAR; PG8_SCHED;
        }
        if (wr == 0) PG8_BAR;
        {
            const int erow = cur.row0 + wr * 64 + fr, ecol = cur.col0 + wc * 32 + 8 * fq;
#define PG8_V8(ai, bj, m) { acc[ai][bj][m][0][0], acc[ai][bj][m][0][1], acc[ai][bj][m][0][2], acc[ai][bj][m][0][3], acc[ai][bj][m][1][0], acc[ai][bj][m][1][1], acc[ai][bj][m][1][2], acc[ai][bj][m][1][3] }
            auto run = [&](const auto& EE, auto KT) {
                typedef typename std::remove_cv<typename std::remove_reference<decltype(EE)>::type>::type EP; constexpr int KIND = decltype(KT)::value;
                if constexpr (pairbj<EP>::value) {
#pragma unroll
                    for (int ai = 0; ai < 2; ++ai)
#pragma unroll
                        for (int m = 0; m < 4; ++m) { const float vg[8] = PG8_V8(ai, 0, m); const float vu[8] = PG8_V8(ai, 1, m); EE.apply_pair(erow + ai * HALF + m * 16, ecol, vg, vu); }
                } else if constexpr (EP::PIPE) {
                    typename EP::Cl cl[2]; EE.template colload<KIND>(ecol, cl[0]); EE.template colload<KIND>(ecol + HALF, cl[1]);
                    typename EP::Ld ld[2][4];
#pragma unroll
                    for (int m = 0; m < 4; ++m) EE.template load<KIND>(erow + m * 16, ecol, ld[0][m]);
#pragma unroll
                    for (int gi = 0; gi < 4; ++gi) { const int ai = gi >> 1, bj = gi & 1;
                        if (gi < 3) { const int ai2 = (gi + 1) >> 1, bj2 = (gi + 1) & 1;
#pragma unroll
                            for (int m = 0; m < 4; ++m) EE.template load<KIND>(erow + ai2 * HALF + m * 16, ecol + bj2 * HALF, ld[(gi + 1) & 1][m]); }
#pragma unroll
                        for (int m = 0; m < 4; ++m) { const float v[8] = PG8_V8(ai, bj, m); EE.template apply<KIND>(erow + ai * HALF + m * 16, ecol + bj * HALF, m, v, ld[gi & 1][m], cl[bj]); } }
                } else {
#pragma unroll
                    for (int bj = 0; bj < 2; ++bj) { typename EP::Cl cl; EE.template colload<KIND>(ecol + bj * HALF, cl);
#pragma unroll
                        for (int ai = 0; ai < 2; ++ai)
#pragma unroll
                            for (int mg = 0; mg < 4; mg += epigroup<EP>::value) { typename EP::Ld ld[4];
#pragma unroll
                                for (int m = mg; m < mg + epigroup<EP>::value; ++m) EE.template load<KIND>(erow + ai * HALF + m * 16, ecol + bj * HALF, ld[m]);
#pragma unroll
                                for (int m = mg; m < mg + epigroup<EP>::value; ++m) { const float v[8] = PG8_V8(ai, bj, m); EE.template apply<KIND>(erow + ai * HALF + m * 16, ecol + bj * HALF, m, v, ld[m], cl); } } }
                }
            };
            if (cur.mode == 3) run(E2, KindTag<0>{});
            else if (PAIRED && cur.mode == 1) {
                if constexpr (PAIRED) {
#pragma unroll
                for (int bj = 0; bj < 2; ++bj)
#pragma unroll
                    for (int ai = 0; ai < 2; ++ai) { typename Epi::Ld ld[4];
#pragma unroll
                        for (int m = 0; m < 4; ++m) E.midload(erow + ai * HALF + m * 16, ecol + bj * HALF, ld[m]);
#pragma unroll
                        for (int m = 0; m < 4; ++m) { float v[8] = PG8_V8(ai, bj, m); E.mid(v, ld[m]);
                            acc[ai][bj][m][0] = (f32x4){v[0], v[1], v[2], v[3]}; acc[ai][bj][m][1] = (f32x4){v[4], v[5], v[6], v[7]}; } }
                }
            } else if constexpr (Epi::NKIND == 1) run(E, KindTag<0>{});
            else { const int kd = __builtin_amdgcn_readfirstlane(E.kind(cur.col0));
                if (kd == 0) run(E, KindTag<0>{}); else if (kd == 1) run(E, KindTag<1>{});
                else if constexpr (Epi::NKIND > 2) { if (kd == 2) run(E, KindTag<2>{}); else run(E, KindTag<3>{}); } }
#undef PG8_V8
        }
        if (!has_next) break;
        if (!PAIRED || cur.mode != 1) {
#pragma unroll
        for (int a = 0; a < 2; ++a)
#pragma unroll
            for (int b = 0; b < 2; ++b)
#pragma unroll
                for (int m = 0; m < 4; ++m)
#pragma unroll
                    for (int n = 0; n < 2; ++n) acc[a][b][m][n] = (f32x4){0.f, 0.f, 0.f, 0.f};
        }
        cur = nxt; cA = nA; cB = nB; ++ui;
        if (wr == 1) PG8_BAR;
    }
    PG8_WAIT_V(0);
    PG8_BAR;
#undef PG8_SA
#undef PG8_SB
#undef PG8_STAGE
#undef PG8_STAGE_A
#undef PG8_LOADIDX
#undef PG8_LDA
#undef PG8_LDB
#undef PG8_MMA
#undef PG8_WAIT_V
#undef PG8_WAIT_L
#undef PG8_BAR
#undef PG8_SCHED
}
template <bool GATHER, bool PAIRED, class Epi, class Sched>
__device__ __forceinline__ void gemm_phase(LAS unsigned char* lds, const int K, const Sched& S, const Epi& E) { gemm_phase2<GATHER, PAIRED, false>(lds, K, S, E, E); }
}
template <class Epi>
__device__ __forceinline__ void fgemm_dense(LAS unsigned char* lds, const bf16* A, const bf16* Bt, int M, int N, int K, const Epi& epi) {
    pg8::DenseOrder S; S.init(A, Bt, M, N, K);
    pg8::gemm_phase<false, false>(lds, K, S, epi);
}
template <class Epi>
__device__ __forceinline__ void fgemm_paired(LAS unsigned char* lds, const bf16* A1, const bf16* B1, const bf16* A2, const bf16* B2, int M, int N, int K, const Epi& epi) {
    pg8::PairedOrder S; S.d.init(A1, B1, M, N, K); S.A2 = (const char*)A2; S.B2 = (const char*)B2;
    pg8::gemm_phase<false, true>(lds, K, S, epi);
}

__device__ __forceinline__ void scan_hgrn(const Args& a, LAS unsigned char* lds, int b, int h, bool meta_only) {
    unsigned char* ws = a.ws; const int tid = threadIdx.x, v = tid >> 2, kq = tid & 3;
    LAS float* qs = (LAS float*)lds; LAS float* fs = qs + 16 * 128;
    const float* meta = (const float*)(ws + WS_META);
    bf16* QA = (bf16*)(ws + WS_QA); const bf16* LFA = (const bf16*)(ws + WS_LFA); const bf16* IA = (const bf16*)(ws + WS_IA);
    float S[32];
#pragma unroll
    for (int j = 0; j < 32; ++j) S[j] = 0.f;
    for (int blk = -1; blk < SEQ / 16; ++blk) {
        __syncthreads();
        for (int i = tid; i < 16 * 128; i += 512) { const int s = i >> 7, k = i & 127;
            if (blk < 0) { qs[i] = meta[0 * 16384 + s * 1024 + h * 128 + k]; fs[i] = __expf(meta[1 * 16384 + s * 1024 + h * 128 + k]); }
            else { const size_t t = (size_t)b * SEQ + blk * 16 + s; qs[i] = bf2f(QA[t * D + h * 128 + k]); fs[i] = __expf(h2f(LFA[t * D + h * 128 + k])); } }
        __syncthreads();
        for (int s = 0; s < 16; ++s) {
            float vt; size_t t = 0;
            if (blk < 0) vt = meta[2 * 16384 + s * 1024 + h * 128 + v]; else { t = (size_t)b * SEQ + blk * 16 + s; vt = bf2f(IA[t * D + h * 128 + v]); }
            float o = 0.f;
#pragma unroll
            for (int j = 0; j < 32; ++j) { const float f = fs[s * 128 + kq * 32 + j], q = qs[s * 128 + kq * 32 + j]; S[j] = f * S[j] + (1.0f - f) * vt; o += S[j] * q; }
            o += __shfl_xor(o, 1); o += __shfl_xor(o, 2);
            if (blk >= 0 && kq == 0) QA[t * D + h * 128 + v] = (bf16)f2bf(o);
        }
        if (meta_only) { float* sm = (float*)(ws + WS_SMETA) + (size_t)h * 128 * 128;
#pragma unroll
            for (int j = 0; j < 32; ++j) sm[(kq * 32 + j) * 128 + v] = S[j];
            break; }
    }
}
__device__ __forceinline__ void scan_mlstm(const Args& a, LAS unsigned char* lds, int b, int h, bool meta_only) {
    unsigned char* ws = a.ws; const int tid = threadIdx.x, v = tid >> 1, kh = tid & 1;
    LAS float* qs = (LAS float*)lds; LAS float* ks = qs + 16 * 128; LAS float* raw = ks + 16 * 128; LAS float* sc = raw + 19 * 256;
    const float* meta = (const float*)(ws + WS_META); const float* igfg = (const float*)(ws + WS_IGFG);
    const bf16* QKB = (const bf16*)(ws + WS_QKB); bf16* VB = (bf16*)(ws + WS_VB);
    const float* cw = a.in[7]; const float* cb = a.in[8]; const float igb = a.in[9][h], fgb = a.in[10][h];
    float C[64], n[64];
#pragma unroll
    for (int j = 0; j < 64; ++j) { C[j] = 0.f; n[j] = 0.f; }
    float M = 0.f;
    for (int blk = -1; blk < SEQ / 16; ++blk) {
        __syncthreads();
        for (int i = tid; i < 19 * 256; i += 512) { const int r = i >> 8, c = i & 255; const int ch = (c < 128) ? h * 128 + c : 512 + h * 128 + (c - 128);
            float val;
            if (blk < 0) { const int mr = r - 3; val = mr >= 0 ? meta[3 * 16384 + mr * 1024 + ch] : 0.f; }
            else { const int tt = blk * 16 + r - 3; val = tt >= 0 ? bf2f(QKB[((size_t)b * SEQ + tt) * D + ch]) : meta[3 * 16384 + (16 + tt) * 1024 + ch]; }
            raw[i] = val; }
        if (tid < 16) { float ig, fg;
            if (blk < 0) { ig = meta[5 * 16384 + tid * 8 + h]; fg = meta[5 * 16384 + tid * 8 + 4 + h]; }
            else { const size_t t = (size_t)b * SEQ + blk * 16 + tid; ig = igfg[t * 8 + h]; fg = igfg[t * 8 + 4 + h]; }
            ig += igb; fg += fgb;
            sc[tid] = ig; sc[16 + tid] = fminf(fg, 0.f) - log1pf(__expf(-fabsf(fg))); }
        __syncthreads();
        for (int i = tid; i < 16 * 256; i += 512) { const int s = i >> 8, c = i & 255; const int ch = (c < 128) ? h * 128 + c : 512 + h * 128 + (c - 128);
            float y = cb[ch];
#pragma unroll
            for (int j = 0; j < 4; ++j) y += cw[j * 1024 + ch] * raw[(s + j) * 256 + c];
            y = siluf_(y);
            if (c < 128) qs[s * 128 + c] = y * 0.08838834764831845f; else ks[s * 128 + c - 128] = y; }
        __syncthreads();
        for (int s = 0; s < 16; ++s) {
            float vt; size_t t = 0;
            if (blk < 0) vt = meta[4 * 16384 + s * 1024 + h * 256 + v]; else { t = (size_t)b * SEQ + blk * 16 + s; vt = bf2f(VB[t * D + h * 256 + v]); }
            const float ig = sc[s], lf = sc[16 + s]; const float Mn = fmaxf(lf + M, ig), fd = __expf(lf + M - Mn), iw = __expf(ig - Mn); M = Mn;
            float num = 0.f, den = 0.f; const float iv = iw * vt;
#pragma unroll
            for (int j = 0; j < 64; ++j) { const float kv = ks[s * 128 + kh * 64 + j], q = qs[s * 128 + kh * 64 + j]; C[j] = fd * C[j] + iv * kv; n[j] = fd * n[j] + iw * kv; num += C[j] * q; den += n[j] * q; }
            num += __shfl_xor(num, 1); den += __shfl_xor(den, 1);
            const float hv = num / fmaxf(fabsf(den), __expf(-M));
            if (blk >= 0 && kh == 0) VB[t * D + h * 256 + v] = (bf16)f2bf(hv);
        }
        if (meta_only) { float* cm = (float*)(ws + WS_CMETA) + (size_t)h * 128 * 256; float* nm = (float*)(ws + WS_NMETA);
#pragma unroll
            for (int j = 0; j < 64; ++j) { cm[(kh * 64 + j) * 256 + v] = C[j]; if (v == 0) nm[h * 128 + kh * 64 + j] = n[j]; }
            if (tid == 0) nm[1024 + h] = M;
            break; }
    }
}

__device__ __forceinline__ void s0_hgrn_prep(const Args& a) {
    unsigned char* ws = a.ws;
    for (int it = blockIdx.x * 512 + threadIdx.x; it < 1024 * 128; it += gridDim.x * 512) {
        const int oct = it & 127, cg = it >> 7; const size_t base = (size_t)cg * 64 * D + oct * 8;
        bf16* Q = (bf16*)(ws + WS_QA) + base; bf16* L = (bf16*)(ws + WS_LFA) + base;
        float r[8], bc[8];
#pragma unroll
        for (int j = 0; j < 8; ++j) { r[j] = 0.f; bc[j] = 0.f; }
#pragma unroll 4
        for (int s = 0; s < 32; ++s) { const u32x4 w = *(const u32x4*)(L + (size_t)s * D);
#pragma unroll
            for (int i = 0; i < 4; ++i) { r[2 * i] += h2f(w[i] & 0xffffu); r[2 * i + 1] += h2f(w[i] >> 16); } }
#pragma unroll 2
        for (int s = 0; s < 64; ++s) { const u32x4 wl = *(const u32x4*)(L + (size_t)s * D), wq = *(const u32x4*)(Q + (size_t)s * D); float qt[8], kt[8];
#pragma unroll
            for (int i = 0; i < 4; ++i) {
#pragma unroll
                for (int hh = 0; hh < 2; ++hh) { const int j = 2 * i + hh; const float lf = h2f(hh ? (wl[i] >> 16) : (wl[i] & 0xffffu)), q = bf2f(hh ? (wq[i] >> 16) : (wq[i] & 0xffffu));
                    bc[j] += lf; qt[j] = q * __expf(fminf(bc[j] - r[j], 80.f)); kt[j] = -expm1f(lf) * __expf(fminf(r[j] - bc[j], 80.f)); } }
            store8_bf16(Q + (size_t)s * D, qt); store8_bf16(L + (size_t)s * D, kt); }
        float* em = (float*)(ws + WS_EM) + (size_t)cg * 1024 + oct * 8; float* el = (float*)(ws + WS_EL) + (size_t)cg * 1024 + oct * 8;
        *(f32x4*)em = (f32x4){__expf(r[0]), __expf(r[1]), __expf(r[2]), __expf(r[3])}; *(f32x4*)(em + 4) = (f32x4){__expf(r[4]), __expf(r[5]), __expf(r[6]), __expf(r[7])};
        *(f32x4*)el = (f32x4){__expf(bc[0] - r[0]), __expf(bc[1] - r[1]), __expf(bc[2] - r[2]), __expf(bc[3] - r[3])}; *(f32x4*)(el + 4) = (f32x4){__expf(bc[4] - r[4]), __expf(bc[5] - r[5]), __expf(bc[6] - r[6]), __expf(bc[7] - r[7])};
    }
}
__device__ __forceinline__ void s0_mlstm_conv(const Args& a) {
    unsigned char* ws = a.ws; const float* cw = a.in[7]; const float* cb = a.in[8]; const float* meta = (const float*)(ws + WS_META);
    for (int it = blockIdx.x * 512 + threadIdx.x; it < 1024 * 128; it += gridDim.x * 512) {
        const int oct = it & 127, cg = it >> 7, ch = oct * 8; bf16* X = (bf16*)(ws + WS_QKB) + (size_t)cg * 64 * D + ch;
        float w0[8], w1[8], w2[8], c0[8], c1[8], c2[8], c3[8], bb[8];
#pragma unroll
        for (int j = 0; j < 8; ++j) { c0[j] = cw[ch + j]; c1[j] = cw[1024 + ch + j]; c2[j] = cw[2048 + ch + j]; c3[j] = cw[3072 + ch + j]; bb[j] = cb[ch + j]; }
        if ((cg & 127) == 0) {
#pragma unroll
            for (int j = 0; j < 8; ++j) { w0[j] = meta[3 * 16384 + 13 * 1024 + ch + j]; w1[j] = meta[3 * 16384 + 14 * 1024 + ch + j]; w2[j] = meta[3 * 16384 + 15 * 1024 + ch + j]; }
        } else { const bf16* hp = (const bf16*)(ws + WS_HALO) + (size_t)(cg - 1) * 3 * D + ch; load8_bf16(hp, w0); load8_bf16(hp + D, w1); load8_bf16(hp + 2 * D, w2); }
        const bool isq = ch < 512; const int hh = (ch & 511) >> 7; const f32x4* gates = (const f32x4*)(ws + WS_GATES);
        const float scale = isq ? 0.08838834764831845f : 1.0f;
#pragma unroll 2
        for (int s = 0; s < 64; ++s) { float x[8], y[8]; load8_bf16(X + (size_t)s * D, x);
            const f32x4 gt = gates[((size_t)cg * 64 + s) * 4 + hh]; const float rs_ = scale * (isq ? gt.x : gt.y);
#pragma unroll
            for (int j = 0; j < 8; ++j) { const float t = bb[j] + c0[j] * w0[j] + c1[j] * w1[j] + c2[j] * w2[j] + c3[j] * x[j]; y[j] = siluf_(t) * rs_; w0[j] = w1[j]; w1[j] = w2[j]; w2[j] = x[j]; }
            store8_bf16(X + (size_t)s * D, y); }
    }
}
__device__ __forceinline__ float logsigmoidf_(float x) { return fminf(x, 0.f) - log1pf(__expf(-fabsf(x))); }
__device__ __forceinline__ void s0_mlstm_gates(const Args& a, LAS unsigned char* lds, int b, int h) {
    unsigned char* ws = a.ws; const int tid = threadIdx.x, lane = tid & 63, wave = tid >> 6; const float igb = a.in[9][h], fgb = a.in[10][h];
    const float* meta = (const float*)(ws + WS_META); const float* igfg = (const float*)(ws + WS_IGFG); f32x4* gates = (f32x4*)(ws + WS_GATES);
    LAS float* sum = (LAS float*)lds;
    LAS float* mc = sum + 256;
    float bcv[16], pmv[16], igv[16];
    __syncthreads();
#pragma unroll
    for (int i = 0; i < 16; ++i) {
        const int c = wave * 16 + i; const size_t t = (size_t)b * SEQ + c * 64 + lane;
        const float ig = igfg[t * 8 + h] + igb, lf = logsigmoidf_(igfg[t * 8 + 4 + h] + fgb);
        float bc = lf;
#pragma unroll
        for (int o = 1; o < 64; o <<= 1) { const float u = __shfl_up(bc, o); if (lane >= o) bc += u; }
        float pm = ig - bc;
#pragma unroll
        for (int o = 1; o < 64; o <<= 1) { const float u = __shfl_up(pm, o); if (lane >= o) pm = fmaxf(pm, u); }
        bcv[i] = bc; pmv[i] = pm; igv[i] = ig;
        if (lane == 63) { sum[2 * c] = bc; sum[2 * c + 1] = pm; }
    }
    __syncthreads();
    if (tid == 0) { float Mc = 0.f;
        for (int s = 0; s < 16; ++s) { const float ig = meta[5 * 16384 + s * 8 + h] + igb, lf = logsigmoidf_(meta[5 * 16384 + s * 8 + 4 + h] + fgb); Mc = fmaxf(lf + Mc, ig); }
        for (int c = 0; c < 128; ++c) { mc[c] = Mc; Mc = sum[2 * c] + fmaxf(Mc, sum[2 * c + 1]); } }
    __syncthreads();
#pragma unroll
    for (int i = 0; i < 16; ++i) { const int c = wave * 16 + i; const size_t t = (size_t)b * SEQ + c * 64 + lane;
        const float Mt = bcv[i] + fmaxf(mc[c], pmv[i]), bL = __shfl(bcv[i], 63), ML = __shfl(Mt, 63);
        gates[t * 4 + h] = (f32x4){__expf(bcv[i] - Mt - bL + ML), __expf(igv[i] - bcv[i] + bL - ML), __expf(-Mt), __expf(bL + mc[c] - ML)}; }
    __syncthreads();
}
__device__ __forceinline__ void s0_prepass(const Args& a, LAS unsigned char* lds) {
    s0_hgrn_prep(a);
    s0_mlstm_conv(a);
    for (int u = blockIdx.x; u < 12; u += gridDim.x) {
        if (u < 8) scan_hgrn(a, lds, 0, u, true);
        else scan_mlstm(a, lds, 0, u - 8, true); }
}

typedef short v4i16_t __attribute__((ext_vector_type(4)));
typedef short bf16x8_t __attribute__((ext_vector_type(8)));
__device__ __forceinline__ v4i16_t tr16(LAS unsigned char* p) { return __builtin_amdgcn_ds_read_tr16_b64_v4i16((LAS v4i16_t*)p); }
__device__ __forceinline__ bf16x8_t cat44(v4i16_t a, v4i16_t b) { return (bf16x8_t){a[0], a[1], a[2], a[3], b[0], b[1], b[2], b[3]}; }
__device__ __forceinline__ bf16x8_t pack8(f32x4 a, f32x4 b) { const u32x4 w = {pk2(a.x, a.y), pk2(a.z, a.w), pk2(b.x, b.y), pk2(b.z, b.w)}; return __builtin_bit_cast(bf16x8_t, w); }
__device__ __forceinline__ bf16x8_t cat22(u32x2 a, u32x2 b) { const u32x4 w = {a.x, a.y, b.x, b.y}; return __builtin_bit_cast(bf16x8_t, w); }
constexpr int SC_QT = 0, SC_KT = 17408, SC_VT = 34816, SC_PT = 44032, SC_EM = 53248, SC_EL = 53760, SC_QS = 272, SC_VS = 144;

constexpr int S3_SET = 45056, S3_P = 90112, S3_ST = 99328;
__device__ __forceinline__ void fscan3_hgrn(const Args& a, LAS unsigned char* lds, int b, int h, int vh) {
    unsigned char* ws = a.ws; const int tid = threadIdx.x, lane = tid & 63, w = tid >> 6, fr = lane & 15, g = lane >> 4, q4 = fr >> 2, p4 = fr & 3;
    const bf16* QA = (const bf16*)(ws + WS_QA); const bf16* KA = (const bf16*)(ws + WS_LFA); bf16* IA = (bf16*)(ws + WS_IA);
    const float* EMg = (const float*)(ws + WS_EM); const float* ELg = (const float*)(ws + WS_EL);
    const int vt = w & 3, th = w >> 2, tt = w & 3, sh = w >> 2;
    f32x4 S[8];
    { const float* sm = (const float*)(ws + WS_SMETA) + (size_t)h * 128 * 128 + vh * 64 + vt * 16 + fr;
#pragma unroll
      for (int kt = 0; kt < 8; ++kt)
#pragma unroll
          for (int r = 0; r < 4; ++r) S[kt][r] = sm[(16 * kt + 4 * g + r) * 128]; }
    const int r0 = tid >> 4, c0 = tid & 15, rv = tid >> 3, cv = tid & 7;
    u32x4 pq0, pq1, pk0, pk1, pv; f32x4 pe;
#define HG_FETCH(c) do { const size_t t0 = (size_t)b * SEQ + (size_t)(c) * 64; \
        pq0 = *(const u32x4*)(QA + (t0 + r0) * D + h * 128 + c0 * 8); pq1 = *(const u32x4*)(QA + (t0 + r0 + 32) * D + h * 128 + c0 * 8); \
        pk0 = *(const u32x4*)(KA + (t0 + r0) * D + h * 128 + c0 * 8); pk1 = *(const u32x4*)(KA + (t0 + r0 + 32) * D + h * 128 + c0 * 8); \
        pv = *(const u32x4*)(IA + (t0 + rv) * D + h * 128 + vh * 64 + cv * 8); \
        if (tid < 64) { const size_t cgi = ((size_t)b * 128 + (c)) * 1024 + h * 128; pe = *(const f32x4*)((tid < 32 ? EMg : ELg) + cgi + (tid & 31) * 4); } } while (0)
#define HG_COMMIT(sb) do { LAS unsigned char* B_ = lds + (sb); *(LAS u32x4*)(B_ + r0 * SC_QS + c0 * 16) = pq0; *(LAS u32x4*)(B_ + (r0 + 32) * SC_QS + c0 * 16) = pq1; \
        *(LAS u32x4*)(B_ + 17408 + r0 * SC_QS + c0 * 16) = pk0; *(LAS u32x4*)(B_ + 17408 + (r0 + 32) * SC_QS + c0 * 16) = pk1; \
        *(LAS u32x4*)(B_ + 34816 + rv * SC_VS + cv * 16) = pv; \
        if (tid < 64) *(LAS f32x4*)(B_ + (tid < 32 ? 44032 : 44544) + (tid & 31) * 16) = pe; } while (0)
    __syncthreads();
    HG_FETCH(0); HG_COMMIT(0);
    __syncthreads();
    for (int c = 0; c < SEQ / 64; ++c) {
        const int sb = (c & 1) * S3_SET;
        LAS unsigned char* Q_ = lds + sb; LAS unsigned char* K_ = Q_ + 17408; LAS unsigned char* V_ = Q_ + 34816; LAS unsigned char* P_ = lds + S3_P;
        if (c + 1 < SEQ / 64) HG_FETCH(c + 1);
        {
            bf16x8_t bq[4];
#pragma unroll
            for (int ks = 0; ks < 4; ++ks) bq[ks] = *(const LAS bf16x8_t*)(Q_ + (tt * 16 + fr) * SC_QS + ks * 64 + g * 16);
#pragma unroll
            for (int si = 0; si < 2; ++si) { const int st = 2 * sh + si; f32x4 acc = {0.f, 0.f, 0.f, 0.f};
#pragma unroll
                for (int ks = 0; ks < 4; ++ks) { const bf16x8_t ak = *(const LAS bf16x8_t*)(K_ + (st * 16 + fr) * SC_QS + ks * 64 + g * 16); acc = __builtin_amdgcn_mfma_f32_16x16x32_bf16(ak, bq[ks], acc, 0, 0, 0); }
                const int t = tt * 16 + fr, s0 = st * 16 + 4 * g; u32x2 pw;
                pw.x = pk2(s0 + 0 <= t ? acc[0] : 0.f, s0 + 1 <= t ? acc[1] : 0.f); pw.y = pk2(s0 + 2 <= t ? acc[2] : 0.f, s0 + 3 <= t ? acc[3] : 0.f);
                *(LAS u32x2*)(P_ + t * SC_VS + s0 * 2) = pw; }
        }
        __syncthreads();
        {
            bf16x8_t afr[4], vfr[2];
#pragma unroll
            for (int kt = 0; kt < 8; ++kt) S[kt] = S[kt] * *(const LAS f32x4*)(Q_ + 44032 + (16 * kt + 4 * g) * 4);
#pragma unroll
            for (int ks = 0; ks < 4; ++ks) afr[ks] = pack8(S[2 * ks], S[2 * ks + 1]);
#pragma unroll
            for (int k2 = 0; k2 < 2; ++k2) { LAS unsigned char* pa = V_ + (32 * k2 + 8 * g + q4) * SC_VS + (vt * 16 + 4 * p4) * 2; vfr[k2] = cat44(tr16(pa), tr16(pa + 4 * SC_VS)); }
            const size_t t0 = (size_t)b * SEQ + (size_t)c * 64;
#pragma unroll
            for (int ti = 0; ti < 2; ++ti) { const int t = (2 * th + ti) * 16 + fr; f32x4 acc = {0.f, 0.f, 0.f, 0.f};
#pragma unroll
                for (int ks = 0; ks < 4; ++ks) { const u32x2 lo = *(const LAS u32x2*)(Q_ + t * SC_QS + (32 * ks + 4 * g) * 2), hi = *(const LAS u32x2*)(Q_ + t * SC_QS + (32 * ks + 16 + 4 * g) * 2);
                    acc = __builtin_amdgcn_mfma_f32_16x16x32_bf16(afr[ks], cat22(lo, hi), acc, 0, 0, 0); }
#pragma unroll
                for (int k2 = 0; k2 < 2; ++k2) { const bf16x8_t pf = *(const LAS bf16x8_t*)(P_ + t * SC_VS + (32 * k2 + 8 * g) * 2); acc = __builtin_amdgcn_mfma_f32_16x16x32_bf16(vfr[k2], pf, acc, 0, 0, 0); }
                u32x2 ow; ow.x = pk2(acc[0], acc[1]); ow.y = pk2(acc[2], acc[3]);
                *(u32x2*)(IA + (t0 + t) * D + h * 128 + vh * 64 + vt * 16 + 4 * g) = ow;
                float sq = (acc[0] * acc[0] + acc[1] * acc[1]) + (acc[2] * acc[2] + acc[3] * acc[3]); sq += __shfl_xor(sq, 16); sq += __shfl_xor(sq, 32);
                if (g == 0) *(LAS float*)(lds + S3_ST + (vt * 64 + t) * 4) = sq; }
#pragma unroll
            for (int kt = 0; kt < 8; ++kt) {
#pragma unroll
                for (int k2 = 0; k2 < 2; ++k2) { LAS unsigned char* pa = K_ + (32 * k2 + 8 * g + q4) * SC_QS + (16 * kt + 4 * p4) * 2; const bf16x8_t ak = cat44(tr16(pa), tr16(pa + 4 * SC_QS));
                    S[kt] = __builtin_amdgcn_mfma_f32_16x16x32_bf16(ak, vfr[k2], S[kt], 0, 0, 0); }
                S[kt] = S[kt] * *(const LAS f32x4*)(Q_ + 44544 + (16 * kt + 4 * g) * 4); }
        }
        if (c + 1 < SEQ / 64) HG_COMMIT(S3_SET - sb);
        __syncthreads();
        if (tid < 64) { const LAS float* sp = (const LAS float*)(lds + S3_ST) + tid;
            ((float*)(ws + WS_STA2))[((size_t)b * SEQ + (size_t)c * 64 + tid) * 16 + h * 2 + vh] = (sp[0] + sp[64]) + (sp[128] + sp[192]); }
    }
#undef HG_FETCH
#undef HG_COMMIT
}
__device__ __forceinline__ void fscan3_mlstm(const Args& a, LAS unsigned char* lds, int b, int h, int vq) {
    unsigned char* ws = a.ws; const int tid = threadIdx.x, lane = tid & 63, w = tid >> 6, fr = lane & 15, g = lane >> 4, q4 = fr >> 2, p4 = fr & 3;
    const bf16* QK = (const bf16*)(ws + WS_QKB); bf16* VB = (bf16*)(ws + WS_VB); const f32x4* GT = (const f32x4*)(ws + WS_GATES);
    const int vt = w & 3, th = w >> 2, tt = w & 3, sh = w >> 2;
    f32x4 S[8], N[8];
    { const float* cm = (const float*)(ws + WS_CMETA) + (size_t)h * 128 * 256 + vq * 64 + vt * 16 + fr; const float* nm = (const float*)(ws + WS_NMETA) + h * 128;
#pragma unroll
      for (int kt = 0; kt < 8; ++kt)
#pragma unroll
          for (int r = 0; r < 4; ++r) { S[kt][r] = cm[(16 * kt + 4 * g + r) * 256]; N[kt][r] = nm[16 * kt + 4 * g + r]; } }
    const u32x4 onew = {0x3F803F80u, 0x3F803F80u, 0x3F803F80u, 0x3F803F80u}; const bf16x8_t ones = __builtin_bit_cast(bf16x8_t, onew);
    const int r0 = tid >> 4, c0 = tid & 15, rv = tid >> 3, cv = tid & 7;
    u32x4 pq0, pq1, pk0, pk1, pv; f32x4 pe;
#define ML_FETCH(c) do { const size_t t0 = (size_t)b * SEQ + (size_t)(c) * 64; \
        pq0 = *(const u32x4*)(QK + (t0 + r0) * D + h * 128 + c0 * 8); pq1 = *(const u32x4*)(QK + (t0 + r0 + 32) * D + h * 128 + c0 * 8); \
        pk0 = *(const u32x4*)(QK + (t0 + r0) * D + 512 + h * 128 + c0 * 8); pk1 = *(const u32x4*)(QK + (t0 + r0 + 32) * D + 512 + h * 128 + c0 * 8); \
        pv = *(const u32x4*)(VB + (t0 + rv) * D + h * 256 + vq * 64 + cv * 8); \
        if (tid < 64) pe = GT[(t0 + tid) * 4 + h]; } while (0)
#define ML_COMMIT(sb) do { LAS unsigned char* B_ = lds + (sb); *(LAS u32x4*)(B_ + r0 * SC_QS + c0 * 16) = pq0; *(LAS u32x4*)(B_ + (r0 + 32) * SC_QS + c0 * 16) = pq1; \
        *(LAS u32x4*)(B_ + 17408 + r0 * SC_QS + c0 * 16) = pk0; *(LAS u32x4*)(B_ + 17408 + (r0 + 32) * SC_QS + c0 * 16) = pk1; \
        *(LAS u32x4*)(B_ + 34816 + rv * SC_VS + cv * 16) = pv; \
        if (tid < 64) *(LAS f32x4*)(B_ + 44032 + tid * 16) = pe; } while (0)
    __syncthreads();
    ML_FETCH(0); ML_COMMIT(0);
    __syncthreads();
    for (int c = 0; c < SEQ / 64; ++c) {
        const int sb = (c & 1) * S3_SET;
        LAS unsigned char* Q_ = lds + sb; LAS unsigned char* K_ = Q_ + 17408; LAS unsigned char* V_ = Q_ + 34816; LAS unsigned char* G_ = Q_ + 44032; LAS unsigned char* P_ = lds + S3_P;
        if (c + 1 < SEQ / 64) ML_FETCH(c + 1);
        const float decay = (*(const LAS f32x4*)G_).w;
        {
            bf16x8_t bq[4];
#pragma unroll
            for (int ks = 0; ks < 4; ++ks) bq[ks] = *(const LAS bf16x8_t*)(Q_ + (tt * 16 + fr) * SC_QS + ks * 64 + g * 16);
#pragma unroll
            for (int si = 0; si < 2; ++si) { const int st = 2 * sh + si; f32x4 acc = {0.f, 0.f, 0.f, 0.f};
#pragma unroll
                for (int ks = 0; ks < 4; ++ks) { const bf16x8_t ak = *(const LAS bf16x8_t*)(K_ + (st * 16 + fr) * SC_QS + ks * 64 + g * 16); acc = __builtin_amdgcn_mfma_f32_16x16x32_bf16(ak, bq[ks], acc, 0, 0, 0); }
                const int t = tt * 16 + fr, s0 = st * 16 + 4 * g; u32x2 pw;
                pw.x = pk2(s0 + 0 <= t ? acc[0] : 0.f, s0 + 1 <= t ? acc[1] : 0.f); pw.y = pk2(s0 + 2 <= t ? acc[2] : 0.f, s0 + 3 <= t ? acc[3] : 0.f);
                *(LAS u32x2*)(P_ + t * SC_VS + s0 * 2) = pw; }
        }
        __syncthreads();
        {
            bf16x8_t vfr[2];
#pragma unroll
            for (int kt = 0; kt < 8; ++kt) { S[kt] = S[kt] * decay; N[kt] = N[kt] * decay; }
#pragma unroll
            for (int k2 = 0; k2 < 2; ++k2) { LAS unsigned char* pa = V_ + (32 * k2 + 8 * g + q4) * SC_VS + (vt * 16 + 4 * p4) * 2; vfr[k2] = cat44(tr16(pa), tr16(pa + 4 * SC_VS)); }
            const size_t t0 = (size_t)b * SEQ + (size_t)c * 64;
#pragma unroll 1
            for (int ti = 0; ti < 2; ++ti) { const int t = (2 * th + ti) * 16 + fr; f32x4 acc = {0.f, 0.f, 0.f, 0.f}, accd = {0.f, 0.f, 0.f, 0.f};
#pragma unroll
                for (int ks = 0; ks < 4; ++ks) { const bf16x8_t af = pack8(S[2 * ks], S[2 * ks + 1]), an = pack8(N[2 * ks], N[2 * ks + 1]);
                    const u32x2 lo = *(const LAS u32x2*)(Q_ + t * SC_QS + (32 * ks + 4 * g) * 2), hi = *(const LAS u32x2*)(Q_ + t * SC_QS + (32 * ks + 16 + 4 * g) * 2); const bf16x8_t qf = cat22(lo, hi);
                    acc = __builtin_amdgcn_mfma_f32_16x16x32_bf16(af, qf, acc, 0, 0, 0); accd = __builtin_amdgcn_mfma_f32_16x16x32_bf16(an, qf, accd, 0, 0, 0); }
#pragma unroll
                for (int k2 = 0; k2 < 2; ++k2) { const bf16x8_t pf = *(const LAS bf16x8_t*)(P_ + t * SC_VS + (32 * k2 + 8 * g) * 2);
                    acc = __builtin_amdgcn_mfma_f32_16x16x32_bf16(vfr[k2], pf, acc, 0, 0, 0); accd = __builtin_amdgcn_mfma_f32_16x16x32_bf16(ones, pf, accd, 0, 0, 0); }
                const float inv = __builtin_amdgcn_rcpf(fmaxf(fabsf(accd[0]), (*(const LAS f32x4*)(G_ + t * 16)).z));
                const float h0_ = acc[0] * inv, h1_ = acc[1] * inv, h2_ = acc[2] * inv, h3_ = acc[3] * inv;
                u32x2 ow; ow.x = pk2(h0_, h1_); ow.y = pk2(h2_, h3_);
                *(u32x2*)(VB + (t0 + t) * D + h * 256 + vq * 64 + vt * 16 + 4 * g) = ow;
                float s1 = (h0_ + h1_) + (h2_ + h3_), s2 = (h0_ * h0_ + h1_ * h1_) + (h2_ * h2_ + h3_ * h3_);
                s1 += __shfl_xor(s1, 16); s1 += __shfl_xor(s1, 32); s2 += __shfl_xor(s2, 16); s2 += __shfl_xor(s2, 32);
                if (g == 0) { *(LAS float*)(lds + S3_ST + (vt * 64 + t) * 4) = s1; *(LAS float*)(lds + S3_ST + 1024 + (vt * 64 + t) * 4) = s2; } }
#pragma unroll
            for (int kt = 0; kt < 8; ++kt) {
#pragma unroll
                for (int k2 = 0; k2 < 2; ++k2) { LAS unsigned char* pa = K_ + (32 * k2 + 8 * g + q4) * SC_QS + (16 * kt + 4 * p4) * 2; const bf16x8_t ak = cat44(tr16(pa), tr16(pa + 4 * SC_QS));
                    S[kt] = __builtin_amdgcn_mfma_f32_16x16x32_bf16(ak, vfr[k2], S[kt], 0, 0, 0); N[kt] = __builtin_amdgcn_mfma_f32_16x16x32_bf16(ak, ones, N[kt], 0, 0, 0); } }
        }
        if (c + 1 < SEQ / 64) ML_COMMIT(S3_SET - sb);
        __syncthreads();
        if (tid < 128) { const int tk = tid & 63, wh = tid >> 6; const LAS float* sp = (const LAS float*)(lds + S3_ST + wh * 1024) + tk;
            ((float*)(ws + WS_STB2))[(((size_t)b * SEQ + (size_t)c * 64 + tk) * 16 + h * 4 + vq) * 2 + wh] = (sp[0] + sp[64]) + (sp[128] + sp[192]); }
    }
#undef ML_FETCH
#undef ML_COMMIT
}

__device__ __forceinline__ void p_ln1_route(const Args& a, LAS unsigned char* lds) {
    unsigned char* ws = a.ws; const int tid = threadIdx.x, lane = tid & 63, wave = tid >> 6, fr = lane & 15, g = lane >> 4;
    LAS int* hist = (LAS int*)lds; LAS float* rbs = (LAS float*)(lds + 256);
    LAS unsigned char* hw = lds + 1024 + wave * 17408;
    LAS float* st = (LAS float*)(lds + 1024 + 8 * 17408 + wave * 256);
    const bf16* z = (const bf16*)(ws + WS_Z); const bf16* WT = (const bf16*)(ws + WS_WRT);
    bf16* h1 = (bf16*)(ws + WS_H0); float* lnst = (float*)(ws + WS_LNST1);
    int* eidx = (int*)(ws + WS_EIDX); float* gwp = (float*)(ws + WS_GW); int* lpos = (int*)(ws + WS_LPOS); int* wgbase = (int*)(ws + WS_WGBASE);
    unsigned* gcnt = (unsigned*)(ws + WS_CTL) + CW_GCNT;
    for (int tile = blockIdx.x; tile < T / 256; tile += gridDim.x) {
        const int half = tile / (T / 512), m0 = tile * 256 + wave * 32;
        __syncthreads();
        if (tid < 64) { hist[tid] = 0; rbs[tid] = a.in[18][tid]; }
        __syncthreads();
        {
            const f32x4* gp = (const f32x4*)a.in[15] + lane; const f32x4* bp = (const f32x4*)a.in[16] + lane;
            f32x4 gg[4], bb[4]; u32x2 zn[4];
#pragma unroll
            for (int j = 0; j < 4; ++j) { gg[j] = gp[64 * j]; bb[j] = bp[64 * j]; zn[j] = ((const u32x2*)(z + (size_t)m0 * D) + lane)[64 * j]; }
            for (int rr = 0; rr < 32; ++rr) {
                const int m = m0 + rr; f32x4 v[4]; float s = 0.f;
#pragma unroll
                for (int j = 0; j < 4; ++j) { const u32x2 zw = zn[j]; v[j] = (f32x4){bf2f(zw.x & 0xffffu), bf2f(zw.x >> 16), bf2f(zw.y & 0xffffu), bf2f(zw.y >> 16)}; s += (v[j].x + v[j].y) + (v[j].z + v[j].w); }
                if (rr + 1 < 32) {
#pragma unroll
                    for (int j = 0; j < 4; ++j) zn[j] = ((const u32x2*)(z + (size_t)(m + 1) * D) + lane)[64 * j]; }
                const float mean = wave_sum(s) * (1.f / D); float s2 = 0.f;
#pragma unroll
                for (int j = 0; j < 4; ++j) { v[j] = v[j] - mean; s2 += (v[j].x * v[j].x + v[j].y * v[j].y) + (v[j].z * v[j].z + v[j].w * v[j].w); }
                const float rstd = 1.f / sqrtf(wave_sum(s2) * (1.f / D) + EPS);
                unsigned* o4 = (unsigned*)(ws + WS_H8 + (size_t)m * D) + lane;
#pragma unroll
                for (int j = 0; j < 4; ++j) { const f32x4 h = v[j] * rstd * gg[j] + bb[j];
                    int w8 = __builtin_amdgcn_cvt_pk_fp8_f32(h.x, h.y, 0, false); w8 = __builtin_amdgcn_cvt_pk_fp8_f32(h.z, h.w, w8, true); o4[64 * j] = (unsigned)w8; }
                if (lane == 0) { lnst[2 * m] = mean; lnst[2 * m + 1] = rstd; st[2 * rr] = mean; st[2 * rr + 1] = rstd; }
            }
        }
        asm volatile("s_waitcnt lgkmcnt(0)" ::: "memory");
        f32x4 acc[2][4];
#pragma unroll
        for (int mt = 0; mt < 2; ++mt)
#pragma unroll
            for (int n = 0; n < 4; ++n) acc[mt][n] = (f32x4){0.f, 0.f, 0.f, 0.f};
        for (int kc = 0; kc < 8; ++kc) {
            { const int kk = (lane & 31) * 4; const f32x4 g4 = *(const f32x4*)(a.in[15] + kc * 128 + kk), b4 = *(const f32x4*)(a.in[16] + kc * 128 + kk);
#pragma unroll 4
              for (int i = 0; i < 16; ++i) { const int row = 2 * i + (lane >> 5); const u32x2 zw = *(const u32x2*)(z + (size_t)(m0 + row) * D + kc * 128 + kk);
                  const f32x4 z4 = {bf2f(zw.x & 0xffffu), bf2f(zw.x >> 16), bf2f(zw.y & 0xffffu), bf2f(zw.y >> 16)};
                  const float mean = st[2 * row], rstd = st[2 * row + 1]; const f32x4 h = (z4 - mean) * rstd * g4 + b4;
                  u32x2 hi; hi.x = pk2(h.x, h.y); hi.y = pk2(h.z, h.w);
                  const f32x4 hr = {bf2f(hi.x & 0xffffu), bf2f(hi.x >> 16), bf2f(hi.y & 0xffffu), bf2f(hi.y >> 16)}; const f32x4 l4 = h - hr;
                  u32x2 lo; lo.x = pk2(l4.x, l4.y); lo.y = pk2(l4.z, l4.w);
                  *(LAS u32x2*)(hw + row * 272 + kk * 2) = hi; *(LAS u32x2*)(hw + 8704 + row * 272 + kk * 2) = lo; } }
            asm volatile("s_waitcnt lgkmcnt(0)" ::: "memory");
#pragma unroll
            for (int ks = 0; ks < 4; ++ks) {
                bf16x8_t ah[2], al[2];
#pragma unroll
                for (int mt = 0; mt < 2; ++mt) { ah[mt] = *(const LAS bf16x8_t*)(hw + (16 * mt + fr) * 272 + ks * 64 + g * 16); al[mt] = *(const LAS bf16x8_t*)(hw + 8704 + (16 * mt + fr) * 272 + ks * 64 + g * 16); }
#pragma unroll
                for (int n = 0; n < 4; ++n) { const bf16* wp = WT + (size_t)(16 * n + fr) * 1024 + kc * 128 + ks * 32 + g * 8;
                    const bf16x8_t bh = *(const bf16x8_t*)wp, bl = *(const bf16x8_t*)(wp + 65536);
#pragma unroll
                    for (int mt = 0; mt < 2; ++mt) { acc[mt][n] = __builtin_amdgcn_mfma_f32_16x16x32_bf16(ah[mt], bh, acc[mt][n], 0, 0, 0);
                        acc[mt][n] = __builtin_amdgcn_mfma_f32_16x16x32_bf16(al[mt], bh, acc[mt][n], 0, 0, 0); acc[mt][n] = __builtin_amdgcn_mfma_f32_16x16x32_bf16(ah[mt], bl, acc[mt][n], 0, 0, 0); } }
            }
            asm volatile("s_waitcnt lgkmcnt(0)" ::: "memory");
        }
        { LAS float* lg = (LAS float*)hw;
#pragma unroll
          for (int mt = 0; mt < 2; ++mt)
#pragma unroll
              for (int n = 0; n < 4; ++n)
#pragma unroll
                  for (int r = 0; r < 4; ++r) lg[(16 * mt + 4 * g + r) * 65 + 16 * n + fr] = acc[mt][n][r]; }
        asm volatile("s_waitcnt lgkmcnt(0)" ::: "memory");
        if (lane < 32) {
            const LAS float* lg = (const LAS float*)hw + lane * 65; const int m = m0 + lane;
            float bsc[64];
#pragma unroll
            for (int e2 = 0; e2 < 64; ++e2) bsc[e2] = 1.0f / (1.0f + expf(-lg[e2])) + rbs[e2];
            float gs[8];
#pragma unroll
            for (int gi = 0; gi < 8; ++gi) { float m1 = -INFINITY, m2 = -INFINITY;
#pragma unroll
                for (int j = 0; j < 8; ++j) { const float v = bsc[8 * gi + j]; m2 = fmaxf(m2, fminf(m1, v)); m1 = fmaxf(m1, v); }
                gs[gi] = m1 + m2; }
            unsigned selmask = 0;
#pragma unroll
            for (int gi = 0; gi < 8; ++gi) { int rank = 0;
#pragma unroll
                for (int gj = 0; gj < 8; ++gj) rank += (gs[gj] > gs[gi] || (gs[gj] == gs[gi] && gj < gi)) ? 1 : 0;
                selmask |= (rank < 4) ? (1u << gi) : 0u; }
            float tv[8]; int te[8];
#pragma unroll
            for (int i = 0; i < 8; ++i) { tv[i] = -INFINITY; te[i] = 0; }
#pragma unroll
            for (int e2 = 0; e2 < 64; ++e2) { float v = ((selmask >> (e2 >> 3)) & 1u) ? bsc[e2] : -INFINITY; int id = e2;
#pragma unroll
                for (int i = 0; i < 8; ++i) { const bool sw = v > tv[i]; const float tvv = tv[i]; const int tee = te[i]; tv[i] = sw ? v : tvv; te[i] = sw ? id : tee; v = sw ? tvv : v; id = sw ? tee : id; } }
            float sc[8], ssum = 0.f;
#pragma unroll
            for (int i = 0; i < 8; ++i) { sc[i] = tv[i] - rbs[te[i]]; ssum += sc[i]; }
            const float scale = ROUTED_SCALE / ssum;
#pragma unroll
            for (int i = 0; i < 8; ++i) { eidx[(size_t)m * 8 + i] = te[i]; gwp[(size_t)m * 8 + i] = sc[i] * scale; lpos[(size_t)m * 8 + i] = atomicAdd((int*)&hist[te[i]], 1); }
        }
        __syncthreads();
        if (tid < 64) wgbase[tile * 64 + tid] = (int)atomicAdd(&gcnt[half * 64 + tid], (unsigned)hist[tid]);
    }
}
__device__ __forceinline__ void load_pstart(const Args& a, LAS int* ps) {
    const unsigned* gcnt = (const unsigned*)(a.ws + WS_CTL) + CW_GCNT;
    __syncthreads();
    if (threadIdx.x < 2) { const int hf = threadIdx.x; int acc = 0;
        for (int e = 0; e < 64; ++e) { ps[hf * 65 + e] = acc; const int c = (int)__hip_atomic_load(gcnt + hf * 64 + e, __ATOMIC_RELAXED, __HIP_MEMORY_SCOPE_AGENT); acc += (c + 255) / 256 * 256; }
        ps[hf * 65 + 64] = acc; }
    __syncthreads();
}
__device__ __forceinline__ void p_slots(const Args& a, LAS unsigned char* lds) {
    unsigned char* ws = a.ws; LAS int* ps = (LAS int*)lds; load_pstart(a, ps);
    const int* eidx = (const int*)(ws + WS_EIDX); const float* gwp = (const float*)(ws + WS_GW); const int* lpos = (const int*)(ws + WS_LPOS); const int* wgbase = (const int*)(ws + WS_WGBASE);
    int* slotof = (int*)(ws + WS_SLOTOF); int* tokslot = (int*)(ws + WS_TOKSLOT); float* wslot = (float*)(ws + WS_WSLOT);
    for (int tile = blockIdx.x; tile < T / 256; tile += gridDim.x) {
        const int half = tile / (T / 512);
        for (int i = threadIdx.x; i < 256 * 8; i += 512) { const size_t idx = (size_t)tile * 2048 + i; const int e = eidx[idx];
            const int slot = ps[half * 65 + e] + wgbase[tile * 64 + e] + lpos[idx];
            slotof[idx] = slot; tokslot[(size_t)half * NSLOTMAX + slot] = (int)(idx >> 3); wslot[(size_t)half * NSLOTMAX + slot] = gwp[idx]; }
    }
}
template <bool DOWN>
__device__ __forceinline__ void f_moe_gemm(const Args& a, LAS unsigned char* lds, int half) {
    unsigned char* ws = a.ws; LAS int* ps = (LAS int*)(lds + 131072); LAS int* te = (LAS int*)(lds + 131072 + 1024); load_pstart(a, ps);
    const int nrt = __builtin_amdgcn_readfirstlane(ps[half * 65 + 64] / 256);
    for (int rt = threadIdx.x; rt < nrt; rt += 512) { int e = 0; for (int j = 1; j < 64; ++j) if (ps[half * 65 + j] <= rt * 256) e = j; te[rt] = e; }
    __syncthreads();
    pg8::GroupedOrder S; S.te = te; S.nct = DOWN ? 4 : 2; S.nrt = nrt; S.nwg1 = nrt * S.nct; S.nwg2 = (HALF_T / 256) * S.nct; S.G = gridDim.x; S.c = blockIdx.x;
    S.idx = (const int*)(ws + WS_TOKSLOT) + (size_t)half * NSLOTMAX; S.ident = (const int*)(ws + WS_IDENT) + half * HALF_T;
    if (!DOWN) { S.K = 512; S.A = (const char*)(ws + WS_H8); S.Bt = (const char*)(ws + WS_WGU); S.Bsh = (const char*)(ws + WS_WSGU); S.estride = (size_t)512 * 1024; S.gather = true;
        const EpiGU eg{(bf16*)(ws + WS_HH)}; pg8::gemm_phase2<true, false, true>(lds, 512, S, eg, eg); }
    else { S.K = 256; S.A = (const char*)(ws + WS_HH); S.Bt = (const char*)(ws + WS_WD); S.Bsh = (const char*)(ws + WS_WSD); S.estride = (size_t)1024 * 256 * 2; S.gather = false;
        pg8::gemm_phase2<false, false, false>(lds, 256, S, EpiDown{(unsigned char*)(ws + WS_YH), (const float*)(ws + WS_WSLOT) + (size_t)half * NSLOTMAX}, EpiSD2{ws, a.out, a.in[15], a.in[16], half * HALF_T}); }
}
__device__ __forceinline__ void p_combine(const Args& a, int half) {
    unsigned char* ws = a.ws; const int lane = threadIdx.x & 63, gw = blockIdx.x * 8 + (threadIdx.x >> 6), NGW = gridDim.x * 8;
    const unsigned char* Y = (const unsigned char*)(ws + WS_YH); const int* slotof = (const int*)(ws + WS_SLOTOF);
    const f32x4* gp = (const f32x4*)a.in[25] + lane; const f32x4* bp = (const f32x4*)a.in[26] + lane;
    for (int mm = gw; mm < HALF_T; mm += NGW) {
        const int m = half * HALF_T + mm;
        f32x4* rr = (f32x4*)(a.out + (size_t)m * D) + lane; const u32x2* rb16 = (const u32x2*)((const bf16*)(ws + WS_H0) + (size_t)m * D) + lane;
        f32x4 v[4];
#pragma unroll
        for (int j = 0; j < 4; ++j) { const u32x2 rw = rb16[64 * j]; v[j] = (f32x4){bf2f(rw.x & 0xffffu), bf2f(rw.x >> 16), bf2f(rw.y & 0xffffu), bf2f(rw.y >> 16)}; }
        f32x4 ys[4];
#pragma unroll
        for (int j = 0; j < 4; ++j) ys[j] = (f32x4){0.f, 0.f, 0.f, 0.f};
        int sl[8];
#pragma unroll
        for (int k = 0; k < 8; ++k) sl[k] = slotof[(size_t)m * 8 + k];
#pragma unroll
        for (int k = 0; k < 8; ++k) { const unsigned* yr = (const unsigned*)(Y + (size_t)sl[k] * D) + lane;
#pragma unroll
            for (int j = 0; j < 4; ++j) { const int w = (int)yr[64 * j]; const f32x2_t lo = __builtin_amdgcn_cvt_pk_f32_fp8(w, false), hi = __builtin_amdgcn_cvt_pk_f32_fp8(w, true);
                ys[j].x += lo.x; ys[j].y += lo.y; ys[j].z += hi.x; ys[j].w += hi.y; } }
#pragma unroll
        for (int j = 0; j < 4; ++j) v[j] = v[j] + ys[j] * 0.03125f;
        float s = 0.f;
#pragma unroll
        for (int j = 0; j < 4; ++j) s += (v[j].x + v[j].y) + (v[j].z + v[j].w);
        const float mean = wave_sum(s) * (1.f / D); float s2 = 0.f;
#pragma unroll
        for (int j = 0; j < 4; ++j) { v[j] = v[j] - mean; s2 += (v[j].x * v[j].x + v[j].y * v[j].y) + (v[j].z * v[j].z + v[j].w * v[j].w); }
        const float rstd = 1.f / sqrtf(wave_sum(s2) * (1.f / D) + EPS);
#pragma unroll
        for (int j = 0; j < 4; ++j) rr[64 * j] = v[j] * rstd * gp[64 * j] + bp[64 * j];
    }
}

__global__ void __launch_bounds__(512, 2) fwd(Args a) {
    extern __shared__ __attribute__((aligned(16))) unsigned char lds_raw[];
    LAS unsigned char* lds = (LAS unsigned char*)lds_raw;
    unsigned char* ws = a.ws;
    const int lo = a.ph_lo, hi = a.ph_hi;
    volatile LAS unsigned* bst = (volatile LAS unsigned*)(lds + LDS_BYTES - 16);
    if (threadIdx.x == 0) { bst[0] = 0u; bst[1] = 0u; }
    __syncthreads();
    XcdBarrier bar = xcd_barrier_post((unsigned*)(ws + WS_CTL) + CW_BAR, bst);
#ifndef PH_MASK
#define PH_MASK 0xFFFFFFFFu
#endif
#define IN(k) ((((PH_MASK) >> (k)) & 1u) && lo <= (k) && (k) < hi)
#define SEAM(k) do { if (IN(k) && IN((k) + 1)) xcd_barrier(bar); } while (0)
    if (IN(0)) p0_prologue(a, lds);
    SEAM(0);
    if (IN(1)) { for (int u = blockIdx.x; u < 32; u += gridDim.x) s0_mlstm_gates(a, lds, u >> 2, u & 3); }
    if (IN(1)) fgemm_dense(lds, (const bf16*)(ws + WS_H0), (const bf16*)(ws + WS_WINT), T, 7168, 1024, EpiA{ws, (unsigned char*)a.out, a.in[5]});
    SEAM(1);
    if (IN(2)) s0_prepass(a, lds);
    SEAM(2);
    if (IN(3)) { for (int u = blockIdx.x; u < 256; u += gridDim.x) if (u < 128) fscan3_hgrn(a, lds, u >> 4, (u >> 1) & 7, u & 1); }
    asm volatile("" ::: "memory");
    if (IN(3)) { for (int u = blockIdx.x; u < 256; u += gridDim.x) if (u >= 128) fscan3_mlstm(a, lds, (u - 128) >> 4, ((u - 128) >> 2) & 3, (u - 128) & 3); }
    if (IN(3) && IN(5)) xcd_barrier(bar);
    if (IN(5)) fgemm_dense(lds, (const bf16*)(ws + WS_H0), (const bf16*)(ws + WS_WINT) + (size_t)7168 * 1024, T, 2048, 1024, EpiB{ws, a.in[6], a.in[11]});
    SEAM(5);
    if (IN(6)) fgemm_paired(lds, (const bf16*)(ws + WS_LFA), (const bf16*)(ws + WS_WAT), (const bf16*)(ws + WS_QKB), (const bf16*)(ws + WS_WBT), T, 1024, 1024, EpiC{ws, (const bf16*)a.out, (const bf16*)a.out + (size_t)T * D});
    SEAM(6);
    if (IN(7)) fgemm_dense(lds, (const bf16*)(ws + WS_IA), (const bf16*)(ws + WS_WOT), T, 1024, 1024, EpiD{ws, a.out, a.in[0], a.in[2], a.in[3]});
    SEAM(7);
    if (IN(8)) p_ln1_route(a, lds);
    SEAM(8);
    if (IN(9)) p_slots(a, lds);
    SEAM(9);
    if (IN(10)) f_moe_gemm<false>(a, lds, 0);
    SEAM(10);
    if (IN(11)) f_moe_gemm<true>(a, lds, 0);
    SEAM(11);
    if (IN(12)) p_combine(a, 0);
    __syncthreads();
    if (IN(13)) f_moe_gemm<false>(a, lds, 1);
    SEAM(13);
    if (IN(14)) f_moe_gemm<true>(a, lds, 1);
    SEAM(14);
    if (IN(15)) p_combine(a, 1);
#undef IN
#undef SEAM
}

extern "C" void kernel_launch(void* const* d_in, const int* in_sizes, int n_in, void* d_out, int out_size, void* d_ws, size_t ws_size, hipStream_t stream) {
    static int grid = 0;
    if (grid == 0) {
        if (n_in != 27 || out_size != T * D || ws_size < WS_END) { fprintf(stderr, "kernel_launch: unexpected shapes (n_in %d out %d ws %zu)\n", n_in, out_size, ws_size); grid = -1; return; }
        int dev = 0, cus = 0;
        if (hipGetDevice(&dev) != hipSuccess || hipDeviceGetAttribute(&cus, hipDeviceAttributeMultiprocessorCount, dev) != hipSuccess) { grid = -1; return; }
        if (hipFuncSetAttribute((const void*)fwd, hipFuncAttributeMaxDynamicSharedMemorySize, LDS_BYTES) != hipSuccess) { grid = -1; return; }
        int per_cu = 0; (void)hipOccupancyMaxActiveBlocksPerMultiprocessor(&per_cu, (const void*)fwd, 512, LDS_BYTES); (void)hipGetLastError();
        grid = cus;
    }
    if (grid < 0) return;
    (void)hipMemsetAsync((char*)d_ws + WS_CTL + CW_BAR * 4, 0, (CW_GCNT + 128 - CW_BAR) * 4, stream);
    Args a{};
    for (int i = 0; i < 27; ++i) a.in[i] = (const float*)d_in[i];
    a.out = (float*)d_out; a.ws = (unsigned char*)d_ws;
    a.ph_lo = 0; a.ph_hi = 16; hipLaunchKernelGGL(fwd, dim3(grid), dim3(512), LDS_BYTES, stream, a);
}
```

```cpp
#include <hip/hip_runtime.h>
#include <stdint.h>
#include <stdio.h>
#include <type_traits>

#define LAS __attribute__((address_space(3)))
typedef unsigned short bf16;
typedef float f32x4 __attribute__((ext_vector_type(4)));
typedef unsigned u32x4 __attribute__((ext_vector_type(4)));
typedef unsigned u32x2 __attribute__((ext_vector_type(2)));

constexpr int D = 1024, NB = 8, SEQ = 8192, T = NB * SEQ, NMETA = 16, INW = 9224;
constexpr int NEXP = 64, TOPK = 8, DEXP = 256;
constexpr float EPS = 1e-5f, DN_ALPHA = 1.189207115002721f, ROUTED_SCALE = 2.5f;
constexpr int HALF_T = T / 2;
constexpr int NSLOTMAX = HALF_T * TOPK + NEXP * 256;

constexpr size_t MiB = 1u << 20;
constexpr size_t WS_CTL = 0, CTL_ZERO_BYTES = 1 * MiB;
constexpr size_t WS_WINT = 1 * MiB;
constexpr size_t WS_WAT = 19 * MiB, WS_WBT = 21 * MiB, WS_WOT = 23 * MiB;
constexpr size_t WS_WSGU = 25 * MiB;
constexpr size_t WS_WSD = 26 * MiB;
constexpr size_t WS_META = 27 * MiB;
constexpr size_t WS_WRT = 27 * MiB + 512 * 1024;
constexpr size_t WS_IGFG = 28 * MiB;
constexpr size_t WS_LNST0 = 30 * MiB;
constexpr size_t WS_LNST1 = 30 * MiB + 512 * 1024;
constexpr size_t WS_STA = 31 * MiB;
constexpr size_t WS_STB = 33 * MiB;
constexpr size_t WS_EIDX = 35 * MiB, WS_GW = 37 * MiB, WS_LPOS = 39 * MiB, WS_SLOTOF = 41 * MiB;
constexpr size_t WS_TOKSLOT = 43 * MiB;
constexpr size_t WS_WSLOT = 46 * MiB;
constexpr size_t WS_WGBASE = 49 * MiB;
constexpr size_t WS_IDENT = 49 * MiB + 128 * 1024;
constexpr size_t WS_EM = 50 * MiB, WS_EL = 54 * MiB;
constexpr size_t WS_HALO = 58 * MiB;
constexpr size_t WS_GATES = 932 * MiB;
constexpr size_t WS_SMETA = 940 * MiB;
constexpr size_t WS_CMETA = 941 * MiB;
constexpr size_t WS_NMETA = 942 * MiB;
constexpr size_t WS_STA2 = 944 * MiB;
constexpr size_t WS_STB2 = 948 * MiB;
constexpr size_t WS_WGU = 64 * MiB;
constexpr size_t WS_WD = 128 * MiB;
constexpr size_t WS_H0 = 162 * MiB;
constexpr size_t WS_QA = 290 * MiB, WS_LFA = 418 * MiB, WS_IA = 546 * MiB, WS_QKB = 674 * MiB, WS_VB = 802 * MiB;
constexpr size_t WS_HH = 290 * MiB;
constexpr size_t WS_YH = 444 * MiB;
constexpr size_t WS_HS = 980 * MiB;
constexpr size_t WS_Z = 720 * MiB;
constexpr size_t WS_H8 = 850 * MiB;
constexpr size_t WS_END = 1024 * MiB;
static_assert(WS_HH + (size_t)(NSLOTMAX + HALF_T) * 512 <= WS_YH && WS_YH + (size_t)NSLOTMAX * 1024 <= WS_Z && WS_Z + (size_t)T * D * 2 <= WS_GATES, "moe map");
constexpr int CW_BAR = 4096, CW_GCNT = 8192;

constexpr int LDS_BYTES = 147456;
constexpr int NPHASE = 20;

__device__ __forceinline__ unsigned f2bf(float f) { unsigned u = __float_as_uint(f); return (u + 0x7fffu + ((u >> 16) & 1u)) >> 16; }
__device__ __forceinline__ float bf2f(unsigned h) { return __uint_as_float(h << 16); }
typedef __bf16 hwbf16x2_t __attribute__((ext_vector_type(2)));
typedef float f32x2_t __attribute__((ext_vector_type(2)));
__device__ __forceinline__ unsigned pk2(float lo, float hi) { const f32x2_t f = {lo, hi}; const hwbf16x2_t b = __builtin_convertvector(f, hwbf16x2_t); return __builtin_bit_cast(unsigned, b); }
__device__ __forceinline__ unsigned f2h(float f) { _Float16 h = (_Float16)f; return (unsigned)__builtin_bit_cast(unsigned short, h); }
__device__ __forceinline__ float h2f(unsigned u) { return (float)__builtin_bit_cast(_Float16, (unsigned short)u); }
__device__ __forceinline__ float wave_sum(float v) {
#pragma unroll
    for (int o = 1; o < 64; o <<= 1) v += __shfl_xor(v, o);
    return v;
}
__device__ __forceinline__ void store8_bf16(bf16* p, const float (&v)[8]);
__device__ __forceinline__ float sigmoidf_(float x) { return __builtin_amdgcn_rcpf(1.0f + __expf(-x)); }
__device__ __forceinline__ float siluf_(float x) { return x * __builtin_amdgcn_rcpf(1.0f + __expf(-x)); }


#define XB_TMO      128
#define XB_XCNT(j)  (256  + 64 * (j))
#define XB_XSUB(j)  (1280 + 64 * (j))
#define XB_XGEN(j)  (2304 + 64 * (j))
#define XB_TOP      3328
#define XB_TOPGEN   3392
#define XCD_BAR_WORDS 3456
#define XB_SPIN_CAP (1u << 20)
__device__ __forceinline__ unsigned xb_ld(unsigned* p)              { return __hip_atomic_load(p, __ATOMIC_RELAXED, __HIP_MEMORY_SCOPE_AGENT); }
__device__ __forceinline__ unsigned xb_add(unsigned* p, unsigned v) { return __hip_atomic_fetch_add(p, v, __ATOMIC_RELAXED, __HIP_MEMORY_SCOPE_AGENT); }
__device__ __forceinline__ unsigned xb_xcc_id() { return (unsigned)__builtin_amdgcn_s_getreg((3 << 11) | 20) & 0xFu; }
#define XB_SPIN(cond, bar) do { unsigned _sp = 0; while (cond) { __builtin_amdgcn_s_sleep(1); \
    if ((++_sp & 255u) == 0u) { if (xb_ld(&(bar)[XB_TMO])) break; if (_sp > XB_SPIN_CAP) { atomicAdd(&(bar)[XB_TMO], 1u); break; } } } } while (0)
struct XcdBarrier { unsigned* bar; unsigned x; volatile LAS unsigned* st; bool lead; };
__device__ __forceinline__ XcdBarrier xcd_barrier_post(unsigned* bar, volatile LAS unsigned* st, bool lead) {
    XcdBarrier b; b.bar = bar; b.x = xb_xcc_id(); b.st = st; b.lead = lead;
    if (lead) (void)xb_add(&bar[XB_XCNT(b.x)], 1u);
    return b;
}
__device__ __forceinline__ void xcd_barrier_complete(unsigned* bar, unsigned x, unsigned& nloc, unsigned& nx) {
    const unsigned G = gridDim.x * gridDim.y * gridDim.z;
    unsigned sum, cnt, mine, sp = 0u;
    for (;;) {
        sum = 0u; cnt = 0u; mine = 0u;
#pragma unroll
        for (unsigned j = 0; j < 16; ++j) { const unsigned c = xb_ld(&bar[XB_XCNT(j)]); sum += c; cnt += (c > 0u) ? 1u : 0u; mine = (j == x) ? c : mine; }
        if (sum == G) break;
        __builtin_amdgcn_s_sleep(1);
        if ((++sp & 255u) == 0u) { if (xb_ld(&bar[XB_TMO])) break; if (sp > XB_SPIN_CAP) { atomicAdd(&bar[XB_TMO], 1u); break; } }
    }
    nloc = mine > 0u ? mine : 1u; nx = cnt > 0u ? cnt : 1u;
}
__device__ __forceinline__ void xcd_barrier(const XcdBarrier& b) {
    asm volatile("s_waitcnt vmcnt(0)" ::: "memory");
    __syncthreads();
    if (b.lead) {
        unsigned* bar = b.bar;
        __builtin_amdgcn_s_waitcnt(0);
        unsigned nloc = b.st[0], nx = b.st[1];
        if (nloc == 0u) { xcd_barrier_complete(bar, b.x, nloc, nx); b.st[0] = nloc; b.st[1] = nx; }
        const unsigned old = xb_add(&bar[XB_XSUB(b.x)], 1u);
        const unsigned gen = old / nloc;
        if (old + 1u == (gen + 1u) * nloc) {
            __builtin_amdgcn_fence(__ATOMIC_RELEASE, "agent");
            asm volatile("s_waitcnt vmcnt(0)" ::: "memory");
            const unsigned og = xb_add(&bar[XB_TOP], 1u);
            const unsigned tg = og / nx;
            if (og + 1u == (tg + 1u) * nx) xb_add(&bar[XB_TOPGEN], 1u);
            else XB_SPIN(xb_ld(&bar[XB_TOPGEN]) == tg, bar);
            __builtin_amdgcn_fence(__ATOMIC_ACQUIRE, "agent");
            xb_add(&bar[XB_XGEN(b.x)], 1u);
            asm volatile("s_waitcnt vmcnt(0)" ::: "memory");
        } else {
            XB_SPIN(xb_ld(&bar[XB_XGEN(b.x)]) == gen, bar);
            __builtin_amdgcn_fence(__ATOMIC_ACQUIRE, "agent");
            asm volatile("s_waitcnt vmcnt(0)" ::: "memory");
        }
    }
    __syncthreads();
}

struct KArgs { const float* in[27]; float* out; unsigned char* ws; int ph_lo, ph_hi; };
struct Args { const float* const (&in)[27]; float* out; unsigned char* ws; int wv; };
__device__ __forceinline__ int tidx_(int wv) { unsigned z; asm volatile("s_mov_b32 %0, 0" : "=s"(z)); return wv * 64 + (int)__builtin_amdgcn_mbcnt_hi(~0u, __builtin_amdgcn_mbcnt_lo(~0u, z)); }

struct TrDesc { const float* W; bf16* WT; int ldw, K, nblk, item, mode, f8; };
__device__ __forceinline__ void tr_load(const TrDesc& d, f32x4 (&t)[8], int lane) {
    const int kb = d.item / d.nblk, nb = d.item % d.nblk, k0 = 64 * kb, n0 = 32 * nb;
#pragma unroll
    for (int i = 0; i < 8; ++i) t[i] = *(const f32x4*)(d.W + (size_t)(k0 + 8 * i + (lane >> 3)) * d.ldw + n0 + 4 * (lane & 7));
}
__device__ __forceinline__ void tr_store(const TrDesc& d, const f32x4 (&t)[8], LAS float* scr, int lane) {
    const int kb = d.item / d.nblk, nb = d.item % d.nblk, k0 = 64 * kb, n0 = 32 * nb;
#pragma unroll
    for (int i = 0; i < 8; ++i) { LAS float* p = scr + (8 * i + (lane >> 3)) * 33 + 4 * (lane & 7); p[0] = t[i].x; p[1] = t[i].y; p[2] = t[i].z; p[3] = t[i].w; }
    asm volatile("s_waitcnt lgkmcnt(0)" ::: "memory");
    const int c = lane & 7;
#pragma unroll
    for (int j = 0; j < 4; ++j) { const int n = (lane >> 3) + 8 * j; const LAS float* s = scr + (8 * c) * 33 + n;
        u32x4 o; o.x = pk2(s[0 * 33], s[1 * 33]); o.y = pk2(s[2 * 33], s[3 * 33]); o.z = pk2(s[4 * 33], s[5 * 33]); o.w = pk2(s[6 * 33], s[7 * 33]);
        const int nn = n0 + n, row = d.mode == 0 ? nn : (nn >> 7) * 256 + (d.mode - 1) * 128 + (nn & 127);
        if (d.f8) {
            int w0 = __builtin_amdgcn_cvt_pk_fp8_f32(64.f * s[0 * 33], 64.f * s[1 * 33], 0, false); w0 = __builtin_amdgcn_cvt_pk_fp8_f32(64.f * s[2 * 33], 64.f * s[3 * 33], w0, true);
            int w1 = __builtin_amdgcn_cvt_pk_fp8_f32(64.f * s[4 * 33], 64.f * s[5 * 33], 0, false); w1 = __builtin_amdgcn_cvt_pk_fp8_f32(64.f * s[6 * 33], 64.f * s[7 * 33], w1, true);
            *(u32x2*)((unsigned char*)d.WT + (size_t)row * d.K + k0 + 8 * c) = (u32x2){(unsigned)w0, (unsigned)w1}; }
        else *(u32x4*)(d.WT + (size_t)row * d.K + k0 + 8 * c) = o; }
    asm volatile("s_waitcnt lgkmcnt(0)" ::: "memory");
}
__device__ __forceinline__ int win_src_off(int g) {
    switch (g) { case 0: return 0; case 1: return 1024; case 2: return 2048; case 3: return 4096; case 4: return 5120; case 5: return 7176; case 6: return 8200; case 7: return 3072; default: return 6144; }
}

__device__ __forceinline__ void p0_prologue(const Args& a, LAS unsigned char* lds) {
    const int tid = threadIdx.x, lane = tid & 63, wave = tid >> 6;
    unsigned char* ws = a.ws;
    const int gw = blockIdx.x * 8 + wave, NGW = gridDim.x * 8;
    {
        LAS float* scr = (LAS float*)(lds + 32768 + wave * 8704);
        constexpr int NA = 12 * 512, NBt = 130 * 128, NC = 65 * 128, NTOT = NA + NBt + NC;
        auto decode = [&](int it) -> TrDesc { TrDesc d; d.f8 = 0;
            if (it < NA) { const int job = it / 512; d.item = it % 512; d.ldw = job < 9 ? INW : 1024; d.K = 1024; d.nblk = 32; d.mode = 0;
                if (job < 9) { d.W = a.in[4] + win_src_off(job); d.WT = (bf16*)(ws + WS_WINT) + (size_t)job * 1024 * 1024; }
                else { d.W = a.in[12 + (job - 9)]; d.WT = (bf16*)(ws + (job == 9 ? WS_WAT : job == 10 ? WS_WBT : WS_WOT)); } }
            else if (it < NA + NBt) { const int r = it - NA, job = r / 128; d.item = r % 128; d.ldw = 256; d.K = 1024; d.nblk = 8;
                d.f8 = 1;
                if (job < 128) { const int e = job & 63, up = job >> 6; d.mode = 1 + up; d.W = a.in[19 + up] + (size_t)e * 1024 * 256; d.WT = (bf16*)(ws + WS_WGU + (size_t)e * 512 * 1024); }
                else { const int up = job - 128; d.mode = 1 + up; d.W = a.in[22 + up]; d.WT = (bf16*)(ws + WS_WSGU); } }
            else { const int r = it - NA - NBt, job = r / 128; d.item = r % 128; d.ldw = 1024; d.K = 256; d.nblk = 32; d.mode = 0; d.f8 = 1;
                if (job < 64) { d.W = a.in[21] + (size_t)job * 256 * 1024; d.WT = (bf16*)(ws + WS_WD + (size_t)job * 1024 * 256); }
                else { d.W = a.in[24]; d.WT = (bf16*)(ws + WS_WSD); } }
            return d; };
        if (gw < NTOT) {
            TrDesc d0 = decode(gw); f32x4 t0[8]; tr_load(d0, t0, lane);
            for (int it = gw; it < NTOT; it += NGW) {
                TrDesc d1 = d0; f32x4 t1[8]; const bool more = it + NGW < NTOT;
                if (more) { d1 = decode(it + NGW); tr_load(d1, t1, lane); }
                tr_store(d0, t0, scr, lane);
                if (more) { d0 = d1;
#pragma unroll
                    for (int i = 0; i < 8; ++i) t0[i] = t1[i]; }
            }
        }
    }
    __syncthreads();
    LAS float* Wg8 = (LAS float*)lds;
    for (int i = tid; i < 1024 * 8; i += 512) Wg8[i] = a.in[4][(size_t)(i >> 3) * INW + 7168 + (i & 7)];
    __syncthreads();
    {
        const float* x = a.in[0]; const f32x4* gp = (const f32x4*)a.in[2] + lane; const f32x4* bp = (const f32x4*)a.in[3] + lane;
        f32x4 g[4], b[4];
#pragma unroll
        for (int j = 0; j < 4; ++j) { g[j] = gp[64 * j]; b[j] = bp[64 * j]; }
        bf16* h0 = (bf16*)(ws + WS_H0); float* lnst = (float*)(ws + WS_LNST0); float* igfg = (float*)(ws + WS_IGFG);
        f32x4 vn[4];
        if (gw < T) { const f32x4* xr = (const f32x4*)(x + (size_t)gw * D) + lane;
#pragma unroll
            for (int j = 0; j < 4; ++j) vn[j] = xr[64 * j]; }
        for (int m = gw; m < T; m += NGW) {
            f32x4 v[4]; float s = 0.f;
#pragma unroll
            for (int j = 0; j < 4; ++j) { v[j] = vn[j]; s += (v[j].x + v[j].y) + (v[j].z + v[j].w); }
            if (m + NGW < T) { const f32x4* xr = (const f32x4*)(x + (size_t)(m + NGW) * D) + lane;
#pragma unroll
                for (int j = 0; j < 4; ++j) vn[j] = xr[64 * j]; }
            const float mean = wave_sum(s) * (1.f / D); float s2 = 0.f;
#pragma unroll
            for (int j = 0; j < 4; ++j) { v[j] = v[j] - mean; s2 += (v[j].x * v[j].x + v[j].y * v[j].y) + (v[j].z * v[j].z + v[j].w * v[j].w); }
            const float rstd = 1.f / sqrtf(wave_sum(s2) * (1.f / D) + EPS);
            float acc[8];
#pragma unroll
            for (int c = 0; c < 8; ++c) acc[c] = 0.f;
            unsigned long long* o8 = (unsigned long long*)(h0 + (size_t)m * D) + lane;
#pragma unroll
            for (int j = 0; j < 4; ++j) {
                f32x4 h = v[j] * rstd * g[j] + b[j];
                o8[64 * j] = (unsigned long long)pk2(h.x, h.y) | ((unsigned long long)pk2(h.z, h.w) << 32);
#pragma unroll
                for (int i = 0; i < 4; ++i) { const int k = 4 * lane + i + 256 * j; const f32x4 w0 = *(const LAS f32x4*)(Wg8 + k * 8), w1 = *(const LAS f32x4*)(Wg8 + k * 8 + 4);
                    const float hv = h[i];
                    acc[0] += hv * w0.x; acc[1] += hv * w0.y; acc[2] += hv * w0.z; acc[3] += hv * w0.w; acc[4] += hv * w1.x; acc[5] += hv * w1.y; acc[6] += hv * w1.z; acc[7] += hv * w1.w; }
            }
            float r4[4], r2[2], r1;
            { const bool up = lane & 1;
#pragma unroll
              for (int c = 0; c < 4; ++c) { const float send = up ? acc[c] : acc[4 + c], keep = up ? acc[4 + c] : acc[c]; r4[c] = keep + __shfl_xor(send, 1); } }
            { const bool up = lane & 2;
#pragma unroll
              for (int c = 0; c < 2; ++c) { const float send = up ? r4[c] : r4[2 + c], keep = up ? r4[2 + c] : r4[c]; r2[c] = keep + __shfl_xor(send, 2); } }
            { const bool up = lane & 4; const float send = up ? r2[0] : r2[1], keep = up ? r2[1] : r2[0]; r1 = keep + __shfl_xor(send, 4); }
            r1 += __shfl_xor(r1, 8); r1 += __shfl_xor(r1, 16); r1 += __shfl_xor(r1, 32);
            if (lane < 8) igfg[(size_t)m * 8 + 4 * (lane & 1) + 2 * ((lane >> 1) & 1) + ((lane >> 2) & 1)] = r1;
            if (lane == 0) { lnst[2 * m] = mean; lnst[2 * m + 1] = rstd; }
        }
    }
    __syncthreads();
    for (int cgp = blockIdx.x; cgp < 81; cgp += gridDim.x) {
        LAS float* hm = (LAS float*)(lds + 32768);
        LAS float* part = (LAS float*)(lds + 32768 + 65536);
        __syncthreads();
        for (int r = wave * 2; r < wave * 2 + 2; ++r) {
            const f32x4* xr = (const f32x4*)(a.in[1] + (size_t)r * D) + lane; const f32x4* gp = (const f32x4*)a.in[2] + lane; const f32x4* bp = (const f32x4*)a.in[3] + lane;
            f32x4 v[4]; float s = 0.f;
#pragma unroll
            for (int j = 0; j < 4; ++j) { v[j] = xr[64 * j]; s += (v[j].x + v[j].y) + (v[j].z + v[j].w); }
            const float mean = wave_sum(s) * (1.f / D); float s2 = 0.f;
#pragma unroll
            for (int j = 0; j < 4; ++j) { v[j] = v[j] - mean; s2 += (v[j].x * v[j].x + v[j].y * v[j].y) + (v[j].z * v[j].z + v[j].w * v[j].w); }
            const float rstd = 1.f / sqrtf(wave_sum(s2) * (1.f / D) + EPS);
#pragma unroll
            for (int j = 0; j < 4; ++j) { const f32x4 h = v[j] * rstd * gp[64 * j] + bp[64 * j]; *(LAS f32x4*)(hm + r * 1024 + 4 * (lane + 64 * j)) = h; }
        }
        __syncthreads();
        const int c = cgp * 64 + lane;
        const int cc = c < 5128 ? c : 5127, g = cc >> 10, srccol = (cc < 5120) ? win_src_off(g) + (cc & 1023) : 7168 + (cc - 5120);
        float acc[16];
#pragma unroll
        for (int r = 0; r < 16; ++r) acc[r] = 0.f;
        const float* wp = a.in[4] + (size_t)(wave * 128) * INW + srccol;
#pragma unroll 4
        for (int k = 0; k < 128; ++k) { const float w = wp[(size_t)k * INW];
#pragma unroll
            for (int r = 0; r < 16; ++r) acc[r] += hm[r * 1024 + wave * 128 + k] * w; }
#pragma unroll
        for (int r = 0; r < 16; ++r) part[(wave * 16 + r) * 64 + lane] = acc[r];
        __syncthreads();
        if (c < 5128) {
            float* meta = (float*)(ws + WS_META);
            for (int r = wave * 2; r < wave * 2 + 2; ++r) { float v = 0.f;
#pragma unroll
                for (int w8 = 0; w8 < 8; ++w8) v += part[(w8 * 16 + r) * 64 + lane];
                if (c < 5120) { const int c1 = c & 1023;
                    if (g == 1) { const float lb = 1.0f / (1.0f + expf(a.in[5][1024 + c1] - a.in[5][c1])); v = logf(lb + (1.0f - lb) * sigmoidf_(v)); }
                    meta[(size_t)g * 16384 + r * 1024 + c1] = v; }
                else meta[5 * 16384 + r * 8 + (c - 5120)] = v; }
        }
    }
    for (int it = blockIdx.x * 512 + tid; it < 64 * 128; it += gridDim.x * 512) { const int e = it >> 7, k0 = (it & 127) * 8; float hi[8], lo[8];
#pragma unroll
        for (int j = 0; j < 8; ++j) { const float wv = a.in[17][(size_t)(k0 + j) * 64 + e]; const float h = bf2f(f2bf(wv)); hi[j] = h; lo[j] = wv - h; }
        store8_bf16((bf16*)(ws + WS_WRT) + (size_t)e * 1024 + k0, hi); store8_bf16((bf16*)(ws + WS_WRT) + 65536 + (size_t)e * 1024 + k0, lo); }
    {
        int* ts = (int*)(ws + WS_TOKSLOT); float* wsl = (float*)(ws + WS_WSLOT);
        for (int i = blockIdx.x * 512 + tid; i < 2 * NSLOTMAX; i += gridDim.x * 512) { ts[i] = 0; wsl[i] = 0.f; }
        int* ident = (int*)(ws + WS_IDENT);
        for (int i = blockIdx.x * 512 + tid; i < T; i += gridDim.x * 512) ident[i] = i;
    }
}

__device__ __forceinline__ void store8_bf16(bf16* p, const float (&v)[8]) { u32x4 w; w.x = pk2(v[0], v[1]); w.y = pk2(v[2], v[3]); w.z = pk2(v[4], v[5]); w.w = pk2(v[6], v[7]); *(u32x4*)p = w; }
__device__ __forceinline__ void load8_bf16(const bf16* p, float (&v)[8]) { const u32x4 w = *(const u32x4*)p;
    v[0] = bf2f(w.x & 0xffffu); v[1] = bf2f(w.x >> 16); v[2] = bf2f(w.y & 0xffffu); v[3] = bf2f(w.y >> 16); v[4] = bf2f(w.z & 0xffffu); v[5] = bf2f(w.z >> 16); v[6] = bf2f(w.w & 0xffffu); v[7] = bf2f(w.w >> 16); }

struct NoData {};
template <int K> struct KindTag { static constexpr int value = K; };
template <class T, class = void> struct epigroup { static constexpr int value = 4; };
template <class T> struct epigroup<T, typename std::enable_if<(T::GROUP > 0)>::type> { static constexpr int value = T::GROUP; };
template <class T, class = void> struct pairbj : std::false_type {};
template <class T> struct pairbj<T, typename std::enable_if<T::PAIRBJ>::type> : std::true_type {};
__device__ __forceinline__ void unpack8(const u32x4 w, float (&v)[8]) { v[0] = bf2f(w.x & 0xffffu); v[1] = bf2f(w.x >> 16); v[2] = bf2f(w.y & 0xffffu); v[3] = bf2f(w.y >> 16); v[4] = bf2f(w.z & 0xffffu); v[5] = bf2f(w.z >> 16); v[6] = bf2f(w.w & 0xffffu); v[7] = bf2f(w.w >> 16); }
struct EpiA {
    static constexpr bool PIPE = false; static constexpr int NKIND = 4;
    unsigned char* ws; unsigned char* dout; const float* lbl;
    struct Cl { float lb[8]; bf16* base; }; typedef NoData Ld;
    __device__ __forceinline__ int kind(int col0) const { const int g = col0 >> 10; return g == 1 ? 1 : g >= 5 ? 2 : g == 3 ? 3 : 0; }
    template <int K> __device__ __forceinline__ void colload(int col0, Cl& cl) const { const int g = col0 >> 10, c = col0 & 1023;
        if (K == 1) {
#pragma unroll
            for (int j = 0; j < 8; ++j) cl.lb[j] = __builtin_amdgcn_rcpf(1.0f + __expf(lbl[1024 + c + j] - lbl[c + j]));
            cl.base = (bf16*)(ws + WS_LFA) + c; }
        else if (K == 2) cl.base = (bf16*)dout + (size_t)(g - 5) * T * D + c;
        else if (K == 3) cl.base = (bf16*)(ws + WS_QKB) + c;
        else cl.base = (bf16*)(ws + (g == 0 ? WS_QA : g == 2 ? WS_IA : WS_VB)) + c; }
    template <int K> __device__ __forceinline__ void load(int, int, Ld&) const {}
    template <int K> __device__ __forceinline__ void apply(int row, int col0, int m, const float (&v)[8], const Ld&, const Cl& cl) const {
        if (K == 1) { float o[8];
#pragma unroll
            for (int j = 0; j < 8; ++j) o[j] = __logf(cl.lb[j] + (1.0f - cl.lb[j]) * sigmoidf_(v[j]));
            u32x4 w; w.x = f2h(o[0]) | (f2h(o[1]) << 16); w.y = f2h(o[2]) | (f2h(o[3]) << 16); w.z = f2h(o[4]) | (f2h(o[5]) << 16); w.w = f2h(o[6]) | (f2h(o[7]) << 16);
            *(u32x4*)(cl.base + (size_t)row * D) = w; }
        else if (K == 2) { float o[8];
#pragma unroll
            for (int j = 0; j < 8; ++j) o[j] = sigmoidf_(v[j]);
            store8_bf16(cl.base + (size_t)row * D, o); }
        else { store8_bf16(cl.base + (size_t)row * D, v);
            if (K == 3 && m == 3) { if ((row & 63) >= 61) store8_bf16((bf16*)(ws + WS_HALO) + ((size_t)(row >> 6) * 3 + ((row & 63) - 61)) * D + (col0 & 1023), v); } }
    }
};
struct EpiB {
    static constexpr bool PIPE = false; static constexpr int NKIND = 2; static constexpr int GROUP = 2;
    unsigned char* ws; const float* hg_g; const float* ml_g;
    struct Cl { float gn[8]; }; struct Ld { u32x4 x; float mean, rstd; };
    __device__ __forceinline__ int kind(int col0) const { return col0 >> 10; }
    template <int K> __device__ __forceinline__ void colload(int col0, Cl& cl) const { const int c = col0 & 1023; const float* gp = (K == 0 ? hg_g : ml_g) + c;
#pragma unroll
        for (int j = 0; j < 8; ++j) cl.gn[j] = gp[j]; }
    template <int K> __device__ __forceinline__ void load(int row, int col0, Ld& ld) const { const int c = col0 & 1023;
        if (K == 0) { ld.x = *(const u32x4*)((const bf16*)(ws + WS_IA) + (size_t)row * D + c); ld.mean = 0.f;
            const f32x2_t p = *(const f32x2_t*)((const float*)(ws + WS_STA2) + (size_t)row * 16 + (c >> 7) * 2); ld.rstd = __builtin_amdgcn_rsqf((p.x + p.y) * (1.f / 128.f) + EPS); }
        else { ld.x = *(const u32x4*)((const bf16*)(ws + WS_VB) + (size_t)row * D + c); const f32x4* st = (const f32x4*)((const float*)(ws + WS_STB2) + ((size_t)row * 16 + (c >> 8) * 4) * 2);
            const f32x4 a0 = st[0], a1 = st[1]; const float s1 = (a0.x + a0.z) + (a1.x + a1.z), s2 = (a0.y + a0.w) + (a1.y + a1.w);
            ld.mean = s1 * (1.f / 256.f); ld.rstd = __builtin_amdgcn_rsqf(fmaxf(s2 * (1.f / 256.f) - ld.mean * ld.mean, 0.f) + EPS); } }
    template <int K> __device__ __forceinline__ void apply(int row, int col0, int, const float (&v)[8], const Ld& ld, const Cl& cl) const {
        const int c = col0 & 1023; float x[8], o[8]; unpack8(ld.x, x);
        if (K == 0) {
#pragma unroll
            for (int j = 0; j < 8; ++j) o[j] = x[j] * ld.rstd * cl.gn[j] * siluf_(v[j]);
            store8_bf16((bf16*)(ws + WS_LFA) + (size_t)row * D + c, o);
        } else {
#pragma unroll
            for (int j = 0; j < 8; ++j) o[j] = (x[j] - ld.mean) * ld.rstd * cl.gn[j] * sigmoidf_(v[j]);
            store8_bf16((bf16*)(ws + WS_QKB) + (size_t)row * D + c, o);
        }
    }
};
struct EpiC {
    static constexpr bool PIPE = true; static constexpr int NKIND = 1;
    unsigned char* ws; const bf16* sga; const bf16* sgb;
    typedef NoData Cl; struct Ld { u32x4 a, b; };
    __device__ __forceinline__ int kind(int) const { return 0; }
    template <int K> __device__ __forceinline__ void colload(int, Cl&) const {}
    __device__ __forceinline__ void midload(int row, int col0, Ld& ld) const { ld.a = *(const u32x4*)(sga + (size_t)row * D + col0); ld.b = *(const u32x4*)(sgb + (size_t)row * D + col0); }
    __device__ __forceinline__ void mid(float (&v)[8], const Ld& ld) const { float sa[8], sb[8]; unpack8(ld.a, sa); unpack8(ld.b, sb);
#pragma unroll
        for (int j = 0; j < 8; ++j) v[j] *= sa[j] * __builtin_amdgcn_rcpf(sb[j]); }
    template <int K> __device__ __forceinline__ void load(int row, int col0, Ld& ld) const { ld.b = *(const u32x4*)(sgb + (size_t)row * D + col0); }
    template <int K> __device__ __forceinline__ void apply(int row, int col0, int, const float (&v)[8], const Ld& ld, const Cl&) const { float sb[8], o[8]; unpack8(ld.b, sb);
#pragma unroll
        for (int j = 0; j < 8; ++j) o[j] = sb[j] * v[j];
        store8_bf16((bf16*)(ws + WS_IA) + (size_t)row * D + col0, o); }
};
struct EpiD {
    static constexpr bool PIPE = false; static constexpr int NKIND = 1;
    unsigned char* ws; float* dout; const float* x; const float* g; const float* b;
    struct Cl { float g[8], b[8]; }; struct Ld { f32x4 x0, x1; float mean, rstd; };
    __device__ __forceinline__ int kind(int) const { return 0; }
    template <int K> __device__ __forceinline__ void colload(int col0, Cl& cl) const {
#pragma unroll
        for (int j = 0; j < 8; ++j) { cl.g[j] = g[col0 + j]; cl.b[j] = b[col0 + j]; } }
    template <int K> __device__ __forceinline__ void load(int row, int col0, Ld& ld) const { const float* st = (const float*)(ws + WS_LNST0) + 2 * (size_t)row; ld.mean = st[0]; ld.rstd = st[1];
        ld.x0 = *(const f32x4*)(x + (size_t)row * D + col0); ld.x1 = *(const f32x4*)(x + (size_t)row * D + col0 + 4); }
    template <int K> __device__ __forceinline__ void apply(int row, int col0, int, const float (&v)[8], const Ld& ld, const Cl& cl) const { float o[8];
#pragma unroll
        for (int j = 0; j < 4; ++j) { o[j] = DN_ALPHA * ((ld.x0[j] - ld.mean) * ld.rstd * cl.g[j] + cl.b[j]) + v[j]; o[4 + j] = DN_ALPHA * ((ld.x1[j] - ld.mean) * ld.rstd * cl.g[4 + j] + cl.b[4 + j]) + v[4 + j]; }
        store8_bf16((bf16*)(ws + WS_Z) + (size_t)row * D + col0, o); }
};
struct EpiGU {
    static constexpr bool PIPE = false; static constexpr int NKIND = 1; static constexpr bool PAIRBJ = true;
    unsigned char* H;
    typedef NoData Cl; typedef NoData Ld;
    __device__ __forceinline__ int kind(int) const { return 0; }
    __device__ __forceinline__ void apply_pair(int row, int col0, const float (&g)[8], const float (&u)[8]) const {
        float o[8];
#pragma unroll
        for (int j = 0; j < 8; ++j) o[j] = fminf(fmaxf(siluf_(g[j] * 0.015625f) * (u[j] * 0.015625f), -448.f), 448.f);
        int w0 = __builtin_amdgcn_cvt_pk_fp8_f32(o[0], o[1], 0, false); w0 = __builtin_amdgcn_cvt_pk_fp8_f32(o[2], o[3], w0, true);
        int w1 = __builtin_amdgcn_cvt_pk_fp8_f32(o[4], o[5], 0, false); w1 = __builtin_amdgcn_cvt_pk_fp8_f32(o[6], o[7], w1, true);
        *(u32x2*)(H + (size_t)row * DEXP + (col0 >> 8) * 128 + (col0 & 127)) = (u32x2){(unsigned)w0, (unsigned)w1}; }
};
struct EpiDown {
    static constexpr bool PIPE = true; static constexpr int NKIND = 1;
    unsigned char* Y; const float* w;
    typedef NoData Cl; struct Ld { float s; };
    __device__ __forceinline__ int kind(int) const { return 0; }
    template <int K> __device__ __forceinline__ void colload(int, Cl&) const {}
    template <int K> __device__ __forceinline__ void load(int row, int, Ld& ld) const { ld.s = w[row]; }
    template <int K> __device__ __forceinline__ void apply(int row, int col0, int, const float (&v)[8], const Ld& ld, const Cl&) const { float o[8]; const float s = ld.s * 0.5f;
#pragma unroll
        for (int j = 0; j < 8; ++j) o[j] = fminf(fmaxf(s * v[j], -448.f), 448.f);
        int w0 = __builtin_amdgcn_cvt_pk_fp8_f32(o[0], o[1], 0, false); w0 = __builtin_amdgcn_cvt_pk_fp8_f32(o[2], o[3], w0, true);
        int w1 = __builtin_amdgcn_cvt_pk_fp8_f32(o[4], o[5], 0, false); w1 = __builtin_amdgcn_cvt_pk_fp8_f32(o[6], o[7], w1, true);
        *(u32x2*)(Y + (size_t)row * D + col0) = (u32x2){(unsigned)w0, (unsigned)w1}; }
};
struct EpiSD2 {
    static constexpr bool PIPE = false; static constexpr int NKIND = 1;
    unsigned char* ws; int tokbase;
    typedef NoData Cl; struct Ld { u32x4 r; };
    __device__ __forceinline__ int kind(int) const { return 0; }
    template <int K> __device__ __forceinline__ void colload(int, Cl&) const {}
    template <int K> __device__ __forceinline__ void load(int row, int col0, Ld& ld) const { ld.r = *(const u32x4*)((const bf16*)(ws + WS_H0) + (size_t)(tokbase + row - NSLOTMAX) * D + col0); }
    template <int K> __device__ __forceinline__ void apply(int row, int col0, int, const float (&v)[8], const Ld& ld, const Cl&) const { float r[8], o[8]; unpack8(ld.r, r);
#pragma unroll
        for (int j = 0; j < 8; ++j) o[j] = r[j] + v[j] * 0.015625f;
        store8_bf16((bf16*)(ws + WS_H0) + (size_t)(tokbase + row - NSLOTMAX) * D + col0, o); }
};

namespace pg8 {
typedef short bf16x8 __attribute__((ext_vector_type(8)));
constexpr int BM = 256, BK = 64, HALF = 128, HTB = HALF * BK * 2, STAGE_BYTES = 8 * HTB, NXCD = 8, WGM = 8;
__device__ __forceinline__ int lds_byte(int r, int c) { const int st = (r >> 4) * 2 + (c >> 5), rr = r & 15, cc = c & 31, ob = rr * 64 + cc * 2; return st * 1024 + (ob ^ (((ob >> 9) & 1) << 5)); }
__device__ __forceinline__ void stage_rc(int b, int& R, int& C) { const int st = b / 1024, sb = b % 1024, swz = sb ^ (((sb >> 9) & 1) << 5); R = (st >> 1) * 16 + swz / 64; C = (st & 1) * 32 + (swz % 64) / 2; }
__device__ __forceinline__ int perm32(int rho) { const int n = rho >> 4, i = rho & 15; return 8 * (i >> 2) + 4 * n + (i & 3); }
typedef int v8i32_t __attribute__((ext_vector_type(8)));
typedef int v4i32_t __attribute__((ext_vector_type(4)));
__device__ __forceinline__ v8i32_t cat88(bf16x8 a, bf16x8 b) { const u32x4 x = __builtin_bit_cast(u32x4, a), y = __builtin_bit_cast(u32x4, b); return (v8i32_t){(int)x.x, (int)x.y, (int)x.z, (int)x.w, (int)y.x, (int)y.y, (int)y.z, (int)y.w}; }
struct Unit { int row0, col0; const char* A; const char* B; const int* idx; int mode; };
__device__ __forceinline__ int xcd_remap(int L, int nwg) { const int q = nwg / NXCD, r = nwg % NXCD, xcd = L % NXCD, off = L / NXCD; return (xcd < r ? xcd * (q + 1) : r * (q + 1) + (xcd - r) * q) + off; }
struct DenseOrder {
    int nM, nN, nwg, G, c, K; const char* A; const char* Bt;
    __device__ __forceinline__ void init(const bf16* A_, const bf16* Bt_, int M, int N, int K_) { A = (const char*)A_; Bt = (const char*)Bt_; K = K_; nM = M / BM; nN = N / BM; nwg = nM * nN; G = gridDim.x; c = blockIdx.x; }
    __device__ __forceinline__ bool next(int i, Unit& u) const {
        const long L = (long)i * G + c; if (L >= nwg) return false;
        const int wgid = xcd_remap((int)L, nwg);
        const int nig = WGM * nN, gid = wgid / nig, fm = gid * WGM, gsz = (nM - fm) < WGM ? (nM - fm) : WGM;
        const int pm = fm + ((wgid % nig) % gsz), pn = (wgid % nig) / gsz;
        u.row0 = pm * BM; u.col0 = pn * BM; u.A = A + (size_t)pm * BM * K * 2; u.B = Bt + (size_t)pn * BM * K * 2; u.idx = nullptr; u.mode = 0; return true;
    }
};
struct PairedOrder {
    DenseOrder d; const char* A2; const char* B2;
    __device__ __forceinline__ bool next(int i, Unit& u) const {
        if (!d.next(i >> 1, u)) return false;
        if (i & 1) { u.A = A2 + (size_t)u.row0 * d.K * 2; u.B = B2 + (size_t)u.col0 * d.K * 2; u.mode = 2; } else u.mode = 1;
        return true;
    }
};
struct GroupedOrder {
    const LAS int* te; int nct, nrt, nwg1, nwg2, G, c, K; const char* A; const int* idx; const int* ident; const char* Bt; const char* Bsh; size_t estride; bool gather;
    __device__ __forceinline__ bool next(int i, Unit& u) const {
        const int n1 = c < nwg1 ? (nwg1 - c + G - 1) / G : 0;
        if (i < n1) { const int wgid = xcd_remap(i * G + c, nwg1), rt = wgid / nct, ct = wgid % nct, row0 = rt * BM; const int e = __builtin_amdgcn_readfirstlane(te[rt]); u.mode = 0; u.col0 = ct * BM;
            u.row0 = row0; u.A = gather ? A : A + (size_t)row0 * K * 2; u.idx = idx + row0; u.B = Bt + (size_t)e * estride + (size_t)ct * BM * K * 2; return true; }
        const int L2 = (i - n1) * G + c; if (L2 >= nwg2) return false;
        const int wgid = xcd_remap(L2, nwg2), rt = wgid / nct, ct = wgid % nct, row0 = NSLOTMAX + rt * BM; u.mode = 3; u.col0 = ct * BM;
        u.row0 = row0; u.A = gather ? A : A + (size_t)row0 * K * 2; u.idx = ident + rt * BM; u.B = Bsh + (size_t)ct * BM * K * 2; return true;
    }
};

template <bool GATHER, bool PAIRED, bool FP8, class Epi, class Sched, class Epi2>
__device__ __forceinline__ void gemm_phase2(LAS unsigned char* lds, const int wv, const int K, const Sched& S, const Epi& E, const Epi2& E2) {
    int tid = tidx_(wv); asm volatile("" : "+v"(tid));
    const int wid = __builtin_amdgcn_readfirstlane(tid >> 6), lane = tid & 63, wr = wid >> 2, wc = wid & 3, fr = lane & 15, fq = lane >> 4;
    const int nt = K / BK;
    unsigned voffA[2], voffB[2];
#pragma unroll
    for (int i = 0; i < 2; ++i) { int R, C; stage_rc(tid * 16 + i * 8192, R, C); const int Rb = (R & ~31) + perm32(R & 31);
        voffA[i] = (unsigned)(R * K + C) * 2u; voffB[i] = (unsigned)(Rb * K + C) * 2u; }
    const size_t kstep = (size_t)(BK * 2);
    const size_t hstep = (size_t)HALF * K * 2;
    const unsigned ldsw = (unsigned)wid * 1024u;
    const int aoffk[2] = { FP8 ? lds_byte(wr * 64 + fr, fq * 16) : lds_byte(wr * 64 + fr, fq * 8), FP8 ? lds_byte(wr * 64 + fr, fq * 16 + 8) : lds_byte(wr * 64 + fr, fq * 8) + 1024 };
    const int boffk[2] = { FP8 ? lds_byte(wc * 32 + fr, fq * 16) : lds_byte(wc * 32 + fr, fq * 8), FP8 ? lds_byte(wc * 32 + fr, fq * 16 + 8) : lds_byte(wc * 32 + fr, fq * 8) + 1024 };
    unsigned cvA[2][2];
#define PG8_SA(b, h) (((b) * 2 + (h)) * HTB)
#define PG8_SB(b, h) ((4 + (b) * 2 + (h)) * HTB)
#define PG8_STAGE(bufoff, gbase, voff) do { _Pragma("unroll") for (int _i = 0; _i < 2; ++_i) \
        __builtin_amdgcn_global_load_lds((const unsigned*)((const char*)(gbase) + (voff)[_i]), (LAS unsigned*)(lds + (bufoff) + ldsw + _i * 8192), 16, 0, 0); } while (0)
#define PG8_STAGE_A(bufoff, kbase, h, usenext) do { if constexpr (GATHER) { PG8_STAGE(bufoff, kbase, cvA[h]); } \
        else { PG8_STAGE(bufoff, (kbase) + (h) * hstep, voffA); } } while (0)
#define PG8_LOADIDX(dst, un) do { _Pragma("unroll") for (int _i = 0; _i < 2; ++_i) { int _R, _C; stage_rc(tid * 16 + _i * 8192, _R, _C); _Pragma("unroll") for (int _h = 0; _h < 2; ++_h) \
        dst[_h][_i] = ((unsigned)(un).idx[_h * HALF + _R] * (unsigned)K + (unsigned)_C) * 2u; } } while (0)
#define PG8_LDA(dst, b, h) do { _Pragma("unroll") for (int m = 0; m < 4; ++m) { if constexpr (FP8) { dst##8[m].lo = *(const LAS v4i32_t*)(lds + PG8_SA(b, h) + aoffk[0] + m * 2048); dst##8[m].hi = *(const LAS v4i32_t*)(lds + PG8_SA(b, h) + aoffk[1] + m * 2048); } \
        else { _Pragma("unroll") for (int k = 0; k < 2; ++k) dst[m][k] = *(const LAS bf16x8*)(lds + PG8_SA(b, h) + aoffk[k] + m * 2048); } } } while (0)
#define PG8_LDB(dst, b, h) do { _Pragma("unroll") for (int n = 0; n < 2; ++n) { if constexpr (FP8) { dst##8[n].lo = *(const LAS v4i32_t*)(lds + PG8_SB(b, h) + boffk[0] + n * 2048); dst##8[n].hi = *(const LAS v4i32_t*)(lds + PG8_SB(b, h) + boffk[1] + n * 2048); } \
        else { _Pragma("unroll") for (int k = 0; k < 2; ++k) dst[n][k] = *(const LAS bf16x8*)(lds + PG8_SB(b, h) + boffk[k] + n * 2048); } } } while (0)
#define PG8_MMA(ai, bj, At, Bt) do { __builtin_amdgcn_s_setprio(1); _Pragma("unroll") for (int m = 0; m < 4; ++m) _Pragma("unroll") for (int n = 0; n < 2; ++n) { \
        if constexpr (FP8) acc[ai][bj][m][n] = __builtin_amdgcn_mfma_scale_f32_16x16x128_f8f6f4(Bt##8[n], At##8[m], acc[ai][bj][m][n], 0, 0, 0, 0x7F7F7F7F, 0, 0x7F7F7F7F); \
        else { _Pragma("unroll") for (int k = 0; k < 2; ++k) acc[ai][bj][m][n] = __builtin_amdgcn_mfma_f32_16x16x32_bf16(Bt[n][k], At[m][k], acc[ai][bj][m][n], 0, 0, 0); } } \
        __builtin_amdgcn_s_setprio(0); \
        if (nt == 2) { _Pragma("unroll") for (int m = 0; m < 4; ++m) asm volatile("" : "+v"(acc[ai][bj][m][0]), "+v"(acc[ai][bj][m][1])); } } while (0)
#define PG8_WAIT_V(n) asm volatile("s_waitcnt vmcnt(" #n ")" ::: "memory")
#define PG8_WAIT_L(n) asm volatile("s_waitcnt lgkmcnt(" #n ")" ::: "memory")
#define PG8_BAR __builtin_amdgcn_s_barrier()
#define PG8_SCHED __builtin_amdgcn_sched_barrier(0)
    Unit cur, nxt; int ui = 0;
    if (!S.next(0, cur)) return;
    f32x4 acc[2][2][4][2];
#pragma unroll
    for (int a = 0; a < 2; ++a)
#pragma unroll
        for (int b = 0; b < 2; ++b)
#pragma unroll
            for (int m = 0; m < 4; ++m)
#pragma unroll
                for (int n = 0; n < 2; ++n) acc[a][b][m][n] = (f32x4){0.f, 0.f, 0.f, 0.f};
    bf16x8 At[4][2], B0[2][2], B1[2][2]; v8i32_t At8[4], B08[2], B18[2];
    const char* cA = cur.A; const char* cB = cur.B;
    if constexpr (GATHER) { PG8_LOADIDX(cvA, cur); }
    PG8_STAGE(PG8_SB(0, 0), cB, voffB); PG8_STAGE(PG8_SB(0, 1), cB + hstep, voffB); PG8_STAGE_A(PG8_SA(0, 0), cA, 0, false); PG8_STAGE_A(PG8_SA(0, 1), cA, 1, false);
    if (wr == 1) PG8_BAR;
    PG8_WAIT_V(2); PG8_BAR;
    PG8_STAGE(PG8_SB(1, 0), cB + kstep, voffB); PG8_STAGE_A(PG8_SA(1, 0), cA + kstep, 0, false); PG8_STAGE(PG8_SB(1, 1), cB + hstep + kstep, voffB);
    PG8_WAIT_V(6); PG8_BAR;
    for (;;) {
        const bool has_next = S.next(ui + 1, nxt);
        const char* nA = has_next ? nxt.A : cA; const char* nB = has_next ? nxt.B : cB;
#pragma unroll 1
        for (int t = 0; t < nt; t += 2) {
            const bool last = (t == nt - 2);
            const char* a1 = cA + (size_t)(t + 1) * kstep;
            const char* a2 = last ? nA : cA + (size_t)(t + 2) * kstep; const char* b2 = last ? nB : cB + (size_t)(t + 2) * kstep;
            const char* a3 = a2 + kstep; const char* b3 = b2 + kstep;
            PG8_LDB(B0, 0, 0); PG8_LDB(B1, 0, 1); PG8_SCHED; PG8_LDA(At, 0, 0); PG8_STAGE_A(PG8_SA(1, 1), a1, 1, false);
            if constexpr (GATHER) { if (last && has_next) PG8_LOADIDX(cvA, nxt); }
            PG8_WAIT_V(8);
            PG8_WAIT_L(0); PG8_BAR; PG8_MMA(0, 0, At, B0); PG8_MMA(0, 1, At, B1); PG8_BAR; PG8_SCHED;
            PG8_LDA(At, 0, 1); PG8_STAGE(PG8_SB(0, 0), b2, voffB); PG8_STAGE(PG8_SB(0, 1), b2 + hstep, voffB); PG8_STAGE_A(PG8_SA(0, 0), a2, 0, last);
            PG8_WAIT_V(8);
            PG8_WAIT_L(0); PG8_BAR; PG8_MMA(1, 0, At, B0); PG8_MMA(1, 1, At, B1); PG8_BAR; PG8_SCHED;
            PG8_LDB(B0, 1, 0); PG8_LDB(B1, 1, 1); PG8_SCHED; PG8_LDA(At, 1, 0); PG8_STAGE_A(PG8_SA(0, 1), a2, 1, last);
            PG8_WAIT_V(8); PG8_WAIT_L(0); PG8_BAR; PG8_MMA(0, 0, At, B0); PG8_MMA(0, 1, At, B1); PG8_BAR; PG8_SCHED;
            PG8_LDA(At, 1, 1); PG8_STAGE(PG8_SB(1, 0), b3, voffB); PG8_STAGE(PG8_SB(1, 1), b3 + hstep, voffB); PG8_STAGE_A(PG8_SA(1, 0), a3, 0, last);
            PG8_WAIT_V(8); PG8_WAIT_L(0); PG8_BAR; PG8_MMA(1, 0, At, B0); PG8_MMA(1, 1, At, B1); PG8_BAR; PG8_SCHED;
        }
        if (wr == 0) PG8_BAR;
        {
            const int erow = cur.row0 + wr * 64 + fr, ecol = cur.col0 + wc * 32 + 8 * fq;
#define PG8_V8(ai, bj, m) { acc[ai][bj][m][0][0], acc[ai][bj][m][0][1], acc[ai][bj][m][0][2], acc[ai][bj][m][0][3], acc[ai][bj][m][1][0], acc[ai][bj][m][1][1], acc[ai][bj][m][1][2], acc[ai][bj][m][1][3] }
            auto run = [&](const auto& EE, auto KT) {
                typedef typename std::remove_cv<typename std::remove_reference<decltype(EE)>::type>::type EP; constexpr int KIND = decltype(KT)::value;
                if constexpr (pairbj<EP>::value) {
#pragma unroll
                    for (int ai = 0; ai < 2; ++ai)
#pragma unroll
                        for (int m = 0; m < 4; ++m) { const float vg[8] = PG8_V8(ai, 0, m); const float vu[8] = PG8_V8(ai, 1, m); EE.apply_pair(erow + ai * HALF + m * 16, ecol, vg, vu); }
                } else if constexpr (EP::PIPE) {
                    typename EP::Cl cl[2]; EE.template colload<KIND>(ecol, cl[0]); EE.template colload<KIND>(ecol + HALF, cl[1]);
                    typename EP::Ld ld[2][4];
#pragma unroll
                    for (int m = 0; m < 4; ++m) EE.template load<KIND>(erow + m * 16, ecol, ld[0][m]);
#pragma unroll
                    for (int gi = 0; gi < 4; ++gi) { const int ai = gi >> 1, bj = gi & 1;
                        if (gi < 3) { const int ai2 = (gi + 1) >> 1, bj2 = (gi + 1) & 1;
#pragma unroll
                            for (int m = 0; m < 4; ++m) EE.template load<KIND>(erow + ai2 * HALF + m * 16, ecol + bj2 * HALF, ld[(gi + 1) & 1][m]); }
#pragma unroll
                        for (int m = 0; m < 4; ++m) { const float v[8] = PG8_V8(ai, bj, m); EE.template apply<KIND>(erow + ai * HALF + m * 16, ecol + bj * HALF, m, v, ld[gi & 1][m], cl[bj]); } }
                } else {
#pragma unroll
                    for (int bj = 0; bj < 2; ++bj) { typename EP::Cl cl; EE.template colload<KIND>(ecol + bj * HALF, cl);
#pragma unroll
                        for (int ai = 0; ai < 2; ++ai)
#pragma unroll
                            for (int mg = 0; mg < 4; mg += epigroup<EP>::value) { typename EP::Ld ld[4];
#pragma unroll
                                for (int m = mg; m < mg + epigroup<EP>::value; ++m) EE.template load<KIND>(erow + ai * HALF + m * 16, ecol + bj * HALF, ld[m]);
#pragma unroll
                                for (int m = mg; m < mg + epigroup<EP>::value; ++m) { const float v[8] = PG8_V8(ai, bj, m); EE.template apply<KIND>(erow + ai * HALF + m * 16, ecol + bj * HALF, m, v, ld[m], cl); } } }
                }
            };
            if (cur.mode == 3) run(E2, KindTag<0>{});
            else if (PAIRED && cur.mode == 1) {
                if constexpr (PAIRED) {
#pragma unroll
                for (int bj = 0; bj < 2; ++bj)
#pragma unroll
                    for (int ai = 0; ai < 2; ++ai) { typename Epi::Ld ld[4];
#pragma unroll
                        for (int m = 0; m < 4; ++m) E.midload(erow + ai * HALF + m * 16, ecol + bj * HALF, ld[m]);
#pragma unroll
                        for (int m = 0; m < 4; ++m) { float v[8] = PG8_V8(ai, bj, m); E.mid(v, ld[m]);
                            acc[ai][bj][m][0] = (f32x4){v[0], v[1], v[2], v[3]}; acc[ai][bj][m][1] = (f32x4){v[4], v[5], v[6], v[7]}; } }
                }
            } else if constexpr (Epi::NKIND == 1) run(E, KindTag<0>{});
            else { const int kd = __builtin_amdgcn_readfirstlane(E.kind(cur.col0));
                if (kd == 0) run(E, KindTag<0>{}); else if (kd == 1) run(E, KindTag<1>{});
                else if constexpr (Epi::NKIND > 2) { if (kd == 2) run(E, KindTag<2>{}); else run(E, KindTag<3>{}); } }
#undef PG8_V8
        }
        if (!has_next) break;
        if (!PAIRED || cur.mode != 1) {
#pragma unroll
        for (int a = 0; a < 2; ++a)
#pragma unroll
            for (int b = 0; b < 2; ++b)
#pragma unroll
                for (int m = 0; m < 4; ++m)
#pragma unroll
                    for (int n = 0; n < 2; ++n) acc[a][b][m][n] = (f32x4){0.f, 0.f, 0.f, 0.f};
        }
        cur = nxt; cA = nA; cB = nB; ++ui;
        if (wr == 1) PG8_BAR;
    }
    PG8_WAIT_V(0);
    PG8_BAR;
#undef PG8_SA
#undef PG8_SB
#undef PG8_STAGE
#undef PG8_STAGE_A
#undef PG8_LOADIDX
#undef PG8_LDA
#undef PG8_LDB
#undef PG8_MMA
#undef PG8_WAIT_V
#undef PG8_WAIT_L
#undef PG8_BAR
#undef PG8_SCHED
}
template <bool GATHER, bool PAIRED, class Epi, class Sched>
__device__ __forceinline__ void gemm_phase(LAS unsigned char* lds, const int wv, const int K, const Sched& S, const Epi& E) { gemm_phase2<GATHER, PAIRED, false>(lds, wv, K, S, E, E); }
}
template <class Epi>
__device__ __forceinline__ void fgemm_dense(LAS unsigned char* lds, const int wv, const bf16* A, const bf16* Bt, int M, int N, int K, const Epi& epi) {
    pg8::DenseOrder S; S.init(A, Bt, M, N, K);
    pg8::gemm_phase<false, false>(lds, wv, K, S, epi);
}
template <class Epi>
__device__ __forceinline__ void fgemm_paired(LAS unsigned char* lds, const int wv, const bf16* A1, const bf16* B1, const bf16* A2, const bf16* B2, int M, int N, int K, const Epi& epi) {
    pg8::PairedOrder S; S.d.init(A1, B1, M, N, K); S.A2 = (const char*)A2; S.B2 = (const char*)B2;
    pg8::gemm_phase<false, true>(lds, wv, K, S, epi);
}

__device__ __forceinline__ void scan_hgrn(const Args& a, LAS unsigned char* lds, int b, int h, bool meta_only) {
    unsigned char* ws = a.ws; const int tid = threadIdx.x, v = tid >> 2, kq = tid & 3;
    LAS float* qs = (LAS float*)lds; LAS float* fs = qs + 16 * 128;
    const float* meta = (const float*)(ws + WS_META);
    bf16* QA = (bf16*)(ws + WS_QA); const bf16* LFA = (const bf16*)(ws + WS_LFA); const bf16* IA = (const bf16*)(ws + WS_IA);
    float S[32];
#pragma unroll
    for (int j = 0; j < 32; ++j) S[j] = 0.f;
    for (int blk = -1; blk < SEQ / 16; ++blk) {
        __syncthreads();
        for (int i = tid; i < 16 * 128; i += 512) { const int s = i >> 7, k = i & 127;
            if (blk < 0) { qs[i] = meta[0 * 16384 + s * 1024 + h * 128 + k]; fs[i] = __expf(meta[1 * 16384 + s * 1024 + h * 128 + k]); }
            else { const size_t t = (size_t)b * SEQ + blk * 16 + s; qs[i] = bf2f(QA[t * D + h * 128 + k]); fs[i] = __expf(h2f(LFA[t * D + h * 128 + k])); } }
        __syncthreads();
        for (int s = 0; s < 16; ++s) {
            float vt; size_t t = 0;
            if (blk < 0) vt = meta[2 * 16384 + s * 1024 + h * 128 + v]; else { t = (size_t)b * SEQ + blk * 16 + s; vt = bf2f(IA[t * D + h * 128 + v]); }
            float o = 0.f;
#pragma unroll
            for (int j = 0; j < 32; ++j) { const float f = fs[s * 128 + kq * 32 + j], q = qs[s * 128 + kq * 32 + j]; S[j] = f * S[j] + (1.0f - f) * vt; o += S[j] * q; }
            o += __shfl_xor(o, 1); o += __shfl_xor(o, 2);
            if (blk >= 0 && kq == 0) QA[t * D + h * 128 + v] = (bf16)f2bf(o);
        }
        if (meta_only) { float* sm = (float*)(ws + WS_SMETA) + (size_t)h * 128 * 128;
#pragma unroll
            for (int j = 0; j < 32; ++j) sm[(kq * 32 + j) * 128 + v] = S[j];
            break; }
    }
}
__device__ __forceinline__ void scan_mlstm(const Args& a, LAS unsigned char* lds, int b, int h, bool meta_only) {
    unsigned char* ws = a.ws; const int tid = threadIdx.x, v = tid >> 1, kh = tid & 1;
    LAS float* qs = (LAS float*)lds; LAS float* ks = qs + 16 * 128; LAS float* raw = ks + 16 * 128; LAS float* sc = raw + 19 * 256;
    const float* meta = (const float*)(ws + WS_META); const float* igfg = (const float*)(ws + WS_IGFG);
    const bf16* QKB = (const bf16*)(ws + WS_QKB); bf16* VB = (bf16*)(ws + WS_VB);
    const float* cw = a.in[7]; const float* cb = a.in[8]; const float igb = a.in[9][h], fgb = a.in[10][h];
    float C[64], n[64];
#pragma unroll
    for (int j = 0; j < 64; ++j) { C[j] = 0.f; n[j] = 0.f; }
    float M = 0.f;
    for (int blk = -1; blk < SEQ / 16; ++blk) {
        __syncthreads();
        for (int i = tid; i < 19 * 256; i += 512) { const int r = i >> 8, c = i & 255; const int ch = (c < 128) ? h * 128 + c : 512 + h * 128 + (c - 128);
            float val;
            if (blk < 0) { const int mr = r - 3; val = mr >= 0 ? meta[3 * 16384 + mr * 1024 + ch] : 0.f; }
            else { const int tt = blk * 16 + r - 3; val = tt >= 0 ? bf2f(QKB[((size_t)b * SEQ + tt) * D + ch]) : meta[3 * 16384 + (16 + tt) * 1024 + ch]; }
            raw[i] = val; }
        if (tid < 16) { float ig, fg;
            if (blk < 0) { ig = meta[5 * 16384 + tid * 8 + h]; fg = meta[5 * 16384 + tid * 8 + 4 + h]; }
            else { const size_t t = (size_t)b * SEQ + blk * 16 + tid; ig = igfg[t * 8 + h]; fg = igfg[t * 8 + 4 + h]; }
            ig += igb; fg += fgb;
            sc[tid] = ig; sc[16 + tid] = fminf(fg, 0.f) - log1pf(__expf(-fabsf(fg))); }
        __syncthreads();
        for (int i = tid; i < 16 * 256; i += 512) { const int s = i >> 8, c = i & 255; const int ch = (c < 128) ? h * 128 + c : 512 + h * 128 + (c - 128);
            float y = cb[ch];
#pragma unroll
            for (int j = 0; j < 4; ++j) y += cw[j * 1024 + ch] * raw[(s + j) * 256 + c];
            y = siluf_(y);
            if (c < 128) qs[s * 128 + c] = y * 0.08838834764831845f; else ks[s * 128 + c - 128] = y; }
        __syncthreads();
        for (int s = 0; s < 16; ++s) {
            float vt; size_t t = 0;
            if (blk < 0) vt = meta[4 * 16384 + s * 1024 + h * 256 + v]; else { t = (size_t)b * SEQ + blk * 16 + s; vt = bf2f(VB[t * D + h * 256 + v]); }
            const float ig = sc[s], lf = sc[16 + s]; const float Mn = fmaxf(lf + M, ig), fd = __expf(lf + M - Mn), iw = __expf(ig - Mn); M = Mn;
            float num = 0.f, den = 0.f; const float iv = iw * vt;
#pragma unroll
            for (int j = 0; j < 64; ++j) { const float kv = ks[s * 128 + kh * 64 + j], q = qs[s * 128 + kh * 64 + j]; C[j] = fd * C[j] + iv * kv; n[j] = fd * n[j] + iw * kv; num += C[j] * q; den += n[j] * q; }
            num += __shfl_xor(num, 1); den += __shfl_xor(den, 1);
            const float hv = num / fmaxf(fabsf(den), __expf(-M));
            if (blk >= 0 && kh == 0) VB[t * D + h * 256 + v] = (bf16)f2bf(hv);
        }
        if (meta_only) { float* cm = (float*)(ws + WS_CMETA) + (size_t)h * 128 * 256; float* nm = (float*)(ws + WS_NMETA);
#pragma unroll
            for (int j = 0; j < 64; ++j) { cm[(kh * 64 + j) * 256 + v] = C[j]; if (v == 0) nm[h * 128 + kh * 64 + j] = n[j]; }
            if (tid == 0) nm[1024 + h] = M;
            break; }
    }
}

__device__ __forceinline__ void s0_hgrn_prep(const Args& a) {
    unsigned char* ws = a.ws;
    for (int it = blockIdx.x * 512 + threadIdx.x; it < 1024 * 128; it += gridDim.x * 512) {
        const int oct = it & 127, cg = it >> 7; const size_t base = (size_t)cg * 64 * D + oct * 8;
        bf16* Q = (bf16*)(ws + WS_QA) + base; bf16* L = (bf16*)(ws + WS_LFA) + base;
        float r[8], bc[8];
#pragma unroll
        for (int j = 0; j < 8; ++j) { r[j] = 0.f; bc[j] = 0.f; }
#pragma unroll 4
        for (int s = 0; s < 32; ++s) { const u32x4 w = *(const u32x4*)(L + (size_t)s * D);
#pragma unroll
            for (int i = 0; i < 4; ++i) { r[2 * i] += h2f(w[i] & 0xffffu); r[2 * i + 1] += h2f(w[i] >> 16); } }
#pragma unroll 2
        for (int s = 0; s < 64; ++s) { const u32x4 wl = *(const u32x4*)(L + (size_t)s * D), wq = *(const u32x4*)(Q + (size_t)s * D); float qt[8], kt[8];
#pragma unroll
            for (int i = 0; i < 4; ++i) {
#pragma unroll
                for (int hh = 0; hh < 2; ++hh) { const int j = 2 * i + hh; const float lf = h2f(hh ? (wl[i] >> 16) : (wl[i] & 0xffffu)), q = bf2f(hh ? (wq[i] >> 16) : (wq[i] & 0xffffu));
                    bc[j] += lf; qt[j] = q * __expf(fminf(bc[j] - r[j], 80.f)); kt[j] = -expm1f(lf) * __expf(fminf(r[j] - bc[j], 80.f)); } }
            store8_bf16(Q + (size_t)s * D, qt); store8_bf16(L + (size_t)s * D, kt); }
        float* em = (float*)(ws + WS_EM) + (size_t)cg * 1024 + oct * 8; float* el = (float*)(ws + WS_EL) + (size_t)cg * 1024 + oct * 8;
        *(f32x4*)em = (f32x4){__expf(r[0]), __expf(r[1]), __expf(r[2]), __expf(r[3])}; *(f32x4*)(em + 4) = (f32x4){__expf(r[4]), __expf(r[5]), __expf(r[6]), __expf(r[7])};
        *(f32x4*)el = (f32x4){__expf(bc[0] - r[0]), __expf(bc[1] - r[1]), __expf(bc[2] - r[2]), __expf(bc[3] - r[3])}; *(f32x4*)(el + 4) = (f32x4){__expf(bc[4] - r[4]), __expf(bc[5] - r[5]), __expf(bc[6] - r[6]), __expf(bc[7] - r[7])};
    }
}
__device__ __forceinline__ void s0_mlstm_conv(const Args& a) {
    unsigned char* ws = a.ws; const float* cw = a.in[7]; const float* cb = a.in[8]; const float* meta = (const float*)(ws + WS_META);
    for (int it = blockIdx.x * 512 + threadIdx.x; it < 1024 * 128; it += gridDim.x * 512) {
        const int oct = it & 127, cg = it >> 7, ch = oct * 8; bf16* X = (bf16*)(ws + WS_QKB) + (size_t)cg * 64 * D + ch;
        float w0[8], w1[8], w2[8], c0[8], c1[8], c2[8], c3[8], bb[8];
#pragma unroll
        for (int j = 0; j < 8; ++j) { c0[j] = cw[ch + j]; c1[j] = cw[1024 + ch + j]; c2[j] = cw[2048 + ch + j]; c3[j] = cw[3072 + ch + j]; bb[j] = cb[ch + j]; }
        if ((cg & 127) == 0) {
#pragma unroll
            for (int j = 0; j < 8; ++j) { w0[j] = meta[3 * 16384 + 13 * 1024 + ch + j]; w1[j] = meta[3 * 16384 + 14 * 1024 + ch + j]; w2[j] = meta[3 * 16384 + 15 * 1024 + ch + j]; }
        } else { const bf16* hp = (const bf16*)(ws + WS_HALO) + (size_t)(cg - 1) * 3 * D + ch; load8_bf16(hp, w0); load8_bf16(hp + D, w1); load8_bf16(hp + 2 * D, w2); }
        const bool isq = ch < 512; const int hh = (ch & 511) >> 7; const f32x4* gates = (const f32x4*)(ws + WS_GATES);
        const float scale = isq ? 0.08838834764831845f : 1.0f;
#pragma unroll 2
        for (int s = 0; s < 64; ++s) { float x[8], y[8]; load8_bf16(X + (size_t)s * D, x);
            const f32x4 gt = gates[((size_t)cg * 64 + s) * 4 + hh]; const float rs_ = scale * (isq ? gt.x : gt.y);
#pragma unroll
            for (int j = 0; j < 8; ++j) { const float t = bb[j] + c0[j] * w0[j] + c1[j] * w1[j] + c2[j] * w2[j] + c3[j] * x[j]; y[j] = siluf_(t) * rs_; w0[j] = w1[j]; w1[j] = w2[j]; w2[j] = x[j]; }
            store8_bf16(X + (size_t)s * D, y); }
    }
}
__device__ __forceinline__ float logsigmoidf_(float x) { return fminf(x, 0.f) - log1pf(__expf(-fabsf(x))); }
__device__ __forceinline__ void s0_mlstm_gates(const Args& a, LAS unsigned char* lds, int b, int h) {
    unsigned char* ws = a.ws; const int tid = threadIdx.x, lane = tid & 63, wave = tid >> 6; const float igb = a.in[9][h], fgb = a.in[10][h];
    const float* meta = (const float*)(ws + WS_META); const float* igfg = (const float*)(ws + WS_IGFG); f32x4* gates = (f32x4*)(ws + WS_GATES);
    LAS float* sum = (LAS float*)lds;
    LAS float* mc = sum + 256;
    float bcv[16], pmv[16], igv[16];
    __syncthreads();
#pragma unroll
    for (int i = 0; i < 16; ++i) {
        const int c = wave * 16 + i; const size_t t = (size_t)b * SEQ + c * 64 + lane;
        const float ig = igfg[t * 8 + h] + igb, lf = logsigmoidf_(igfg[t * 8 + 4 + h] + fgb);
        float bc = lf;
#pragma unroll
        for (int o = 1; o < 64; o <<= 1) { const float u = __shfl_up(bc, o); if (lane >= o) bc += u; }
        float pm = ig - bc;
#pragma unroll
        for (int o = 1; o < 64; o <<= 1) { const float u = __shfl_up(pm, o); if (lane >= o) pm = fmaxf(pm, u); }
        bcv[i] = bc; pmv[i] = pm; igv[i] = ig;
        if (lane == 63) { sum[2 * c] = bc; sum[2 * c + 1] = pm; }
    }
    __syncthreads();
    if (tid == 0) { float Mc = 0.f;
        for (int s = 0; s < 16; ++s) { const float ig = meta[5 * 16384 + s * 8 + h] + igb, lf = logsigmoidf_(meta[5 * 16384 + s * 8 + 4 + h] + fgb); Mc = fmaxf(lf + Mc, ig); }
        for (int c = 0; c < 128; ++c) { mc[c] = Mc; Mc = sum[2 * c] + fmaxf(Mc, sum[2 * c + 1]); } }
    __syncthreads();
#pragma unroll
    for (int i = 0; i < 16; ++i) { const int c = wave * 16 + i; const size_t t = (size_t)b * SEQ + c * 64 + lane;
        const float Mt = bcv[i] + fmaxf(mc[c], pmv[i]), bL = __shfl(bcv[i], 63), ML = __shfl(Mt, 63);
        gates[t * 4 + h] = (f32x4){__expf(bcv[i] - Mt - bL + ML), __expf(igv[i] - bcv[i] + bL - ML), __expf(-Mt), __expf(bL + mc[c] - ML)}; }
    __syncthreads();
}
__device__ __forceinline__ void s0_prepass(const Args& a, LAS unsigned char* lds) {
    s0_hgrn_prep(a);
    s0_mlstm_conv(a);
    for (int u = blockIdx.x; u < 12; u += gridDim.x) {
        if (u < 8) scan_hgrn(a, lds, 0, u, true);
        else scan_mlstm(a, lds, 0, u - 8, true); }
}

typedef short v4i16_t __attribute__((ext_vector_type(4)));
typedef short bf16x8_t __attribute__((ext_vector_type(8)));
__device__ __forceinline__ v4i16_t tr16(LAS unsigned char* p) { return __builtin_amdgcn_ds_read_tr16_b64_v4i16((LAS v4i16_t*)p); }
__device__ __forceinline__ bf16x8_t cat44(v4i16_t a, v4i16_t b) { return (bf16x8_t){a[0], a[1], a[2], a[3], b[0], b[1], b[2], b[3]}; }
__device__ __forceinline__ bf16x8_t pack8(f32x4 a, f32x4 b) { const u32x4 w = {pk2(a.x, a.y), pk2(a.z, a.w), pk2(b.x, b.y), pk2(b.z, b.w)}; return __builtin_bit_cast(bf16x8_t, w); }
__device__ __forceinline__ bf16x8_t cat22(u32x2 a, u32x2 b) { const u32x4 w = {a.x, a.y, b.x, b.y}; return __builtin_bit_cast(bf16x8_t, w); }
constexpr int SC_QT = 0, SC_KT = 17408, SC_VT = 34816, SC_PT = 44032, SC_EM = 53248, SC_EL = 53760, SC_QS = 272, SC_VS = 144;

constexpr int S3_SET = 45056, S3_P = 90112, S3_ST = 99328;
__device__ __forceinline__ void fscan3_hgrn(const Args& a, LAS unsigned char* lds, int b, int h, int vh) {
    unsigned char* ws = a.ws; const int tid = threadIdx.x, lane = tid & 63, w = tid >> 6, fr = lane & 15, g = lane >> 4, q4 = fr >> 2, p4 = fr & 3;
    const bf16* QA = (const bf16*)(ws + WS_QA); const bf16* KA = (const bf16*)(ws + WS_LFA); bf16* IA = (bf16*)(ws + WS_IA);
    const float* EMg = (const float*)(ws + WS_EM); const float* ELg = (const float*)(ws + WS_EL);
    const int vt = w & 3, th = w >> 2, tt = w & 3, sh = w >> 2;
    f32x4 S[8];
    { const float* sm = (const float*)(ws + WS_SMETA) + (size_t)h * 128 * 128 + vh * 64 + vt * 16 + fr;
#pragma unroll
      for (int kt = 0; kt < 8; ++kt)
#pragma unroll
          for (int r = 0; r < 4; ++r) S[kt][r] = sm[(16 * kt + 4 * g + r) * 128]; }
    const int r0 = tid >> 4, c0 = tid & 15, rv = tid >> 3, cv = tid & 7;
    u32x4 pq0, pq1, pk0, pk1, pv; f32x4 pe;
#define HG_FETCH(c) do { const size_t t0 = (size_t)b * SEQ + (size_t)(c) * 64; \
        pq0 = *(const u32x4*)(QA + (t0 + r0) * D + h * 128 + c0 * 8); pq1 = *(const u32x4*)(QA + (t0 + r0 + 32) * D + h * 128 + c0 * 8); \
        pk0 = *(const u32x4*)(KA + (t0 + r0) * D + h * 128 + c0 * 8); pk1 = *(const u32x4*)(KA + (t0 + r0 + 32) * D + h * 128 + c0 * 8); \
        pv = *(const u32x4*)(IA + (t0 + rv) * D + h * 128 + vh * 64 + cv * 8); \
        if (tid < 64) { const size_t cgi = ((size_t)b * 128 + (c)) * 1024 + h * 128; pe = *(const f32x4*)((tid < 32 ? EMg : ELg) + cgi + (tid & 31) * 4); } } while (0)
#define HG_COMMIT(sb) do { LAS unsigned char* B_ = lds + (sb); *(LAS u32x4*)(B_ + r0 * SC_QS + c0 * 16) = pq0; *(LAS u32x4*)(B_ + (r0 + 32) * SC_QS + c0 * 16) = pq1; \
        *(LAS u32x4*)(B_ + 17408 + r0 * SC_QS + c0 * 16) = pk0; *(LAS u32x4*)(B_ + 17408 + (r0 + 32) * SC_QS + c0 * 16) = pk1; \
        *(LAS u32x4*)(B_ + 34816 + rv * SC_VS + cv * 16) = pv; \
        if (tid < 64) *(LAS f32x4*)(B_ + (tid < 32 ? 44032 : 44544) + (tid & 31) * 16) = pe; } while (0)
    __syncthreads();
    HG_FETCH(0); HG_COMMIT(0);
    __syncthreads();
    for (int c = 0; c < SEQ / 64; ++c) {
        const int sb = (c & 1) * S3_SET;
        LAS unsigned char* Q_ = lds + sb; LAS unsigned char* K_ = Q_ + 17408; LAS unsigned char* V_ = Q_ + 34816; LAS unsigned char* P_ = lds + S3_P;
        if (c + 1 < SEQ / 64) HG_FETCH(c + 1);
        {
            bf16x8_t bq[4];
#pragma unroll
            for (int ks = 0; ks < 4; ++ks) bq[ks] = *(const LAS bf16x8_t*)(Q_ + (tt * 16 + fr) * SC_QS + ks * 64 + g * 16);
#pragma unroll
            for (int si = 0; si < 2; ++si) { const int st = 2 * sh + si; f32x4 acc = {0.f, 0.f, 0.f, 0.f};
#pragma unroll
                for (int ks = 0; ks < 4; ++ks) { const bf16x8_t ak = *(const LAS bf16x8_t*)(K_ + (st * 16 + fr) * SC_QS + ks * 64 + g * 16); acc = __builtin_amdgcn_mfma_f32_16x16x32_bf16(ak, bq[ks], acc, 0, 0, 0); }
                const int t = tt * 16 + fr, s0 = st * 16 + 4 * g; u32x2 pw;
                pw.x = pk2(s0 + 0 <= t ? acc[0] : 0.f, s0 + 1 <= t ? acc[1] : 0.f); pw.y = pk2(s0 + 2 <= t ? acc[2] : 0.f, s0 + 3 <= t ? acc[3] : 0.f);
                *(LAS u32x2*)(P_ + t * SC_VS + s0 * 2) = pw; }
        }
        __syncthreads();
        {
            bf16x8_t afr[4], vfr[2];
#pragma unroll
            for (int kt = 0; kt < 8; ++kt) S[kt] = S[kt] * *(const LAS f32x4*)(Q_ + 44032 + (16 * kt + 4 * g) * 4);
#pragma unroll
            for (int ks = 0; ks < 4; ++ks) afr[ks] = pack8(S[2 * ks], S[2 * ks + 1]);
#pragma unroll
            for (int k2 = 0; k2 < 2; ++k2) { LAS unsigned char* pa = V_ + (32 * k2 + 8 * g + q4) * SC_VS + (vt * 16 + 4 * p4) * 2; vfr[k2] = cat44(tr16(pa), tr16(pa + 4 * SC_VS)); }
            const size_t t0 = (size_t)b * SEQ + (size_t)c * 64;
#pragma unroll
            for (int ti = 0; ti < 2; ++ti) { const int t = (2 * th + ti) * 16 + fr; f32x4 acc = {0.f, 0.f, 0.f, 0.f};
#pragma unroll
                for (int ks = 0; ks < 4; ++ks) { const u32x2 lo = *(const LAS u32x2*)(Q_ + t * SC_QS + (32 * ks + 4 * g) * 2), hi = *(const LAS u32x2*)(Q_ + t * SC_QS + (32 * ks + 16 + 4 * g) * 2);
                    acc = __builtin_amdgcn_mfma_f32_16x16x32_bf16(afr[ks], cat22(lo, hi), acc, 0, 0, 0); }
#pragma unroll
                for (int k2 = 0; k2 < 2; ++k2) { const bf16x8_t pf = *(const LAS bf16x8_t*)(P_ + t * SC_VS + (32 * k2 + 8 * g) * 2); acc = __builtin_amdgcn_mfma_f32_16x16x32_bf16(vfr[k2], pf, acc, 0, 0, 0); }
                u32x2 ow; ow.x = pk2(acc[0], acc[1]); ow.y = pk2(acc[2], acc[3]);
                *(u32x2*)(IA + (t0 + t) * D + h * 128 + vh * 64 + vt * 16 + 4 * g) = ow;
                float sq = (acc[0] * acc[0] + acc[1] * acc[1]) + (acc[2] * acc[2] + acc[3] * acc[3]); sq += __shfl_xor(sq, 16); sq += __shfl_xor(sq, 32);
                if (g == 0) *(LAS float*)(lds + S3_ST + (vt * 64 + t) * 4) = sq; }
#pragma unroll
            for (int kt = 0; kt < 8; ++kt) {
#pragma unroll
                for (int k2 = 0; k2 < 2; ++k2) { LAS unsigned char* pa = K_ + (32 * k2 + 8 * g + q4) * SC_QS + (16 * kt + 4 * p4) * 2; const bf16x8_t ak = cat44(tr16(pa), tr16(pa + 4 * SC_QS));
                    S[kt] = __builtin_amdgcn_mfma_f32_16x16x32_bf16(ak, vfr[k2], S[kt], 0, 0, 0); }
                S[kt] = S[kt] * *(const LAS f32x4*)(Q_ + 44544 + (16 * kt + 4 * g) * 4); }
        }
        if (c + 1 < SEQ / 64) HG_COMMIT(S3_SET - sb);
        __syncthreads();
        if (tid < 64) { const LAS float* sp = (const LAS float*)(lds + S3_ST) + tid;
            ((float*)(ws + WS_STA2))[((size_t)b * SEQ + (size_t)c * 64 + tid) * 16 + h * 2 + vh] = (sp[0] + sp[64]) + (sp[128] + sp[192]); }
    }
#undef HG_FETCH
#undef HG_COMMIT
}
__device__ __forceinline__ void fscan3_mlstm(const Args& a, LAS unsigned char* lds, int b, int h, int vq) {
    unsigned char* ws = a.ws; const int tid = threadIdx.x, lane = tid & 63, w = tid >> 6, fr = lane & 15, g = lane >> 4, q4 = fr >> 2, p4 = fr & 3;
    const bf16* QK = (const bf16*)(ws + WS_QKB); bf16* VB = (bf16*)(ws + WS_VB); const f32x4* GT = (const f32x4*)(ws + WS_GATES);
    const int vt = w & 3, th = w >> 2, tt = w & 3, sh = w >> 2;
    f32x4 S[8], N[8];
    { const float* cm = (const float*)(ws + WS_CMETA) + (size_t)h * 128 * 256 + vq * 64 + vt * 16 + fr; const float* nm = (const float*)(ws + WS_NMETA) + h * 128;
#pragma unroll
      for (int kt = 0; kt < 8; ++kt)
#pragma unroll
          for (int r = 0; r < 4; ++r) { S[kt][r] = cm[(16 * kt + 4 * g + r) * 256]; N[kt][r] = nm[16 * kt + 4 * g + r]; } }
    const u32x4 onew = {0x3F803F80u, 0x3F803F80u, 0x3F803F80u, 0x3F803F80u}; const bf16x8_t ones = __builtin_bit_cast(bf16x8_t, onew);
    const int r0 = tid >> 4, c0 = tid & 15, rv = tid >> 3, cv = tid & 7;
    u32x4 pq0, pq1, pk0, pk1, pv; f32x4 pe;
#define ML_FETCH(c) do { const size_t t0 = (size_t)b * SEQ + (size_t)(c) * 64; \
        pq0 = *(const u32x4*)(QK + (t0 + r0) * D + h * 128 + c0 * 8); pq1 = *(const u32x4*)(QK + (t0 + r0 + 32) * D + h * 128 + c0 * 8); \
        pk0 = *(const u32x4*)(QK + (t0 + r0) * D + 512 + h * 128 + c0 * 8); pk1 = *(const u32x4*)(QK + (t0 + r0 + 32) * D + 512 + h * 128 + c0 * 8); \
        pv = *(const u32x4*)(VB + (t0 + rv) * D + h * 256 + vq * 64 + cv * 8); \
        if (tid < 64) pe = GT[(t0 + tid) * 4 + h]; } while (0)
#define ML_COMMIT(sb) do { LAS unsigned char* B_ = lds + (sb); *(LAS u32x4*)(B_ + r0 * SC_QS + c0 * 16) = pq0; *(LAS u32x4*)(B_ + (r0 + 32) * SC_QS + c0 * 16) = pq1; \
        *(LAS u32x4*)(B_ + 17408 + r0 * SC_QS + c0 * 16) = pk0; *(LAS u32x4*)(B_ + 17408 + (r0 + 32) * SC_QS + c0 * 16) = pk1; \
        *(LAS u32x4*)(B_ + 34816 + rv * SC_VS + cv * 16) = pv; \
        if (tid < 64) *(LAS f32x4*)(B_ + 44032 + tid * 16) = pe; } while (0)
    __syncthreads();
    ML_FETCH(0); ML_COMMIT(0);
    __syncthreads();
    for (int c = 0; c < SEQ / 64; ++c) {
        const int sb = (c & 1) * S3_SET;
        LAS unsigned char* Q_ = lds + sb; LAS unsigned char* K_ = Q_ + 17408; LAS unsigned char* V_ = Q_ + 34816; LAS unsigned char* G_ = Q_ + 44032; LAS unsigned char* P_ = lds + S3_P;
        if (c + 1 < SEQ / 64) ML_FETCH(c + 1);
        const float decay = (*(const LAS f32x4*)G_).w;
        {
            bf16x8_t bq[4];
#pragma unroll
            for (int ks = 0; ks < 4; ++ks) bq[ks] = *(const LAS bf16x8_t*)(Q_ + (tt * 16 + fr) * SC_QS + ks * 64 + g * 16);
#pragma unroll
            for (int si = 0; si < 2; ++si) { const int st = 2 * sh + si; f32x4 acc = {0.f, 0.f, 0.f, 0.f};
#pragma unroll
                for (int ks = 0; ks < 4; ++ks) { const bf16x8_t ak = *(const LAS bf16x8_t*)(K_ + (st * 16 + fr) * SC_QS + ks * 64 + g * 16); acc = __builtin_amdgcn_mfma_f32_16x16x32_bf16(ak, bq[ks], acc, 0, 0, 0); }
                const int t = tt * 16 + fr, s0 = st * 16 + 4 * g; u32x2 pw;
                pw.x = pk2(s0 + 0 <= t ? acc[0] : 0.f, s0 + 1 <= t ? acc[1] : 0.f); pw.y = pk2(s0 + 2 <= t ? acc[2] : 0.f, s0 + 3 <= t ? acc[3] : 0.f);
                *(LAS u32x2*)(P_ + t * SC_VS + s0 * 2) = pw; }
        }
        __syncthreads();
        {
            bf16x8_t vfr[2];
#pragma unroll
            for (int kt = 0; kt < 8; ++kt) { S[kt] = S[kt] * decay; N[kt] = N[kt] * decay; }
#pragma unroll
            for (int k2 = 0; k2 < 2; ++k2) { LAS unsigned char* pa = V_ + (32 * k2 + 8 * g + q4) * SC_VS + (vt * 16 + 4 * p4) * 2; vfr[k2] = cat44(tr16(pa), tr16(pa + 4 * SC_VS)); }
            const size_t t0 = (size_t)b * SEQ + (size_t)c * 64;
#pragma unroll 1
            for (int ti = 0; ti < 2; ++ti) { const int t = (2 * th + ti) * 16 + fr; f32x4 acc = {0.f, 0.f, 0.f, 0.f}, accd = {0.f, 0.f, 0.f, 0.f};
#pragma unroll
                for (int ks = 0; ks < 4; ++ks) { const bf16x8_t af = pack8(S[2 * ks], S[2 * ks + 1]), an = pack8(N[2 * ks], N[2 * ks + 1]);
                    const u32x2 lo = *(const LAS u32x2*)(Q_ + t * SC_QS + (32 * ks + 4 * g) * 2), hi = *(const LAS u32x2*)(Q_ + t * SC_QS + (32 * ks + 16 + 4 * g) * 2); const bf16x8_t qf = cat22(lo, hi);
                    acc = __builtin_amdgcn_mfma_f32_16x16x32_bf16(af, qf, acc, 0, 0, 0); accd = __builtin_amdgcn_mfma_f32_16x16x32_bf16(an, qf, accd, 0, 0, 0); }
#pragma unroll
                for (int k2 = 0; k2 < 2; ++k2) { const bf16x8_t pf = *(const LAS bf16x8_t*)(P_ + t * SC_VS + (32 * k2 + 8 * g) * 2);
                    acc = __builtin_amdgcn_mfma_f32_16x16x32_bf16(vfr[k2], pf, acc, 0, 0, 0); accd = __builtin_amdgcn_mfma_f32_16x16x32_bf16(ones, pf, accd, 0, 0, 0); }
                const float inv = __builtin_amdgcn_rcpf(fmaxf(fabsf(accd[0]), (*(const LAS f32x4*)(G_ + t * 16)).z));
                const float h0_ = acc[0] * inv, h1_ = acc[1] * inv, h2_ = acc[2] * inv, h3_ = acc[3] * inv;
                u32x2 ow; ow.x = pk2(h0_, h1_); ow.y = pk2(h2_, h3_);
                *(u32x2*)(VB + (t0 + t) * D + h * 256 + vq * 64 + vt * 16 + 4 * g) = ow;
                float s1 = (h0_ + h1_) + (h2_ + h3_), s2 = (h0_ * h0_ + h1_ * h1_) + (h2_ * h2_ + h3_ * h3_);
                s1 += __shfl_xor(s1, 16); s1 += __shfl_xor(s1, 32); s2 += __shfl_xor(s2, 16); s2 += __shfl_xor(s2, 32);
                if (g == 0) { *(LAS float*)(lds + S3_ST + (vt * 64 + t) * 4) = s1; *(LAS float*)(lds + S3_ST + 1024 + (vt * 64 + t) * 4) = s2; } }
#pragma unroll
            for (int kt = 0; kt < 8; ++kt) {
#pragma unroll
                for (int k2 = 0; k2 < 2; ++k2) { LAS unsigned char* pa = K_ + (32 * k2 + 8 * g + q4) * SC_QS + (16 * kt + 4 * p4) * 2; const bf16x8_t ak = cat44(tr16(pa), tr16(pa + 4 * SC_QS));
                    S[kt] = __builtin_amdgcn_mfma_f32_16x16x32_bf16(ak, vfr[k2], S[kt], 0, 0, 0); N[kt] = __builtin_amdgcn_mfma_f32_16x16x32_bf16(ak, ones, N[kt], 0, 0, 0); } }
        }
        if (c + 1 < SEQ / 64) ML_COMMIT(S3_SET - sb);
        __syncthreads();
        if (tid < 128) { const int tk = tid & 63, wh = tid >> 6; const LAS float* sp = (const LAS float*)(lds + S3_ST + wh * 1024) + tk;
            ((float*)(ws + WS_STB2))[(((size_t)b * SEQ + (size_t)c * 64 + tk) * 16 + h * 4 + vq) * 2 + wh] = (sp[0] + sp[64]) + (sp[128] + sp[192]); }
    }
#undef ML_FETCH
#undef ML_COMMIT
}

__device__ __forceinline__ void p_ln1_route(const Args& a, LAS unsigned char* lds) {
    unsigned char* ws = a.ws; const int tid = threadIdx.x, lane = tid & 63, wave = tid >> 6, fr = lane & 15, g = lane >> 4;
    LAS int* hist = (LAS int*)lds; LAS float* rbs = (LAS float*)(lds + 256);
    LAS unsigned char* hw = lds + 1024 + wave * 17408;
    LAS float* st = (LAS float*)(lds + 1024 + 8 * 17408 + wave * 256);
    const bf16* z = (const bf16*)(ws + WS_Z); const bf16* WT = (const bf16*)(ws + WS_WRT);
    bf16* h1 = (bf16*)(ws + WS_H0); float* lnst = (float*)(ws + WS_LNST1);
    int* eidx = (int*)(ws + WS_EIDX); float* gwp = (float*)(ws + WS_GW); int* lpos = (int*)(ws + WS_LPOS); int* wgbase = (int*)(ws + WS_WGBASE);
    unsigned* gcnt = (unsigned*)(ws + WS_CTL) + CW_GCNT;
    for (int tile = blockIdx.x; tile < T / 256; tile += gridDim.x) {
        const int half = tile / (T / 512), m0 = tile * 256 + wave * 32;
        __syncthreads();
        if (tid < 64) { hist[tid] = 0; rbs[tid] = a.in[18][tid]; }
        __syncthreads();
        {
            const f32x4* gp = (const f32x4*)a.in[15] + lane; const f32x4* bp = (const f32x4*)a.in[16] + lane;
            f32x4 gg[4], bb[4]; u32x2 zn[4];
#pragma unroll
            for (int j = 0; j < 4; ++j) { gg[j] = gp[64 * j]; bb[j] = bp[64 * j]; zn[j] = ((const u32x2*)(z + (size_t)m0 * D) + lane)[64 * j]; }
            for (int rr = 0; rr < 32; ++rr) {
                const int m = m0 + rr; f32x4 v[4]; float s = 0.f;
#pragma unroll
                for (int j = 0; j < 4; ++j) { const u32x2 zw = zn[j]; v[j] = (f32x4){bf2f(zw.x & 0xffffu), bf2f(zw.x >> 16), bf2f(zw.y & 0xffffu), bf2f(zw.y >> 16)}; s += (v[j].x + v[j].y) + (v[j].z + v[j].w); }
                if (rr + 1 < 32) {
#pragma unroll
                    for (int j = 0; j < 4; ++j) zn[j] = ((const u32x2*)(z + (size_t)(m + 1) * D) + lane)[64 * j]; }
                const float mean = wave_sum(s) * (1.f / D); float s2 = 0.f;
#pragma unroll
                for (int j = 0; j < 4; ++j) { v[j] = v[j] - mean; s2 += (v[j].x * v[j].x + v[j].y * v[j].y) + (v[j].z * v[j].z + v[j].w * v[j].w); }
                const float rstd = 1.f / sqrtf(wave_sum(s2) * (1.f / D) + EPS);
                unsigned* o4 = (unsigned*)(ws + WS_H8 + (size_t)m * D) + lane; unsigned long long* o8 = (unsigned long long*)(h1 + (size_t)m * D) + lane;
#pragma unroll
                for (int j = 0; j < 4; ++j) { const f32x4 h = v[j] * rstd * gg[j] + bb[j];
                    int w8 = __builtin_amdgcn_cvt_pk_fp8_f32(h.x, h.y, 0, false); w8 = __builtin_amdgcn_cvt_pk_fp8_f32(h.z, h.w, w8, true); o4[64 * j] = (unsigned)w8;
                    const f32x4 ah = h * DN_ALPHA; o8[64 * j] = (unsigned long long)pk2(ah.x, ah.y) | ((unsigned long long)pk2(ah.z, ah.w) << 32); }
                if (lane == 0) { lnst[2 * m] = mean; lnst[2 * m + 1] = rstd; st[2 * rr] = mean; st[2 * rr + 1] = rstd; }
            }
        }
        asm volatile("s_waitcnt lgkmcnt(0)" ::: "memory");
        f32x4 acc[2][4];
#pragma unroll
        for (int mt = 0; mt < 2; ++mt)
#pragma unroll
            for (int n = 0; n < 4; ++n) acc[mt][n] = (f32x4){0.f, 0.f, 0.f, 0.f};
        for (int kc = 0; kc < 8; ++kc) {
            { const int kk = (lane & 31) * 4; const f32x4 g4 = *(const f32x4*)(a.in[15] + kc * 128 + kk), b4 = *(const f32x4*)(a.in[16] + kc * 128 + kk);
#pragma unroll 4
              for (int i = 0; i < 16; ++i) { const int row = 2 * i + (lane >> 5); const u32x2 zw = *(const u32x2*)(z + (size_t)(m0 + row) * D + kc * 128 + kk);
                  const f32x4 z4 = {bf2f(zw.x & 0xffffu), bf2f(zw.x >> 16), bf2f(zw.y & 0xffffu), bf2f(zw.y >> 16)};
                  const float mean = st[2 * row], rstd = st[2 * row + 1]; const f32x4 h = (z4 - mean) * rstd * g4 + b4;
                  u32x2 hi; hi.x = pk2(h.x, h.y); hi.y = pk2(h.z, h.w);
                  const f32x4 hr = {bf2f(hi.x & 0xffffu), bf2f(hi.x >> 16), bf2f(hi.y & 0xffffu), bf2f(hi.y >> 16)}; const f32x4 l4 = h - hr;
                  u32x2 lo; lo.x = pk2(l4.x, l4.y); lo.y = pk2(l4.z, l4.w);
                  *(LAS u32x2*)(hw + row * 272 + kk * 2) = hi; *(LAS u32x2*)(hw + 8704 + row * 272 + kk * 2) = lo; } }
            asm volatile("s_waitcnt lgkmcnt(0)" ::: "memory");
#pragma unroll
            for (int ks = 0; ks < 4; ++ks) {
                bf16x8_t ah[2], al[2];
#pragma unroll
                for (int mt = 0; mt < 2; ++mt) { ah[mt] = *(const LAS bf16x8_t*)(hw + (16 * mt + fr) * 272 + ks * 64 + g * 16); al[mt] = *(const LAS bf16x8_t*)(hw + 8704 + (16 * mt + fr) * 272 + ks * 64 + g * 16); }
#pragma unroll
                for (int n = 0; n < 4; ++n) { const bf16* wp = WT + (size_t)(16 * n + fr) * 1024 + kc * 128 + ks * 32 + g * 8;
                    const bf16x8_t bh = *(const bf16x8_t*)wp, bl = *(const bf16x8_t*)(wp + 65536);
#pragma unroll
                    for (int mt = 0; mt < 2; ++mt) { acc[mt][n] = __builtin_amdgcn_mfma_f32_16x16x32_bf16(ah[mt], bh, acc[mt][n], 0, 0, 0);
                        acc[mt][n] = __builtin_amdgcn_mfma_f32_16x16x32_bf16(al[mt], bh, acc[mt][n], 0, 0, 0); acc[mt][n] = __builtin_amdgcn_mfma_f32_16x16x32_bf16(ah[mt], bl, acc[mt][n], 0, 0, 0); } }
            }
            asm volatile("s_waitcnt lgkmcnt(0)" ::: "memory");
        }
        { LAS float* lg = (LAS float*)hw;
#pragma unroll
          for (int mt = 0; mt < 2; ++mt)
#pragma unroll
              for (int n = 0; n < 4; ++n)
#pragma unroll
                  for (int r = 0; r < 4; ++r) lg[(16 * mt + 4 * g + r) * 65 + 16 * n + fr] = acc[mt][n][r]; }
        asm volatile("s_waitcnt lgkmcnt(0)" ::: "memory");
        if (lane < 32) {
            const LAS float* lg = (const LAS float*)hw + lane * 65; const int m = m0 + lane;
            float bsc[64];
#pragma unroll
            for (int e2 = 0; e2 < 64; ++e2) bsc[e2] = 1.0f / (1.0f + expf(-lg[e2])) + rbs[e2];
            float gs[8];
#pragma unroll
            for (int gi = 0; gi < 8; ++gi) { float m1 = -INFINITY, m2 = -INFINITY;
#pragma unroll
                for (int j = 0; j < 8; ++j) { const float v = bsc[8 * gi + j]; m2 = fmaxf(m2, fminf(m1, v)); m1 = fmaxf(m1, v); }
                gs[gi] = m1 + m2; }
            unsigned selmask = 0;
#pragma unroll
            for (int gi = 0; gi < 8; ++gi) { int rank = 0;
#pragma unroll
                for (int gj = 0; gj < 8; ++gj) rank += (gs[gj] > gs[gi] || (gs[gj] == gs[gi] && gj < gi)) ? 1 : 0;
                selmask |= (rank < 4) ? (1u << gi) : 0u; }
            float tv[8]; int te[8];
#pragma unroll
            for (int i = 0; i < 8; ++i) { tv[i] = -INFINITY; te[i] = 0; }
#pragma unroll
            for (int e2 = 0; e2 < 64; ++e2) { float v = ((selmask >> (e2 >> 3)) & 1u) ? bsc[e2] : -INFINITY; int id = e2;
#pragma unroll
                for (int i = 0; i < 8; ++i) { const bool sw = v > tv[i]; const float tvv = tv[i]; const int tee = te[i]; tv[i] = sw ? v : tvv; te[i] = sw ? id : tee; v = sw ? tvv : v; id = sw ? tee : id; } }
            float sc[8], ssum = 0.f;
#pragma unroll
            for (int i = 0; i < 8; ++i) { sc[i] = tv[i] - rbs[te[i]]; ssum += sc[i]; }
            const float scale = ROUTED_SCALE / ssum;
#pragma unroll
            for (int i = 0; i < 8; ++i) { eidx[(size_t)m * 8 + i] = te[i]; gwp[(size_t)m * 8 + i] = sc[i] * scale; lpos[(size_t)m * 8 + i] = atomicAdd((int*)&hist[te[i]], 1); }
        }
        __syncthreads();
        if (tid < 64) wgbase[tile * 64 + tid] = (int)atomicAdd(&gcnt[half * 64 + tid], (unsigned)hist[tid]);
    }
}
__device__ __forceinline__ void load_pstart(const Args& a, LAS int* ps) {
    const unsigned* gcnt = (const unsigned*)(a.ws + WS_CTL) + CW_GCNT;
    __syncthreads();
    if (tidx_(a.wv) < 2) { const int hf = tidx_(a.wv); int acc = 0;
        for (int e = 0; e < 64; ++e) { ps[hf * 65 + e] = acc; const int c = (int)__hip_atomic_load(gcnt + hf * 64 + e, __ATOMIC_RELAXED, __HIP_MEMORY_SCOPE_AGENT); acc += (c + 255) / 256 * 256; }
        ps[hf * 65 + 64] = acc; }
    __syncthreads();
}
__device__ __forceinline__ void p_slots(const Args& a, LAS unsigned char* lds) {
    unsigned char* ws = a.ws; LAS int* ps = (LAS int*)lds; load_pstart(a, ps);
    const int* eidx = (const int*)(ws + WS_EIDX); const float* gwp = (const float*)(ws + WS_GW); const int* lpos = (const int*)(ws + WS_LPOS); const int* wgbase = (const int*)(ws + WS_WGBASE);
    int* slotof = (int*)(ws + WS_SLOTOF); int* tokslot = (int*)(ws + WS_TOKSLOT); float* wslot = (float*)(ws + WS_WSLOT);
    for (int tile = blockIdx.x; tile < T / 256; tile += gridDim.x) {
        const int half = tile / (T / 512);
        for (int i = threadIdx.x; i < 256 * 8; i += 512) { const size_t idx = (size_t)tile * 2048 + i; const int e = eidx[idx];
            const int slot = ps[half * 65 + e] + wgbase[tile * 64 + e] + lpos[idx];
            slotof[idx] = slot; tokslot[(size_t)half * NSLOTMAX + slot] = (int)(idx >> 3); wslot[(size_t)half * NSLOTMAX + slot] = gwp[idx]; }
    }
}
template <bool DOWN>
__device__ __forceinline__ void f_moe_gemm(const Args& a, LAS unsigned char* lds, int half) {
    unsigned char* ws = a.ws; LAS int* ps = (LAS int*)(lds + 131072); LAS int* te = (LAS int*)(lds + 131072 + 1024); load_pstart(a, ps);
    const int nrt = __builtin_amdgcn_readfirstlane(ps[half * 65 + 64] / 256);
    for (int rt = tidx_(a.wv); rt < nrt; rt += 512) { int e = 0; for (int j = 1; j < 64; ++j) if (ps[half * 65 + j] <= rt * 256) e = j; te[rt] = e; }
    __syncthreads();
    pg8::GroupedOrder S; S.te = te; S.nct = DOWN ? 4 : 2; S.nrt = nrt; S.nwg1 = nrt * S.nct; S.nwg2 = (HALF_T / 256) * S.nct; S.G = gridDim.x; S.c = blockIdx.x;
    S.idx = (const int*)(ws + WS_TOKSLOT) + (size_t)half * NSLOTMAX; S.ident = (const int*)(ws + WS_IDENT) + half * HALF_T;
    if (!DOWN) { S.K = 512; S.A = (const char*)(ws + WS_H8); S.Bt = (const char*)(ws + WS_WGU); S.Bsh = (const char*)(ws + WS_WSGU); S.estride = (size_t)512 * 1024; S.gather = true;
        const EpiGU eg{(unsigned char*)(ws + WS_HH)}; pg8::gemm_phase2<true, false, true>(lds, a.wv, 512, S, eg, eg); }
    else { S.K = 128; S.A = (const char*)(ws + WS_HH); S.Bt = (const char*)(ws + WS_WD); S.Bsh = (const char*)(ws + WS_WSD); S.estride = (size_t)1024 * 256; S.gather = false;
        pg8::GroupedOrder S1 = S; S1.nwg2 = 0; const EpiDown ed{(unsigned char*)(ws + WS_YH), (const float*)(ws + WS_WSLOT) + (size_t)half * NSLOTMAX};
        pg8::gemm_phase2<false, false, true>(lds, a.wv, 128, S1, ed, ed);
        pg8::GroupedOrder S2 = S; S2.nwg1 = 0; const EpiSD2 es{ws, half * HALF_T};
        pg8::gemm_phase2<false, false, true>(lds, a.wv, 128, S2, es, es); }
}
__device__ __forceinline__ void p_combine(const Args& a, int half) {
    unsigned char* ws = a.ws; const int lane = tidx_(a.wv) & 63, gw = blockIdx.x * 8 + (tidx_(a.wv) >> 6), NGW = gridDim.x * 8;
    const unsigned char* Y = (const unsigned char*)(ws + WS_YH); const int* slotof = (const int*)(ws + WS_SLOTOF);
    const f32x4* gp = (const f32x4*)a.in[25] + lane; const f32x4* bp = (const f32x4*)a.in[26] + lane;
    for (int mm = gw; mm < HALF_T; mm += NGW) {
        const int m = half * HALF_T + mm;
        f32x4* rr = (f32x4*)(a.out + (size_t)m * D) + lane; const u32x2* rb16 = (const u32x2*)((const bf16*)(ws + WS_H0) + (size_t)m * D) + lane;
        f32x4 v[4];
#pragma unroll
        for (int j = 0; j < 4; ++j) { const u32x2 rw = rb16[64 * j]; v[j] = (f32x4){bf2f(rw.x & 0xffffu), bf2f(rw.x >> 16), bf2f(rw.y & 0xffffu), bf2f(rw.y >> 16)}; }
        f32x4 ys[4];
#pragma unroll
        for (int j = 0; j < 4; ++j) ys[j] = (f32x4){0.f, 0.f, 0.f, 0.f};
        int sl[8];
#pragma unroll
        for (int k = 0; k < 8; ++k) sl[k] = slotof[(size_t)m * 8 + k];
#pragma unroll
        for (int k = 0; k < 8; ++k) { const unsigned* yr = (const unsigned*)(Y + (size_t)sl[k] * D) + lane;
#pragma unroll
            for (int j = 0; j < 4; ++j) { const int w = (int)yr[64 * j]; const f32x2_t lo = __builtin_amdgcn_cvt_pk_f32_fp8(w, false), hi = __builtin_amdgcn_cvt_pk_f32_fp8(w, true);
                ys[j].x += lo.x; ys[j].y += lo.y; ys[j].z += hi.x; ys[j].w += hi.y; } }
#pragma unroll
        for (int j = 0; j < 4; ++j) v[j] = v[j] + ys[j] * 0.03125f;
        float s = 0.f;
#pragma unroll
        for (int j = 0; j < 4; ++j) s += (v[j].x + v[j].y) + (v[j].z + v[j].w);
        const float mean = wave_sum(s) * (1.f / D); float s2 = 0.f;
#pragma unroll
        for (int j = 0; j < 4; ++j) { v[j] = v[j] - mean; s2 += (v[j].x * v[j].x + v[j].y * v[j].y) + (v[j].z * v[j].z + v[j].w * v[j].w); }
        const float rstd = 1.f / sqrtf(wave_sum(s2) * (1.f / D) + EPS);
#pragma unroll
        for (int j = 0; j < 4; ++j) rr[64 * j] = v[j] * rstd * gp[64 * j] + bp[64 * j];
    }
}

__global__ void __launch_bounds__(512, 2) fwd(const KArgs ka) {
    extern __shared__ __attribute__((aligned(16))) unsigned char lds_raw[];
    LAS unsigned char* lds = (LAS unsigned char*)lds_raw;
    const Args a{ka.in, ka.out, ka.ws, __builtin_amdgcn_readfirstlane((int)threadIdx.x >> 6)};
    unsigned char* ws = a.ws;
    const int lo = ka.ph_lo, hi = ka.ph_hi;
    volatile LAS unsigned* bst = (volatile LAS unsigned*)(lds + LDS_BYTES - 16);
    const bool lead = tidx_(a.wv) == 0;
    if (lead) { bst[0] = 0u; bst[1] = 0u; }
    __syncthreads();
    XcdBarrier bar = xcd_barrier_post((unsigned*)(ws + WS_CTL) + CW_BAR, bst, lead);
#ifndef PH_MASK
#define PH_MASK 0xFFFFFFFFu
#endif
#define IN(k) ((((PH_MASK) >> (k)) & 1u) && lo <= (k) && (k) < hi)
#define SEAM(k) do { if (IN(k) && IN((k) + 1)) xcd_barrier(bar); } while (0)
    if (IN(0)) p0_prologue(a, lds);
    SEAM(0);
    if (IN(1)) { for (int u = blockIdx.x; u < 32; u += gridDim.x) s0_mlstm_gates(a, lds, u >> 2, u & 3); }
    if (IN(1)) fgemm_dense(lds, a.wv, (const bf16*)(ws + WS_H0), (const bf16*)(ws + WS_WINT), T, 7168, 1024, EpiA{ws, (unsigned char*)a.out, a.in[5]});
    SEAM(1);
    if (IN(2)) s0_prepass(a, lds);
    SEAM(2);
    if (IN(3)) { for (int u = blockIdx.x; u < 256; u += gridDim.x) if (u < 128) fscan3_hgrn(a, lds, u >> 4, (u >> 1) & 7, u & 1); }
    asm volatile("" ::: "memory");
    if (IN(3)) { for (int u = blockIdx.x; u < 256; u += gridDim.x) if (u >= 128) fscan3_mlstm(a, lds, (u - 128) >> 4, ((u - 128) >> 2) & 3, (u - 128) & 3); }
    if (IN(3) && IN(5)) xcd_barrier(bar);
    if (IN(5)) fgemm_dense(lds, a.wv, (const bf16*)(ws + WS_H0), (const bf16*)(ws + WS_WINT) + (size_t)7168 * 1024, T, 2048, 1024, EpiB{ws, a.in[6], a.in[11]});
    SEAM(5);
    if (IN(6)) fgemm_paired(lds, a.wv, (const bf16*)(ws + WS_LFA), (const bf16*)(ws + WS_WAT), (const bf16*)(ws + WS_QKB), (const bf16*)(ws + WS_WBT), T, 1024, 1024, EpiC{ws, (const bf16*)a.out, (const bf16*)a.out + (size_t)T * D});
    SEAM(6);
    if (IN(7)) fgemm_dense(lds, a.wv, (const bf16*)(ws + WS_IA), (const bf16*)(ws + WS_WOT), T, 1024, 1024, EpiD{ws, a.out, a.in[0], a.in[2], a.in[3]});
    SEAM(7);
    if (IN(8)) p_ln1_route(a, lds);
    SEAM(8);
    if (IN(9)) p_slots(a, lds);
    SEAM(9);
    if (IN(10)) f_moe_gemm<false>(a, lds, 0);
    SEAM(10);
    if (IN(11)) f_moe_gemm<true>(a, lds, 0);
    SEAM(11);
    if (IN(12)) p_combine(a, 0);
    __syncthreads();
    if (IN(13)) f_moe_gemm<false>(a, lds, 1);
    SEAM(13);
    if (IN(14)) f_moe_gemm<true>(a, lds, 1);
    SEAM(14);
    if (IN(15)) p_combine(a, 1);
#undef IN
#undef SEAM
}

extern "C" void kernel_launch(void* const* d_in, const int* in_sizes, int n_in, void* d_out, int out_size, void* d_ws, size_t ws_size, hipStream_t stream) {
    static int grid = 0;
    if (grid == 0) {
        if (n_in != 27 || out_size != T * D || ws_size < WS_END) { fprintf(stderr, "kernel_launch: unexpected shapes (n_in %d out %d ws %zu)\n", n_in, out_size, ws_size); grid = -1; return; }
        int dev = 0, cus = 0;
        if (hipGetDevice(&dev) != hipSuccess || hipDeviceGetAttribute(&cus, hipDeviceAttributeMultiprocessorCount, dev) != hipSuccess) { grid = -1; return; }
        if (hipFuncSetAttribute((const void*)fwd, hipFuncAttributeMaxDynamicSharedMemorySize, LDS_BYTES) != hipSuccess) { grid = -1; return; }
        int per_cu = 0; (void)hipOccupancyMaxActiveBlocksPerMultiprocessor(&per_cu, (const void*)fwd, 512, LDS_BYTES); (void)hipGetLastError();
        grid = cus;
    }
    if (grid < 0) return;
    (void)hipMemsetAsync((char*)d_ws + WS_CTL + CW_BAR * 4, 0, (CW_GCNT + 128 - CW_BAR) * 4, stream);
    KArgs a{};
    for (int i = 0; i < 27; ++i) a.in[i] = (const float*)d_in[i];
    a.out = (float*)d_out; a.ws = (unsigned char*)d_ws;
    a.ph_lo = 0; a.ph_hi = 16; hipLaunchKernelGGL(fwd, dim3(grid), dim3(512), LDS_BYTES, stream, a);
}
```

```cpp
#include <hip/hip_runtime.h>
#include <stdint.h>
#include <stdio.h>
#include <type_traits>

#define LAS __attribute__((address_space(3)))
typedef unsigned short bf16;
typedef float f32x4 __attribute__((ext_vector_type(4)));
typedef unsigned u32x4 __attribute__((ext_vector_type(4)));
typedef unsigned u32x2 __attribute__((ext_vector_type(2)));

constexpr int D = 1024, NB = 8, SEQ = 8192, T = NB * SEQ, NMETA = 16, INW = 9224;
constexpr int NEXP = 64, TOPK = 8, DEXP = 256;
constexpr float EPS = 1e-5f, DN_ALPHA = 1.189207115002721f, ROUTED_SCALE = 2.5f;
constexpr int HALF_T = T / 2;
constexpr int NSLOTMAX = HALF_T * TOPK + NEXP * 256;

constexpr size_t MiB = 1u << 20;
constexpr size_t WS_CTL = 0, CTL_ZERO_BYTES = 1 * MiB;
constexpr size_t WS_WINT = 1 * MiB;
constexpr size_t WS_WAT = 19 * MiB, WS_WBT = 21 * MiB, WS_WOT = 23 * MiB;
constexpr size_t WS_WSGU = 25 * MiB;
constexpr size_t WS_WSD = 26 * MiB;
constexpr size_t WS_META = 27 * MiB;
constexpr size_t WS_WRT = 27 * MiB + 512 * 1024;
constexpr size_t WS_IGFG = 28 * MiB;
constexpr size_t WS_LNST0 = 30 * MiB;
constexpr size_t WS_LNST1 = 30 * MiB + 512 * 1024;
constexpr size_t WS_STA = 31 * MiB;
constexpr size_t WS_STB = 33 * MiB;
constexpr size_t WS_EIDX = 35 * MiB, WS_GW = 37 * MiB, WS_LPOS = 39 * MiB, WS_SLOTOF = 41 * MiB;
constexpr size_t WS_TOKSLOT = 43 * MiB;
constexpr size_t WS_WSLOT = 46 * MiB;
constexpr size_t WS_WGBASE = 49 * MiB;
constexpr size_t WS_IDENT = 49 * MiB + 128 * 1024;
constexpr size_t WS_EM = 50 * MiB, WS_EL = 54 * MiB;
constexpr size_t WS_HALO = 58 * MiB;
constexpr size_t WS_GATES = 932 * MiB;
constexpr size_t WS_SMETA = 940 * MiB;
constexpr size_t WS_CMETA = 941 * MiB;
constexpr size_t WS_NMETA = 942 * MiB;
constexpr size_t WS_STA2 = 944 * MiB;
constexpr size_t WS_STB2 = 948 * MiB;
constexpr size_t WS_WGU = 64 * MiB;
constexpr size_t WS_WD = 128 * MiB;
constexpr size_t WS_H0 = 162 * MiB;
constexpr size_t WS_QA = 290 * MiB, WS_LFA = 418 * MiB, WS_IA = 546 * MiB, WS_QKB = 674 * MiB, WS_VB = 802 * MiB;
constexpr size_t WS_HH = 290 * MiB;
constexpr size_t WS_YH = 444 * MiB;
constexpr size_t WS_HS = 980 * MiB;
constexpr size_t WS_Z = 720 * MiB;
constexpr size_t WS_H8 = 850 * MiB;
constexpr size_t WS_END = 1024 * MiB;
static_assert(WS_HH + (size_t)(NSLOTMAX + HALF_T) * 512 <= WS_YH && WS_YH + (size_t)NSLOTMAX * 1024 <= WS_Z && WS_Z + (size_t)T * D * 2 <= WS_GATES, "moe map");
constexpr int CW_BAR = 4096, CW_GCNT = 8192;

constexpr int LDS_BYTES = 147456;
constexpr int NPHASE = 20;

__device__ __forceinline__ unsigned f2bf(float f) { unsigned u = __float_as_uint(f); return (u + 0x7fffu + ((u >> 16) & 1u)) >> 16; }
__device__ __forceinline__ float bf2f(unsigned h) { return __uint_as_float(h << 16); }
typedef __bf16 hwbf16x2_t __attribute__((ext_vector_type(2)));
typedef float f32x2_t __attribute__((ext_vector_type(2)));
__device__ __forceinline__ unsigned pk2(float lo, float hi) { const f32x2_t f = {lo, hi}; const hwbf16x2_t b = __builtin_convertvector(f, hwbf16x2_t); return __builtin_bit_cast(unsigned, b); }
__device__ __forceinline__ unsigned f2h(float f) { _Float16 h = (_Float16)f; return (unsigned)__builtin_bit_cast(unsigned short, h); }
__device__ __forceinline__ float h2f(unsigned u) { return (float)__builtin_bit_cast(_Float16, (unsigned short)u); }
#define DPPF(v, ctrl) __builtin_bit_cast(float, __builtin_amdgcn_update_dpp(0, __builtin_bit_cast(int, (v)), (ctrl), 0xf, 0xf, true))
__device__ __forceinline__ float rl_(float v, const int l) { return __builtin_bit_cast(float, __builtin_amdgcn_readlane(__builtin_bit_cast(int, v), l)); }
__device__ __forceinline__ float wave_sum(float v) {
    v += DPPF(v, 0xB1); v += DPPF(v, 0x4E); v += DPPF(v, 0x141); v += DPPF(v, 0x140);
    return (rl_(v, 0) + rl_(v, 16)) + (rl_(v, 32) + rl_(v, 48));
}
__device__ __forceinline__ void store8_bf16(bf16* p, const float (&v)[8]);
__device__ __forceinline__ float sigmoidf_(float x) { return __builtin_amdgcn_rcpf(1.0f + __expf(-x)); }
__device__ __forceinline__ float siluf_(float x) { return x * __builtin_amdgcn_rcpf(1.0f + __expf(-x)); }


#define XB_TMO      128
#define XB_XCNT(j)  (256  + 64 * (j))
#define XB_XSUB(j)  (1280 + 64 * (j))
#define XB_XGEN(j)  (2304 + 64 * (j))
#define XB_TOP      3328
#define XB_TOPGEN   3392
#define XCD_BAR_WORDS 3456
#define XB_SPIN_CAP (1u << 20)
__device__ __forceinline__ unsigned xb_ld(unsigned* p)              { return __hip_atomic_load(p, __ATOMIC_RELAXED, __HIP_MEMORY_SCOPE_AGENT); }
__device__ __forceinline__ unsigned xb_add(unsigned* p, unsigned v) { return __hip_atomic_fetch_add(p, v, __ATOMIC_RELAXED, __HIP_MEMORY_SCOPE_AGENT); }
__device__ __forceinline__ unsigned xb_xcc_id() { return (unsigned)__builtin_amdgcn_s_getreg((3 << 11) | 20) & 0xFu; }
#define XB_SPIN(cond, bar) do { unsigned _sp = 0; while (cond) { __builtin_amdgcn_s_sleep(1); \
    if ((++_sp & 255u) == 0u) { if (xb_ld(&(bar)[XB_TMO])) break; if (_sp > XB_SPIN_CAP) { atomicAdd(&(bar)[XB_TMO], 1u); break; } } } } while (0)
struct XcdBarrier { unsigned* bar; unsigned x; volatile LAS unsigned* st; bool lead; };
__device__ __forceinline__ XcdBarrier xcd_barrier_post(unsigned* bar, volatile LAS unsigned* st, bool lead) {
    XcdBarrier b; b.bar = bar; b.x = xb_xcc_id(); b.st = st; b.lead = lead;
    if (lead) (void)xb_add(&bar[XB_XCNT(b.x)], 1u);
    return b;
}
__device__ __forceinline__ void xcd_barrier_complete(unsigned* bar, unsigned x, unsigned& nloc, unsigned& nx) {
    const unsigned G = gridDim.x * gridDim.y * gridDim.z;
    unsigned sum, cnt, mine, sp = 0u;
    for (;;) {
        sum = 0u; cnt = 0u; mine = 0u;
#pragma unroll
        for (unsigned j = 0; j < 16; ++j) { const unsigned c = xb_ld(&bar[XB_XCNT(j)]); sum += c; cnt += (c > 0u) ? 1u : 0u; mine = (j == x) ? c : mine; }
        if (sum == G) break;
        __builtin_amdgcn_s_sleep(1);
        if ((++sp & 255u) == 0u) { if (xb_ld(&bar[XB_TMO])) break; if (sp > XB_SPIN_CAP) { atomicAdd(&bar[XB_TMO], 1u); break; } }
    }
    nloc = mine > 0u ? mine : 1u; nx = cnt > 0u ? cnt : 1u;
}
__device__ __forceinline__ void xcd_barrier(const XcdBarrier& b) {
    asm volatile("s_waitcnt vmcnt(0)" ::: "memory");
    __syncthreads();
    if (b.lead) {
        unsigned* bar = b.bar;
        __builtin_amdgcn_s_waitcnt(0);
        unsigned nloc = b.st[0], nx = b.st[1];
        if (nloc == 0u) { xcd_barrier_complete(bar, b.x, nloc, nx); b.st[0] = nloc; b.st[1] = nx; }
        const unsigned old = xb_add(&bar[XB_XSUB(b.x)], 1u);
        const unsigned gen = old / nloc;
        if (old + 1u == (gen + 1u) * nloc) {
            __builtin_amdgcn_fence(__ATOMIC_RELEASE, "agent");
            asm volatile("s_waitcnt vmcnt(0)" ::: "memory");
            const unsigned og = xb_add(&bar[XB_TOP], 1u);
            const unsigned tg = og / nx;
            if (og + 1u == (tg + 1u) * nx) xb_add(&bar[XB_TOPGEN], 1u);
            else XB_SPIN(xb_ld(&bar[XB_TOPGEN]) == tg, bar);
            __builtin_amdgcn_fence(__ATOMIC_ACQUIRE, "agent");
            xb_add(&bar[XB_XGEN(b.x)], 1u);
            asm volatile("s_waitcnt vmcnt(0)" ::: "memory");
        } else {
            XB_SPIN(xb_ld(&bar[XB_XGEN(b.x)]) == gen, bar);
            __builtin_amdgcn_fence(__ATOMIC_ACQUIRE, "agent");
            asm volatile("s_waitcnt vmcnt(0)" ::: "memory");
        }
    }
    __syncthreads();
}

struct KArgs { const float* in[27]; float* out; unsigned char* ws; int ph_lo, ph_hi; };
struct Args { const float* const (&in)[27]; float* out; unsigned char* ws; int wv; };
__device__ __forceinline__ int tidx_(int wv) { unsigned z; asm volatile("s_mov_b32 %0, 0" : "=s"(z)); return wv * 64 + (int)__builtin_amdgcn_mbcnt_hi(~0u, __builtin_amdgcn_mbcnt_lo(~0u, z)); }

struct TrDesc { const float* W; bf16* WT; int ldw, K, nblk, item, mode, f8; };
__device__ __forceinline__ void tr_load(const TrDesc& d, f32x4 (&t)[8], int lane) {
    const int kb = d.item / d.nblk, nb = d.item % d.nblk, k0 = 64 * kb, n0 = 32 * nb;
#pragma unroll
    for (int i = 0; i < 8; ++i) t[i] = *(const f32x4*)(d.W + (size_t)(k0 + 8 * i + (lane >> 3)) * d.ldw + n0 + 4 * (lane & 7));
}
__device__ __forceinline__ void tr_store(const TrDesc& d, const f32x4 (&t)[8], LAS float* scr, int lane) {
    const int kb = d.item / d.nblk, nb = d.item % d.nblk, k0 = 64 * kb, n0 = 32 * nb;
#pragma unroll
    for (int i = 0; i < 8; ++i) { LAS float* p = scr + (8 * i + (lane >> 3)) * 33 + 4 * (lane & 7); p[0] = t[i].x; p[1] = t[i].y; p[2] = t[i].z; p[3] = t[i].w; }
    asm volatile("s_waitcnt lgkmcnt(0)" ::: "memory");
    const int c = lane & 7;
#pragma unroll
    for (int j = 0; j < 4; ++j) { const int n = (lane >> 3) + 8 * j; const LAS float* s = scr + (8 * c) * 33 + n;
        u32x4 o; o.x = pk2(s[0 * 33], s[1 * 33]); o.y = pk2(s[2 * 33], s[3 * 33]); o.z = pk2(s[4 * 33], s[5 * 33]); o.w = pk2(s[6 * 33], s[7 * 33]);
        const int nn = n0 + n, row = d.mode == 0 ? nn : (nn >> 7) * 256 + (d.mode - 1) * 128 + (nn & 127);
        if (d.f8) {
            int w0 = __builtin_amdgcn_cvt_pk_fp8_f32(64.f * s[0 * 33], 64.f * s[1 * 33], 0, false); w0 = __builtin_amdgcn_cvt_pk_fp8_f32(64.f * s[2 * 33], 64.f * s[3 * 33], w0, true);
            int w1 = __builtin_amdgcn_cvt_pk_fp8_f32(64.f * s[4 * 33], 64.f * s[5 * 33], 0, false); w1 = __builtin_amdgcn_cvt_pk_fp8_f32(64.f * s[6 * 33], 64.f * s[7 * 33], w1, true);
            *(u32x2*)((unsigned char*)d.WT + (size_t)row * d.K + k0 + 8 * c) = (u32x2){(unsigned)w0, (unsigned)w1}; }
        else *(u32x4*)(d.WT + (size_t)row * d.K + k0 + 8 * c) = o; }
    asm volatile("s_waitcnt lgkmcnt(0)" ::: "memory");
}
__device__ __forceinline__ int win_src_off(int g) {
    switch (g) { case 0: return 0; case 1: return 1024; case 2: return 2048; case 3: return 4096; case 4: return 5120; case 5: return 7176; case 6: return 8200; case 7: return 3072; default: return 6144; }
}

__device__ __forceinline__ void p0_prologue(const Args& a, LAS unsigned char* lds) {
    const int tid = threadIdx.x, lane = tid & 63, wave = tid >> 6;
    unsigned char* ws = a.ws;
    const int gw = blockIdx.x * 8 + wave, NGW = gridDim.x * 8;
    {
        LAS float* scr = (LAS float*)(lds + 32768 + wave * 8704);
        constexpr int NA = 12 * 512, NBt = 130 * 128, NC = 65 * 128, NTOT = NA + NBt + NC;
        auto decode = [&](int it) -> TrDesc { TrDesc d; d.f8 = 0;
            if (it < NA) { const int job = it / 512; d.item = it % 512; d.ldw = job < 9 ? INW : 1024; d.K = 1024; d.nblk = 32; d.mode = 0;
                if (job < 9) { d.W = a.in[4] + win_src_off(job); d.WT = (bf16*)(ws + WS_WINT) + (size_t)job * 1024 * 1024; }
                else { d.W = a.in[12 + (job - 9)]; d.WT = (bf16*)(ws + (job == 9 ? WS_WAT : job == 10 ? WS_WBT : WS_WOT)); } }
            else if (it < NA + NBt) { const int r = it - NA, job = r / 128; d.item = r % 128; d.ldw = 256; d.K = 1024; d.nblk = 8;
                d.f8 = 1;
                if (job < 128) { const int e = job & 63, up = job >> 6; d.mode = 1 + up; d.W = a.in[19 + up] + (size_t)e * 1024 * 256; d.WT = (bf16*)(ws + WS_WGU + (size_t)e * 512 * 1024); }
                else { const int up = job - 128; d.mode = 1 + up; d.W = a.in[22 + up]; d.WT = (bf16*)(ws + WS_WSGU); } }
            else { const int r = it - NA - NBt, job = r / 128; d.item = r % 128; d.ldw = 1024; d.K = 256; d.nblk = 32; d.mode = 0; d.f8 = 1;
                if (job < 64) { d.W = a.in[21] + (size_t)job * 256 * 1024; d.WT = (bf16*)(ws + WS_WD + (size_t)job * 1024 * 256); }
                else { d.W = a.in[24]; d.WT = (bf16*)(ws + WS_WSD); } }
            return d; };
        if (gw < NTOT) {
            TrDesc d0 = decode(gw); f32x4 t0[8]; tr_load(d0, t0, lane);
            for (int it = gw; it < NTOT; it += NGW) {
                TrDesc d1 = d0; f32x4 t1[8]; const bool more = it + NGW < NTOT;
                if (more) { d1 = decode(it + NGW); tr_load(d1, t1, lane); }
                tr_store(d0, t0, scr, lane);
                if (more) { d0 = d1;
#pragma unroll
                    for (int i = 0; i < 8; ++i) t0[i] = t1[i]; }
            }
        }
    }
    __syncthreads();
    LAS float* Wg8 = (LAS float*)lds;
    for (int i = tid; i < 1024 * 8; i += 512) Wg8[i] = a.in[4][(size_t)(i >> 3) * INW + 7168 + (i & 7)];
    __syncthreads();
    {
        const float* x = a.in[0]; const f32x4* gp = (const f32x4*)a.in[2] + lane; const f32x4* bp = (const f32x4*)a.in[3] + lane;
        f32x4 g[4], b[4];
#pragma unroll
        for (int j = 0; j < 4; ++j) { g[j] = gp[64 * j]; b[j] = bp[64 * j]; }
        bf16* h0 = (bf16*)(ws + WS_H0); float* lnst = (float*)(ws + WS_LNST0); float* igfg = (float*)(ws + WS_IGFG);
        f32x4 vn[4];
        if (gw < T) { const f32x4* xr = (const f32x4*)(x + (size_t)gw * D) + lane;
#pragma unroll
            for (int j = 0; j < 4; ++j) vn[j] = xr[64 * j]; }
        for (int m = gw; m < T; m += NGW) {
            f32x4 v[4]; float s = 0.f;
#pragma unroll
            for (int j = 0; j < 4; ++j) { v[j] = vn[j]; s += (v[j].x + v[j].y) + (v[j].z + v[j].w); }
            if (m + NGW < T) { const f32x4* xr = (const f32x4*)(x + (size_t)(m + NGW) * D) + lane;
#pragma unroll
                for (int j = 0; j < 4; ++j) vn[j] = xr[64 * j]; }
            const float mean = wave_sum(s) * (1.f / D); float s2 = 0.f;
#pragma unroll
            for (int j = 0; j < 4; ++j) { v[j] = v[j] - mean; s2 += (v[j].x * v[j].x + v[j].y * v[j].y) + (v[j].z * v[j].z + v[j].w * v[j].w); }
            const float rstd = 1.f / sqrtf(wave_sum(s2) * (1.f / D) + EPS);
            float acc[8];
#pragma unroll
            for (int c = 0; c < 8; ++c) acc[c] = 0.f;
            unsigned long long* o8 = (unsigned long long*)(h0 + (size_t)m * D) + lane;
#pragma unroll
            for (int j = 0; j < 4; ++j) {
                f32x4 h = v[j] * rstd * g[j] + b[j];
                o8[64 * j] = (unsigned long long)pk2(h.x, h.y) | ((unsigned long long)pk2(h.z, h.w) << 32);
#pragma unroll
                for (int i = 0; i < 4; ++i) { const int k = 4 * lane + i + 256 * j; const f32x4 w0 = *(const LAS f32x4*)(Wg8 + k * 8), w1 = *(const LAS f32x4*)(Wg8 + k * 8 + 4);
                    const float hv = h[i];
                    acc[0] += hv * w0.x; acc[1] += hv * w0.y; acc[2] += hv * w0.z; acc[3] += hv * w0.w; acc[4] += hv * w1.x; acc[5] += hv * w1.y; acc[6] += hv * w1.z; acc[7] += hv * w1.w; }
            }
            float r4[4], r2[2], r1;
            { const bool up = lane & 1;
#pragma unroll
              for (int c = 0; c < 4; ++c) { const float send = up ? acc[c] : acc[4 + c], keep = up ? acc[4 + c] : acc[c]; r4[c] = keep + __shfl_xor(send, 1); } }
            { const bool up = lane & 2;
#pragma unroll
              for (int c = 0; c < 2; ++c) { const float send = up ? r4[c] : r4[2 + c], keep = up ? r4[2 + c] : r4[c]; r2[c] = keep + __shfl_xor(send, 2); } }
            { const bool up = lane & 4; const float send = up ? r2[0] : r2[1], keep = up ? r2[1] : r2[0]; r1 = keep + __shfl_xor(send, 4); }
            r1 += __shfl_xor(r1, 8); r1 += __shfl_xor(r1, 16); r1 += __shfl_xor(r1, 32);
            if (lane < 8) igfg[(size_t)m * 8 + 4 * (lane & 1) + 2 * ((lane >> 1) & 1) + ((lane >> 2) & 1)] = r1;
            if (lane == 0) { lnst[2 * m] = mean; lnst[2 * m + 1] = rstd; }
        }
    }
    __syncthreads();
    for (int cgp = blockIdx.x; cgp < 81; cgp += gridDim.x) {
        LAS float* hm = (LAS float*)(lds + 32768);
        LAS float* part = (LAS float*)(lds + 32768 + 65536);
        __syncthreads();
        for (int r = wave * 2; r < wave * 2 + 2; ++r) {
            const f32x4* xr = (const f32x4*)(a.in[1] + (size_t)r * D) + lane; const f32x4* gp = (const f32x4*)a.in[2] + lane; const f32x4* bp = (const f32x4*)a.in[3] + lane;
            f32x4 v[4]; float s = 0.f;
#pragma unroll
            for (int j = 0; j < 4; ++j) { v[j] = xr[64 * j]; s += (v[j].x + v[j].y) + (v[j].z + v[j].w); }
            const float mean = wave_sum(s) * (1.f / D); float s2 = 0.f;
#pragma unroll
            for (int j = 0; j < 4; ++j) { v[j] = v[j] - mean; s2 += (v[j].x * v[j].x + v[j].y * v[j].y) + (v[j].z * v[j].z + v[j].w * v[j].w); }
            const float rstd = 1.f / sqrtf(wave_sum(s2) * (1.f / D) + EPS);
#pragma unroll
            for (int j = 0; j < 4; ++j) { const f32x4 h = v[j] * rstd * gp[64 * j] + bp[64 * j]; *(LAS f32x4*)(hm + r * 1024 + 4 * (lane + 64 * j)) = h; }
        }
        __syncthreads();
        const int c = cgp * 64 + lane;
        const int cc = c < 5128 ? c : 5127, g = cc >> 10, srccol = (cc < 5120) ? win_src_off(g) + (cc & 1023) : 7168 + (cc - 5120);
        float acc[16];
#pragma unroll
        for (int r = 0; r < 16; ++r) acc[r] = 0.f;
        const float* wp = a.in[4] + (size_t)(wave * 128) * INW + srccol;
#pragma unroll 4
        for (int k = 0; k < 128; ++k) { const float w = wp[(size_t)k * INW];
#pragma unroll
            for (int r = 0; r < 16; ++r) acc[r] += hm[r * 1024 + wave * 128 + k] * w; }
#pragma unroll
        for (int r = 0; r < 16; ++r) part[(wave * 16 + r) * 64 + lane] = acc[r];
        __syncthreads();
        if (c < 5128) {
            float* meta = (float*)(ws + WS_META);
            for (int r = wave * 2; r < wave * 2 + 2; ++r) { float v = 0.f;
#pragma unroll
                for (int w8 = 0; w8 < 8; ++w8) v += part[(w8 * 16 + r) * 64 + lane];
                if (c < 5120) { const int c1 = c & 1023;
                    if (g == 1) { const float lb = 1.0f / (1.0f + expf(a.in[5][1024 + c1] - a.in[5][c1])); v = logf(lb + (1.0f - lb) * sigmoidf_(v)); }
                    meta[(size_t)g * 16384 + r * 1024 + c1] = v; }
                else meta[5 * 16384 + r * 8 + (c - 5120)] = v; }
        }
    }
    for (int it = blockIdx.x * 512 + tid; it < 64 * 128; it += gridDim.x * 512) { const int e = it >> 7, k0 = (it & 127) * 8; float hi[8], lo[8];
#pragma unroll
        for (int j = 0; j < 8; ++j) { const float wv = a.in[17][(size_t)(k0 + j) * 64 + e]; const float h = bf2f(f2bf(wv)); hi[j] = h; lo[j] = wv - h; }
        store8_bf16((bf16*)(ws + WS_WRT) + (size_t)e * 1024 + k0, hi); store8_bf16((bf16*)(ws + WS_WRT) + 65536 + (size_t)e * 1024 + k0, lo); }
    {
        int* ts = (int*)(ws + WS_TOKSLOT); float* wsl = (float*)(ws + WS_WSLOT);
        for (int i = blockIdx.x * 512 + tid; i < 2 * NSLOTMAX; i += gridDim.x * 512) { ts[i] = 0; wsl[i] = 0.f; }
        int* ident = (int*)(ws + WS_IDENT);
        for (int i = blockIdx.x * 512 + tid; i < T; i += gridDim.x * 512) ident[i] = i;
    }
}

__device__ __forceinline__ void store8_bf16(bf16* p, const float (&v)[8]) { u32x4 w; w.x = pk2(v[0], v[1]); w.y = pk2(v[2], v[3]); w.z = pk2(v[4], v[5]); w.w = pk2(v[6], v[7]); *(u32x4*)p = w; }
__device__ __forceinline__ void load8_bf16(const bf16* p, float (&v)[8]) { const u32x4 w = *(const u32x4*)p;
    v[0] = bf2f(w.x & 0xffffu); v[1] = bf2f(w.x >> 16); v[2] = bf2f(w.y & 0xffffu); v[3] = bf2f(w.y >> 16); v[4] = bf2f(w.z & 0xffffu); v[5] = bf2f(w.z >> 16); v[6] = bf2f(w.w & 0xffffu); v[7] = bf2f(w.w >> 16); }

struct NoData {};
template <int K> struct KindTag { static constexpr int value = K; };
template <class T, class = void> struct epigroup { static constexpr int value = 4; };
template <class T> struct epigroup<T, typename std::enable_if<(T::GROUP > 0)>::type> { static constexpr int value = T::GROUP; };
template <class T, class = void> struct rowld : std::false_type {};
template <class T> struct rowld<T, typename std::enable_if<T::ROWLD>::type> : std::true_type {};
template <class T, class = void> struct statld : std::false_type {};
template <class T> struct statld<T, typename std::enable_if<T::STATLD>::type> : std::true_type {};
template <class T, class = void> struct pairbj : std::false_type {};
template <class T> struct pairbj<T, typename std::enable_if<T::PAIRBJ>::type> : std::true_type {};
__device__ __forceinline__ void unpack8(const u32x4 w, float (&v)[8]) { v[0] = bf2f(w.x & 0xffffu); v[1] = bf2f(w.x >> 16); v[2] = bf2f(w.y & 0xffffu); v[3] = bf2f(w.y >> 16); v[4] = bf2f(w.z & 0xffffu); v[5] = bf2f(w.z >> 16); v[6] = bf2f(w.w & 0xffffu); v[7] = bf2f(w.w >> 16); }
struct EpiA {
    static constexpr bool PIPE = false; static constexpr int NKIND = 4;
    unsigned char* ws; unsigned char* dout; const float* lbl;
    struct Cl { float lb[8]; bf16* base; }; typedef NoData Ld;
    __device__ __forceinline__ int kind(int col0) const { const int g = col0 >> 10; return g == 1 ? 1 : g >= 5 ? 2 : g == 3 ? 3 : 0; }
    template <int K> __device__ __forceinline__ void colload(int col0, Cl& cl) const { const int g = col0 >> 10, c = col0 & 1023;
        if (K == 1) {
#pragma unroll
            for (int j = 0; j < 8; ++j) cl.lb[j] = __builtin_amdgcn_rcpf(1.0f + __expf(lbl[1024 + c + j] - lbl[c + j]));
            cl.base = (bf16*)(ws + WS_LFA) + c; }
        else if (K == 2) cl.base = (bf16*)dout + (size_t)(g - 5) * T * D + c;
        else if (K == 3) cl.base = (bf16*)(ws + WS_QKB) + c;
        else cl.base = (bf16*)(ws + (g == 0 ? WS_QA : g == 2 ? WS_IA : WS_VB)) + c; }
    template <int K> __device__ __forceinline__ void load(int, int, Ld&) const {}
    template <int K> __device__ __forceinline__ void apply(int row, int col0, int m, const float (&v)[8], const Ld&, const Cl& cl) const {
        if (K == 1) { float o[8];
#pragma unroll
            for (int j = 0; j < 8; ++j) o[j] = __logf(cl.lb[j] + (1.0f - cl.lb[j]) * sigmoidf_(v[j]));
            u32x4 w; w.x = f2h(o[0]) | (f2h(o[1]) << 16); w.y = f2h(o[2]) | (f2h(o[3]) << 16); w.z = f2h(o[4]) | (f2h(o[5]) << 16); w.w = f2h(o[6]) | (f2h(o[7]) << 16);
            *(u32x4*)(cl.base + (size_t)row * D) = w; }
        else if (K == 2) { float o[8];
#pragma unroll
            for (int j = 0; j < 8; ++j) o[j] = sigmoidf_(v[j]);
            store8_bf16(cl.base + (size_t)row * D, o); }
        else { store8_bf16(cl.base + (size_t)row * D, v);
            if (K == 3 && m == 3) { if ((row & 63) >= 61) store8_bf16((bf16*)(ws + WS_HALO) + ((size_t)(row >> 6) * 3 + ((row & 63) - 61)) * D + (col0 & 1023), v); } }
    }
};
struct EpiB {
    static constexpr bool PIPE = false; static constexpr int NKIND = 2; static constexpr bool STATLD = true;
    unsigned char* ws; const float* hg_g; const float* ml_g;
    struct Cl { float gn[8]; }; struct Ld { u32x4 x; }; struct Rs { float mean, rstd; };
    __device__ __forceinline__ int kind(int col0) const { return col0 >> 10; }
    template <int K> static constexpr bool stat_per_half() { return K == 0; }
    template <int K> __device__ __forceinline__ void colload(int col0, Cl& cl) const { const int c = col0 & 1023; const float* gp = (K == 0 ? hg_g : ml_g) + c;
#pragma unroll
        for (int j = 0; j < 8; ++j) cl.gn[j] = gp[j]; }
    template <int K> __device__ __forceinline__ void rowstat(int row, int col0, Rs& rs) const { const int c = col0 & 1023;
        if (K == 0) { rs.mean = 0.f; const f32x2_t p = *(const f32x2_t*)((const float*)(ws + WS_STA2) + (size_t)row * 16 + (c >> 7) * 2); rs.rstd = __builtin_amdgcn_rsqf((p.x + p.y) * (1.f / 128.f) + EPS); }
        else { const f32x4* st = (const f32x4*)((const float*)(ws + WS_STB2) + ((size_t)row * 16 + (c >> 8) * 4) * 2);
            const f32x4 a0 = st[0], a1 = st[1]; const float s1 = (a0.x + a0.z) + (a1.x + a1.z), s2 = (a0.y + a0.w) + (a1.y + a1.w);
            rs.mean = s1 * (1.f / 256.f); rs.rstd = __builtin_amdgcn_rsqf(fmaxf(s2 * (1.f / 256.f) - rs.mean * rs.mean, 0.f) + EPS); } }
    template <int K> __device__ __forceinline__ void load(int row, int col0, Ld& ld) const { const int c = col0 & 1023;
        ld.x = *(const u32x4*)((const bf16*)(ws + (K == 0 ? WS_IA : WS_VB)) + (size_t)row * D + c); }
    template <int K> __device__ __forceinline__ void apply(int row, int col0, const float (&v)[8], const Ld& ld, const Rs& rs, const Cl& cl) const {
        const int c = col0 & 1023; float x[8], o[8]; unpack8(ld.x, x);
        if (K == 0) {
#pragma unroll
            for (int j = 0; j < 8; ++j) o[j] = x[j] * rs.rstd * cl.gn[j] * siluf_(v[j]);
            store8_bf16((bf16*)(ws + WS_LFA) + (size_t)row * D + c, o);
        } else {
#pragma unroll
            for (int j = 0; j < 8; ++j) o[j] = (x[j] - rs.mean) * rs.rstd * cl.gn[j] * sigmoidf_(v[j]);
            store8_bf16((bf16*)(ws + WS_QKB) + (size_t)row * D + c, o);
        }
    }
};
struct EpiC {
    static constexpr bool PIPE = true; static constexpr int NKIND = 1;
    unsigned char* ws; const bf16* sga; const bf16* sgb;
    typedef NoData Cl; struct Ld { u32x4 a, b; };
    __device__ __forceinline__ int kind(int) const { return 0; }
    template <int K> __device__ __forceinline__ void colload(int, Cl&) const {}
    __device__ __forceinline__ void midload(int row, int col0, Ld& ld) const { ld.a = *(const u32x4*)(sga + (size_t)row * D + col0); ld.b = *(const u32x4*)(sgb + (size_t)row * D + col0); }
    __device__ __forceinline__ void mid(float (&v)[8], const Ld& ld) const { float sa[8], sb[8]; unpack8(ld.a, sa); unpack8(ld.b, sb);
#pragma unroll
        for (int j = 0; j < 8; ++j) v[j] *= sa[j] * __builtin_amdgcn_rcpf(sb[j]); }
    template <int K> __device__ __forceinline__ void load(int row, int col0, Ld& ld) const { ld.b = *(const u32x4*)(sgb + (size_t)row * D + col0); }
    template <int K> __device__ __forceinline__ void apply(int row, int col0, int, const float (&v)[8], const Ld& ld, const Cl&) const { float sb[8], o[8]; unpack8(ld.b, sb);
#pragma unroll
        for (int j = 0; j < 8; ++j) o[j] = sb[j] * v[j];
        store8_bf16((bf16*)(ws + WS_IA) + (size_t)row * D + col0, o); }
};
struct EpiD {
    static constexpr bool PIPE = true; static constexpr int NKIND = 1;
    unsigned char* ws;
    typedef NoData Cl; struct Ld { u32x4 h; };
    __device__ __forceinline__ int kind(int) const { return 0; }
    template <int K> __device__ __forceinline__ void colload(int, Cl&) const {}
    template <int K> __device__ __forceinline__ void load(int row, int col0, Ld& ld) const { ld.h = *(const u32x4*)((const bf16*)(ws + WS_H0) + (size_t)row * D + col0); }
    template <int K> __device__ __forceinline__ void apply(int row, int col0, int, const float (&v)[8], const Ld& ld, const Cl&) const { float h[8], o[8]; unpack8(ld.h, h);
#pragma unroll
        for (int j = 0; j < 8; ++j) o[j] = DN_ALPHA * h[j] + v[j];
        store8_bf16((bf16*)(ws + WS_Z) + (size_t)row * D + col0, o); }
};
struct EpiGU {
    static constexpr bool PIPE = false; static constexpr int NKIND = 1; static constexpr bool PAIRBJ = true;
    unsigned char* H;
    typedef NoData Cl; typedef NoData Ld;
    __device__ __forceinline__ int kind(int) const { return 0; }
    __device__ __forceinline__ void apply_pair(int row, int col0, const float (&g)[8], const float (&u)[8]) const {
        float o[8];
#pragma unroll
        for (int j = 0; j < 8; ++j) {
            const float e = __builtin_amdgcn_exp2f(g[j] * (-1.4426950408889634f / 256.f));
            o[j] = __builtin_amdgcn_fmed3f(g[j] * u[j] * __builtin_amdgcn_rcpf(__builtin_fmaf(e, 65536.f, 65536.f)), -448.f, 448.f); }
        int w0 = __builtin_amdgcn_cvt_pk_fp8_f32(o[0], o[1], 0, false); w0 = __builtin_amdgcn_cvt_pk_fp8_f32(o[2], o[3], w0, true);
        int w1 = __builtin_amdgcn_cvt_pk_fp8_f32(o[4], o[5], 0, false); w1 = __builtin_amdgcn_cvt_pk_fp8_f32(o[6], o[7], w1, true);
        *(u32x2*)(H + (size_t)row * DEXP + (col0 >> 8) * 128 + (col0 & 127)) = (u32x2){(unsigned)w0, (unsigned)w1}; }
};
struct EpiDown {
    static constexpr bool PIPE = false; static constexpr int NKIND = 1; static constexpr bool ROWLD = true;
    unsigned char* Y; const float* w;
    typedef NoData Cl; struct Ld { float s; };
    __device__ __forceinline__ int kind(int) const { return 0; }
    template <int K> __device__ __forceinline__ void colload(int, Cl&) const {}
    template <int K> __device__ __forceinline__ void load(int row, int, Ld& ld) const { ld.s = w[row]; }
    typedef u32x2 Pk;
    template <int K> __device__ __forceinline__ Pk pack(const float (&v)[8], const Ld& ld) const { float o[8]; const float s = ld.s * 0.125f;
#pragma unroll
        for (int j = 0; j < 8; ++j) o[j] = __builtin_amdgcn_fmed3f(s * v[j], -448.f, 448.f);
        int w0 = __builtin_amdgcn_cvt_pk_fp8_f32(o[0], o[1], 0, false); w0 = __builtin_amdgcn_cvt_pk_fp8_f32(o[2], o[3], w0, true);
        int w1 = __builtin_amdgcn_cvt_pk_fp8_f32(o[4], o[5], 0, false); w1 = __builtin_amdgcn_cvt_pk_fp8_f32(o[6], o[7], w1, true);
        return (u32x2){(unsigned)w0, (unsigned)w1}; }
    template <int K> __device__ __forceinline__ void put(int row, int col0, const Pk w) const { *(u32x2*)(Y + (size_t)row * D + col0) = w; }
    template <int K> __device__ __forceinline__ void apply(int row, int col0, int, const float (&v)[8], const Ld& ld, const Cl&) const { put<K>(row, col0, pack<K>(v, ld)); }
};
struct EpiSD2 {
    static constexpr bool PIPE = false; static constexpr int NKIND = 1;
    unsigned char* ws; int tokbase;
    typedef NoData Cl; typedef NoData Ld;
    __device__ __forceinline__ int kind(int) const { return 0; }
    template <int K> __device__ __forceinline__ void colload(int, Cl&) const {}
    template <int K> __device__ __forceinline__ void load(int, int, Ld&) const {}
    typedef u32x4 Pk;
    template <int K> __device__ __forceinline__ Pk pack(const float (&v)[8], const Ld&) const { u32x4 w;
        w.x = pk2(v[0] * 0.00390625f, v[1] * 0.00390625f); w.y = pk2(v[2] * 0.00390625f, v[3] * 0.00390625f); w.z = pk2(v[4] * 0.00390625f, v[5] * 0.00390625f); w.w = pk2(v[6] * 0.00390625f, v[7] * 0.00390625f); return w; }
    template <int K> __device__ __forceinline__ void put(int row, int col0, const Pk w) const { *(u32x4*)((bf16*)(ws + WS_H0) + (size_t)(tokbase + row - NSLOTMAX) * D + col0) = w; }
    template <int K> __device__ __forceinline__ void apply(int row, int col0, int, const float (&v)[8], const Ld& ld, const Cl&) const { put<K>(row, col0, pack<K>(v, ld)); }
};

namespace pg8 {
typedef short bf16x8 __attribute__((ext_vector_type(8)));
constexpr int BM = 256, BK = 64, HALF = 128, HTB = HALF * BK * 2, STAGE_BYTES = 8 * HTB, NXCD = 8, WGM = 8;
__device__ __forceinline__ int lds_byte(int r, int c) { const int st = (r >> 4) * 2 + (c >> 5), rr = r & 15, cc = c & 31, ob = rr * 64 + cc * 2; return st * 1024 + (ob ^ (((ob >> 9) & 1) << 5)); }
__device__ __forceinline__ void stage_rc(int b, int& R, int& C) { const int st = b / 1024, sb = b % 1024, swz = sb ^ (((sb >> 9) & 1) << 5); R = (st >> 1) * 16 + swz / 64; C = (st & 1) * 32 + (swz % 64) / 2; }
__device__ __forceinline__ int perm32(int rho) { const int n = rho >> 4, i = rho & 15; return 8 * (i >> 2) + 4 * n + (i & 3); }
typedef int v8i32_t __attribute__((ext_vector_type(8)));
typedef int v4i32_t __attribute__((ext_vector_type(4)));
__device__ __forceinline__ v8i32_t cat88(bf16x8 a, bf16x8 b) { const u32x4 x = __builtin_bit_cast(u32x4, a), y = __builtin_bit_cast(u32x4, b); return (v8i32_t){(int)x.x, (int)x.y, (int)x.z, (int)x.w, (int)y.x, (int)y.y, (int)y.z, (int)y.w}; }
struct Unit { int row0, col0; const char* A; const char* B; const int* idx; int mode; };
__device__ __forceinline__ int xcd_remap(int L, int nwg) { const int q = nwg / NXCD, r = nwg % NXCD, xcd = L % NXCD, off = L / NXCD; return (xcd < r ? xcd * (q + 1) : r * (q + 1) + (xcd - r) * q) + off; }
struct DenseOrder {
    int nM, nN, nwg, G, c, K; const char* A; const char* Bt;
    __device__ __forceinline__ void init(const bf16* A_, const bf16* Bt_, int M, int N, int K_) { A = (const char*)A_; Bt = (const char*)Bt_; K = K_; nM = M / BM; nN = N / BM; nwg = nM * nN; G = gridDim.x; c = blockIdx.x; }
    __device__ __forceinline__ bool next(int i, Unit& u) const {
        const long L = (long)i * G + c; if (L >= nwg) return false;
        const int wgid = xcd_remap((int)L, nwg);
        const int nig = WGM * nN, gid = wgid / nig, fm = gid * WGM, gsz = (nM - fm) < WGM ? (nM - fm) : WGM;
        const int pm = fm + ((wgid % nig) % gsz), pn = (wgid % nig) / gsz;
        u.row0 = pm * BM; u.col0 = pn * BM; u.A = A + (size_t)pm * BM * K * 2; u.B = Bt + (size_t)pn * BM * K * 2; u.idx = nullptr; u.mode = 0; return true;
    }
};
struct PairedOrder {
    DenseOrder d; const char* A2; const char* B2;
    __device__ __forceinline__ bool next(int i, Unit& u) const {
        if (!d.next(i >> 1, u)) return false;
        if (i & 1) { u.A = A2 + (size_t)u.row0 * d.K * 2; u.B = B2 + (size_t)u.col0 * d.K * 2; u.mode = 2; } else u.mode = 1;
        return true;
    }
};
struct GroupedOrder {
    const LAS int* te; int nct, nrt, nwg1, nwg2, G, c, K; const char* A; const int* idx; const int* ident; const char* Bt; const char* Bsh; size_t estride; bool gather;
    __device__ __forceinline__ bool next(int i, Unit& u) const {
        const int n1 = c < nwg1 ? (nwg1 - c + G - 1) / G : 0;
        if (i < n1) { const int wgid = xcd_remap(i * G + c, nwg1), rt = wgid / nct, ct = wgid % nct, row0 = rt * BM; const int e = __builtin_amdgcn_readfirstlane(te[rt]); u.mode = 0; u.col0 = ct * BM;
            u.row0 = row0; u.A = gather ? A : A + (size_t)row0 * K * 2; u.idx = idx + row0; u.B = Bt + (size_t)e * estride + (size_t)ct * BM * K * 2; return true; }
        const int L2 = (i - n1) * G + c; if (L2 >= nwg2) return false;
        const int wgid = xcd_remap(L2, nwg2), rt = wgid / nct, ct = wgid % nct, row0 = NSLOTMAX + rt * BM; u.mode = 3; u.col0 = ct * BM;
        u.row0 = row0; u.A = gather ? A : A + (size_t)row0 * K * 2; u.idx = ident + rt * BM; u.B = Bsh + (size_t)ct * BM * K * 2; return true;
    }
};

template <bool GATHER, bool PAIRED, bool FP8, bool NT2 = false, class Epi, class Sched, class Epi2>
__device__ __forceinline__ void gemm_phase2(LAS unsigned char* lds, const int wv, const int K, const Sched& S, const Epi& E, const Epi2& E2) {
    int tid = tidx_(wv); asm volatile("" : "+v"(tid));
    const int wid = __builtin_amdgcn_readfirstlane(tid >> 6), lane = tid & 63, wr = wid >> 2, wc = wid & 3, fr = lane & 15, fq = lane >> 4;
    const int nt = K / BK;
    unsigned voffA, voffB;
    { int R, C; stage_rc(tid * 16, R, C); const int Rb = (R & ~31) + perm32(R & 31); voffA = (unsigned)(R * K + C) * 2u; voffB = (unsigned)(Rb * K + C) * 2u; }
    const size_t pstep = (size_t)64 * K * 2;
    const size_t kstep = (size_t)(BK * 2);
    const size_t hstep = (size_t)HALF * K * 2;
    const unsigned ldsw = (unsigned)wid * 1024u;
    const int aoffk[2] = { FP8 ? lds_byte(wr * 64 + fr, fq * 16) : lds_byte(wr * 64 + fr, fq * 8), FP8 ? lds_byte(wr * 64 + fr, fq * 16 + 8) : lds_byte(wr * 64 + fr, fq * 8) + 1024 };
    const int boffk[2] = { FP8 ? lds_byte(wc * 32 + fr, fq * 16) : lds_byte(wc * 32 + fr, fq * 8), FP8 ? lds_byte(wc * 32 + fr, fq * 16 + 8) : lds_byte(wc * 32 + fr, fq * 8) + 1024 };
    LAS unsigned char* ldsB[2];
#pragma unroll
    for (int k = 0; k < 2; ++k) { ldsB[k] = lds + 65536 + boffk[k]; asm volatile("" : "+v"(ldsB[k])); }
    unsigned cvA[2][2];
#define PG8_SA(b, h) (((b) * 2 + (h)) * HTB)
#define PG8_SB(b, h) ((4 + (b) * 2 + (h)) * HTB)
#define PG8_STAGE(bufoff, gbase, voff) do { _Pragma("unroll") for (int _i = 0; _i < 2; ++_i) { const char* _b = (const char*)(gbase) + _i * pstep; asm volatile("" : "+s"(_b)); \
        __builtin_amdgcn_global_load_lds((const unsigned*)(_b + (voff)), (LAS unsigned*)(lds + (bufoff) + ldsw + _i * 8192), 16, 0, 0); } } while (0)
#define PG8_STAGE_G(bufoff, gbase, voff) do { const char* _b = (const char*)(gbase); asm volatile("" : "+s"(_b)); _Pragma("unroll") for (int _i = 0; _i < 2; ++_i) \
        __builtin_amdgcn_global_load_lds((const unsigned*)(_b + (voff)[_i]), (LAS unsigned*)(lds + (bufoff) + ldsw + _i * 8192), 16, 0, 0); } while (0)
#define PG8_STAGE_A(bufoff, kbase, h, usenext) do { if constexpr (GATHER) { PG8_STAGE_G(bufoff, kbase, cvA[h]); } \
        else { PG8_STAGE(bufoff, (kbase) + (h) * hstep, voffA); } } while (0)
#define PG8_LOADIDX(dst, un) do { _Pragma("unroll") for (int _i = 0; _i < 2; ++_i) { int _R, _C; stage_rc(tid * 16 + _i * 8192, _R, _C); _Pragma("unroll") for (int _h = 0; _h < 2; ++_h) \
        dst[_h][_i] = ((unsigned)(un).idx[_h * HALF + _R] * (unsigned)K + (unsigned)_C) * 2u; } } while (0)
#define PG8_LDA(dst, b, h) do { _Pragma("unroll") for (int m = 0; m < 4; ++m) { if constexpr (FP8) { dst##8[m].lo = *(const LAS v4i32_t*)(lds + PG8_SA(b, h) + aoffk[0] + m * 2048); dst##8[m].hi = *(const LAS v4i32_t*)(lds + PG8_SA(b, h) + aoffk[1] + m * 2048); } \
        else { _Pragma("unroll") for (int k = 0; k < 2; ++k) dst[m][k] = *(const LAS bf16x8*)(lds + PG8_SA(b, h) + aoffk[k] + m * 2048); } } } while (0)
#define PG8_LDB(dst, b, h) do { _Pragma("unroll") for (int n = 0; n < 2; ++n) { if constexpr (FP8) { dst##8[n].lo = *(const LAS v4i32_t*)(ldsB[0] + (PG8_SB(b, h) - 65536) + n * 2048); dst##8[n].hi = *(const LAS v4i32_t*)(ldsB[1] + (PG8_SB(b, h) - 65536) + n * 2048); } \
        else { _Pragma("unroll") for (int k = 0; k < 2; ++k) dst[n][k] = *(const LAS bf16x8*)(lds + PG8_SB(b, h) + boffk[k] + n * 2048); } } } while (0)
#define PG8_MMA(ai, bj, At, Bt) do { __builtin_amdgcn_s_setprio(1); _Pragma("unroll") for (int m = 0; m < 4; ++m) _Pragma("unroll") for (int n = 0; n < 2; ++n) { \
        if constexpr (FP8) acc[ai][bj][m][n] = __builtin_amdgcn_mfma_scale_f32_16x16x128_f8f6f4(Bt##8[n], At##8[m], acc[ai][bj][m][n], 0, 0, 2, 0x3F800000, 2, 0x3F800000);        \
        else { _Pragma("unroll") for (int k = 0; k < 2; ++k) acc[ai][bj][m][n] = __builtin_amdgcn_mfma_f32_16x16x32_bf16(Bt[n][k], At[m][k], acc[ai][bj][m][n], 0, 0, 0); } } \
        __builtin_amdgcn_s_setprio(0); \
        if (nt == 2) { _Pragma("unroll") for (int m = 0; m < 4; ++m) asm volatile("" : "+v"(acc[ai][bj][m][0]), "+v"(acc[ai][bj][m][1])); } } while (0)
#define PG8_WAIT_V(n) asm volatile("s_waitcnt vmcnt(" #n ")" ::: "memory")
#define PG8_WAIT_L(n) asm volatile("s_waitcnt lgkmcnt(" #n ")" ::: "memory")
#define PG8_BAR __builtin_amdgcn_s_barrier()
#define PG8_SCHED __builtin_amdgcn_sched_barrier(0)
    Unit cur, nxt; int ui = 0;
    if (!S.next(0, cur)) return;
    f32x4 acc[2][2][4][2];
#pragma unroll
    for (int a = 0; a < 2; ++a)
#pragma unroll
        for (int b = 0; b < 2; ++b)
#pragma unroll
            for (int m = 0; m < 4; ++m)
#pragma unroll
                for (int n = 0; n < 2; ++n) acc[a][b][m][n] = (f32x4){0.f, 0.f, 0.f, 0.f};
    bf16x8 At[4][2], B0[2][2], B1[2][2]; v8i32_t At8[4], B08[2], B18[2];
    const char* cA = cur.A; const char* cB = cur.B;
    if constexpr (GATHER) { PG8_LOADIDX(cvA, cur); }
    PG8_STAGE(PG8_SB(0, 0), cB, voffB); PG8_STAGE(PG8_SB(0, 1), cB + hstep, voffB); PG8_STAGE_A(PG8_SA(0, 0), cA, 0, false); PG8_STAGE_A(PG8_SA(0, 1), cA, 1, false);
    if (wr == 1) PG8_BAR;
    PG8_WAIT_V(2); PG8_BAR;
    PG8_STAGE(PG8_SB(1, 0), cB + kstep, voffB); PG8_STAGE_A(PG8_SA(1, 0), cA + kstep, 0, false); PG8_STAGE(PG8_SB(1, 1), cB + hstep + kstep, voffB);
    PG8_WAIT_V(6); PG8_BAR;
    if constexpr (NT2) { PG8_STAGE_A(PG8_SA(1, 1), cA + kstep, 1, false); PG8_WAIT_V(0); PG8_BAR; }
    for (;;) {
        const bool has_next = S.next(ui + 1, nxt);
        const char* nA = has_next ? nxt.A : cA; const char* nB = has_next ? nxt.B : cB;
        if constexpr (NT2) {
            PG8_LDB(B0, 0, 0); PG8_LDB(B1, 0, 1); PG8_SCHED; PG8_LDA(At, 0, 0);
            PG8_WAIT_L(0); PG8_BAR; PG8_MMA(0, 0, At, B0); PG8_MMA(0, 1, At, B1); PG8_BAR; PG8_SCHED;
            PG8_LDA(At, 0, 1); PG8_STAGE(PG8_SB(0, 0), nB, voffB); PG8_STAGE(PG8_SB(0, 1), nB + hstep, voffB); PG8_STAGE_A(PG8_SA(0, 0), nA, 0, true);
            PG8_WAIT_L(0); PG8_BAR; PG8_MMA(1, 0, At, B0); PG8_MMA(1, 1, At, B1); PG8_BAR; PG8_SCHED;
            PG8_LDB(B0, 1, 0); PG8_LDB(B1, 1, 1); PG8_SCHED; PG8_LDA(At, 1, 0); PG8_STAGE_A(PG8_SA(0, 1), nA, 1, true);
            PG8_WAIT_L(0); PG8_BAR; PG8_MMA(0, 0, At, B0); PG8_MMA(0, 1, At, B1); PG8_BAR; PG8_SCHED;
            PG8_LDA(At, 1, 1); PG8_STAGE(PG8_SB(1, 0), nB + kstep, voffB); PG8_STAGE(PG8_SB(1, 1), nB + hstep + kstep, voffB); PG8_STAGE_A(PG8_SA(1, 0), nA + kstep, 0, true);
            PG8_WAIT_L(0); PG8_BAR; PG8_MMA(1, 0, At, B0); PG8_MMA(1, 1, At, B1); PG8_BAR; PG8_SCHED;
            PG8_STAGE_A(PG8_SA(1, 1), nA + kstep, 1, true);
        } else
#pragma unroll 1
        for (int t = 0; t < nt; t += 2) {
            const bool last = (t == nt - 2);
            const char* a1 = cA + (size_t)(t + 1) * kstep;
            const char* a2 = last ? nA : cA + (size_t)(t + 2) * kstep; const char* b2 = last ? nB : cB + (size_t)(t + 2) * kstep;
            const char* a3 = a2 + kstep; const char* b3 = b2 + kstep;
            PG8_LDB(B0, 0, 0); PG8_LDB(B1, 0, 1); PG8_SCHED; PG8_LDA(At, 0, 0); PG8_STAGE_A(PG8_SA(1, 1), a1, 1, false);
            if constexpr (GATHER) { if (last && has_next) PG8_LOADIDX(cvA, nxt); }
            PG8_WAIT_V(8);
            PG8_WAIT_L(0); PG8_BAR; PG8_MMA(0, 0, At, B0); PG8_MMA(0, 1, At, B1); PG8_BAR; PG8_SCHED;
            PG8_LDA(At, 0, 1); PG8_STAGE(PG8_SB(0, 0), b2, voffB); PG8_STAGE(PG8_SB(0, 1), b2 + hstep, voffB); PG8_STAGE_A(PG8_SA(0, 0), a2, 0, last);
            PG8_WAIT_V(8);
            PG8_WAIT_L(0); PG8_BAR; PG8_MMA(1, 0, At, B0); PG8_MMA(1, 1, At, B1); PG8_BAR; PG8_SCHED;
            PG8_LDB(B0, 1, 0); PG8_LDB(B1, 1, 1); PG8_SCHED; PG8_LDA(At, 1, 0); PG8_STAGE_A(PG8_SA(0, 1), a2, 1, last);
            PG8_WAIT_V(8); PG8_WAIT_L(0); PG8_BAR; PG8_MMA(0, 0, At, B0); PG8_MMA(0, 1, At, B1); PG8_BAR; PG8_SCHED;
            PG8_LDA(At, 1, 1); PG8_STAGE(PG8_SB(1, 0), b3, voffB); PG8_STAGE(PG8_SB(1, 1), b3 + hstep, voffB); PG8_STAGE_A(PG8_SA(1, 0), a3, 0, last);
            PG8_WAIT_V(8); PG8_WAIT_L(0); PG8_BAR; PG8_MMA(1, 0, At, B0); PG8_MMA(1, 1, At, B1); PG8_BAR; PG8_SCHED;
        }
        if (wr == 0) PG8_BAR;
        {
            const int erow = cur.row0 + wr * 64 + fr, ecol = cur.col0 + wc * 32 + 8 * fq;
#define PG8_V8(ai, bj, m) { acc[ai][bj][m][0][0], acc[ai][bj][m][0][1], acc[ai][bj][m][0][2], acc[ai][bj][m][0][3], acc[ai][bj][m][1][0], acc[ai][bj][m][1][1], acc[ai][bj][m][1][2], acc[ai][bj][m][1][3] }
            auto run = [&](const auto& EE, auto KT) {
                typedef typename std::remove_cv<typename std::remove_reference<decltype(EE)>::type>::type EP; constexpr int KIND = decltype(KT)::value;
                if constexpr (pairbj<EP>::value) {
#pragma unroll
                    for (int ai = 0; ai < 2; ++ai)
#pragma unroll
                        for (int m = 0; m < 4; ++m) { const float vg[8] = PG8_V8(ai, 0, m); const float vu[8] = PG8_V8(ai, 1, m); EE.apply_pair(erow + ai * HALF + m * 16, ecol, vg, vu); }
                } else if constexpr (statld<EP>::value) {
                    typename EP::Rs rs[2][4];
#pragma unroll
                    for (int bj = 0; bj < 2; ++bj) { typename EP::Cl cl; typename EP::Ld ld[2][4]; EE.template colload<KIND>(ecol + bj * HALF, cl);
                        if (bj == 0 || EP::template stat_per_half<KIND>()) {
#pragma unroll
                            for (int ai = 0; ai < 2; ++ai)
#pragma unroll
                                for (int m = 0; m < 4; ++m) EE.template rowstat<KIND>(erow + ai * HALF + m * 16, ecol + bj * HALF, rs[ai][m]); }
#pragma unroll
                        for (int ai = 0; ai < 2; ++ai)
#pragma unroll
                            for (int m = 0; m < 4; ++m) EE.template load<KIND>(erow + ai * HALF + m * 16, ecol + bj * HALF, ld[ai][m]);
                        PG8_SCHED;
#pragma unroll
                        for (int ai = 0; ai < 2; ++ai)
#pragma unroll
                            for (int m = 0; m < 4; ++m) { const float v[8] = PG8_V8(ai, bj, m); EE.template apply<KIND>(erow + ai * HALF + m * 16, ecol + bj * HALF, v, ld[ai][m], rs[ai][m], cl); }
                        PG8_SCHED; }
                } else if constexpr (NT2) {
                    typename EP::Cl cl; typename EP::Ld ld[2][4]; typename EP::Pk pk[2][2][4];
#pragma unroll
                    for (int ai = 0; ai < 2; ++ai)
#pragma unroll
                        for (int m = 0; m < 4; ++m) EE.template load<KIND>(erow + ai * HALF + m * 16, ecol, ld[ai][m]);
#pragma unroll
                    for (int bj = 0; bj < 2; ++bj)
#pragma unroll
                        for (int ai = 0; ai < 2; ++ai)
#pragma unroll
                            for (int m = 0; m < 4; ++m) { const float v[8] = PG8_V8(ai, bj, m); pk[bj][ai][m] = EE.template pack<KIND>(v, ld[ai][m]); }
                    PG8_WAIT_V(0); PG8_BAR;
#pragma unroll
                    for (int bj = 0; bj < 2; ++bj)
#pragma unroll
                        for (int ai = 0; ai < 2; ++ai)
#pragma unroll
                            for (int m = 0; m < 4; ++m) EE.template put<KIND>(erow + ai * HALF + m * 16, ecol + bj * HALF, pk[bj][ai][m]);
                } else if constexpr (rowld<EP>::value) {
                    typename EP::Cl cl; typename EP::Ld ld[2][4];
#pragma unroll
                    for (int ai = 0; ai < 2; ++ai)
#pragma unroll
                        for (int m = 0; m < 4; ++m) EE.template load<KIND>(erow + ai * HALF + m * 16, ecol, ld[ai][m]);
#pragma unroll
                    for (int bj = 0; bj < 2; ++bj)
#pragma unroll
                        for (int ai = 0; ai < 2; ++ai)
#pragma unroll
                            for (int m = 0; m < 4; ++m) { const float v[8] = PG8_V8(ai, bj, m); EE.template apply<KIND>(erow + ai * HALF + m * 16, ecol + bj * HALF, m, v, ld[ai][m], cl); }
                } else if constexpr (EP::PIPE) {
                    typename EP::Cl cl[2]; EE.template colload<KIND>(ecol, cl[0]); EE.template colload<KIND>(ecol + HALF, cl[1]);
                    typename EP::Ld ld[2][4];
#pragma unroll
                    for (int m = 0; m < 4; ++m) EE.template load<KIND>(erow + m * 16, ecol, ld[0][m]);
#pragma unroll
                    for (int gi = 0; gi < 4; ++gi) { const int ai = gi >> 1, bj = gi & 1;
                        if (gi < 3) { const int ai2 = (gi + 1) >> 1, bj2 = (gi + 1) & 1;
#pragma unroll
                            for (int m = 0; m < 4; ++m) EE.template load<KIND>(erow + ai2 * HALF + m * 16, ecol + bj2 * HALF, ld[(gi + 1) & 1][m]); }
#pragma unroll
                        for (int m = 0; m < 4; ++m) { const float v[8] = PG8_V8(ai, bj, m); EE.template apply<KIND>(erow + ai * HALF + m * 16, ecol + bj * HALF, m, v, ld[gi & 1][m], cl[bj]); } }
                } else {
#pragma unroll
                    for (int bj = 0; bj < 2; ++bj) { typename EP::Cl cl; EE.template colload<KIND>(ecol + bj * HALF, cl);
#pragma unroll
                        for (int ai = 0; ai < 2; ++ai)
#pragma unroll
                            for (int mg = 0; mg < 4; mg += epigroup<EP>::value) { typename EP::Ld ld[4];
#pragma unroll
                                for (int m = mg; m < mg + epigroup<EP>::value; ++m) EE.template load<KIND>(erow + ai * HALF + m * 16, ecol + bj * HALF, ld[m]);
#pragma unroll
                                for (int m = mg; m < mg + epigroup<EP>::value; ++m) { const float v[8] = PG8_V8(ai, bj, m); EE.template apply<KIND>(erow + ai * HALF + m * 16, ecol + bj * HALF, m, v, ld[m], cl); } } }
                }
            };
            if (cur.mode == 3) run(E2, KindTag<0>{});
            else if (PAIRED && cur.mode == 1) {
                if constexpr (PAIRED) {
#pragma unroll
                for (int bj = 0; bj < 2; ++bj) { typename Epi::Ld ld[2][4];
#pragma unroll
                    for (int ai = 0; ai < 2; ++ai)
#pragma unroll
                        for (int m = 0; m < 4; ++m) E.midload(erow + ai * HALF + m * 16, ecol + bj * HALF, ld[ai][m]);
                    PG8_SCHED;
#pragma unroll
                    for (int ai = 0; ai < 2; ++ai)
#pragma unroll
                        for (int m = 0; m < 4; ++m) { float v[8] = PG8_V8(ai, bj, m); E.mid(v, ld[ai][m]);
                            acc[ai][bj][m][0] = (f32x4){v[0], v[1], v[2], v[3]}; acc[ai][bj][m][1] = (f32x4){v[4], v[5], v[6], v[7]}; }
                    PG8_SCHED; }
                }
            } else if constexpr (Epi::NKIND == 1) run(E, KindTag<0>{});
            else { const int kd = __builtin_amdgcn_readfirstlane(E.kind(cur.col0));
                if (kd == 0) run(E, KindTag<0>{}); else if (kd == 1) run(E, KindTag<1>{});
                else if constexpr (Epi::NKIND > 2) { if (kd == 2) run(E, KindTag<2>{}); else run(E, KindTag<3>{}); } }
#undef PG8_V8
        }
        if (!has_next) break;
        if (!PAIRED || cur.mode != 1) {
#pragma unroll
        for (int a = 0; a < 2; ++a)
#pragma unroll
            for (int b = 0; b < 2; ++b)
#pragma unroll
                for (int m = 0; m < 4; ++m)
#pragma unroll
                    for (int n = 0; n < 2; ++n) acc[a][b][m][n] = (f32x4){0.f, 0.f, 0.f, 0.f};
        }
        cur = nxt; cA = nA; cB = nB; ++ui;
        if (wr == 1) PG8_BAR;
    }
    PG8_WAIT_V(0);
    PG8_BAR;
#undef PG8_SA
#undef PG8_SB
#undef PG8_STAGE
#undef PG8_STAGE_A
#undef PG8_LOADIDX
#undef PG8_LDA
#undef PG8_LDB
#undef PG8_MMA
#undef PG8_WAIT_V
#undef PG8_WAIT_L
#undef PG8_BAR
#undef PG8_SCHED
}
template <bool GATHER, bool PAIRED, class Epi, class Sched>
__device__ __forceinline__ void gemm_phase(LAS unsigned char* lds, const int wv, const int K, const Sched& S, const Epi& E) { gemm_phase2<GATHER, PAIRED, false>(lds, wv, K, S, E, E); }
}
template <class Epi>
__device__ __forceinline__ void fgemm_dense(LAS unsigned char* lds, const int wv, const bf16* A, const bf16* Bt, int M, int N, int K, const Epi& epi) {
    pg8::DenseOrder S; S.init(A, Bt, M, N, K);
    pg8::gemm_phase<false, false>(lds, wv, K, S, epi);
}
template <class Epi>
__device__ __forceinline__ void fgemm_paired(LAS unsigned char* lds, const int wv, const bf16* A1, const bf16* B1, const bf16* A2, const bf16* B2, int M, int N, int K, const Epi& epi) {
    pg8::PairedOrder S; S.d.init(A1, B1, M, N, K); S.A2 = (const char*)A2; S.B2 = (const char*)B2;
    pg8::gemm_phase<false, true>(lds, wv, K, S, epi);
}

__device__ __forceinline__ void scan_hgrn(const Args& a, LAS unsigned char* lds, int b, int h, bool meta_only) {
    unsigned char* ws = a.ws; const int tid = threadIdx.x, v = tid >> 2, kq = tid & 3;
    LAS float* qs = (LAS float*)lds; LAS float* fs = qs + 16 * 128;
    const float* meta = (const float*)(ws + WS_META);
    bf16* QA = (bf16*)(ws + WS_QA); const bf16* LFA = (const bf16*)(ws + WS_LFA); const bf16* IA = (const bf16*)(ws + WS_IA);
    float S[32];
#pragma unroll
    for (int j = 0; j < 32; ++j) S[j] = 0.f;
    for (int blk = -1; blk < SEQ / 16; ++blk) {
        __syncthreads();
        for (int i = tid; i < 16 * 128; i += 512) { const int s = i >> 7, k = i & 127;
            if (blk < 0) { qs[i] = meta[0 * 16384 + s * 1024 + h * 128 + k]; fs[i] = __expf(meta[1 * 16384 + s * 1024 + h * 128 + k]); }
            else { const size_t t = (size_t)b * SEQ + blk * 16 + s; qs[i] = bf2f(QA[t * D + h * 128 + k]); fs[i] = __expf(h2f(LFA[t * D + h * 128 + k])); } }
        __syncthreads();
        for (int s = 0; s < 16; ++s) {
            float vt; size_t t = 0;
            if (blk < 0) vt = meta[2 * 16384 + s * 1024 + h * 128 + v]; else { t = (size_t)b * SEQ + blk * 16 + s; vt = bf2f(IA[t * D + h * 128 + v]); }
            float o = 0.f;
#pragma unroll
            for (int j = 0; j < 32; ++j) { const float f = fs[s * 128 + kq * 32 + j], q = qs[s * 128 + kq * 32 + j]; S[j] = f * S[j] + (1.0f - f) * vt; o += S[j] * q; }
            o += __shfl_xor(o, 1); o += __shfl_xor(o, 2);
            if (blk >= 0 && kq == 0) QA[t * D + h * 128 + v] = (bf16)f2bf(o);
        }
        if (meta_only) { float* sm = (float*)(ws + WS_SMETA) + (size_t)h * 128 * 128;
#pragma unroll
            for (int j = 0; j < 32; ++j) sm[(kq * 32 + j) * 128 + v] = S[j];
            break; }
    }
}
__device__ __forceinline__ void scan_mlstm(const Args& a, LAS unsigned char* lds, int b, int h, bool meta_only) {
    unsigned char* ws = a.ws; const int tid = threadIdx.x, v = tid >> 1, kh = tid & 1;
    LAS float* qs = (LAS float*)lds; LAS float* ks = qs + 16 * 128; LAS float* raw = ks + 16 * 128; LAS float* sc = raw + 19 * 256;
    const float* meta = (const float*)(ws + WS_META); const float* igfg = (const float*)(ws + WS_IGFG);
    const bf16* QKB = (const bf16*)(ws + WS_QKB); bf16* VB = (bf16*)(ws + WS_VB);
    const float* cw = a.in[7]; const float* cb = a.in[8]; const float igb = a.in[9][h], fgb = a.in[10][h];
    float C[64], n[64];
#pragma unroll
    for (int j = 0; j < 64; ++j) { C[j] = 0.f; n[j] = 0.f; }
    float M = 0.f;
    for (int blk = -1; blk < SEQ / 16; ++blk) {
        __syncthreads();
        for (int i = tid; i < 19 * 256; i += 512) { const int r = i >> 8, c = i & 255; const int ch = (c < 128) ? h * 128 + c : 512 + h * 128 + (c - 128);
            float val;
            if (blk < 0) { const int mr = r - 3; val = mr >= 0 ? meta[3 * 16384 + mr * 1024 + ch] : 0.f; }
            else { const int tt = blk * 16 + r - 3; val = tt >= 0 ? bf2f(QKB[((size_t)b * SEQ + tt) * D + ch]) : meta[3 * 16384 + (16 + tt) * 1024 + ch]; }
            raw[i] = val; }
        if (tid < 16) { float ig, fg;
            if (blk < 0) { ig = meta[5 * 16384 + tid * 8 + h]; fg = meta[5 * 16384 + tid * 8 + 4 + h]; }
            else { const size_t t = (size_t)b * SEQ + blk * 16 + tid; ig = igfg[t * 8 + h]; fg = igfg[t * 8 + 4 + h]; }
            ig += igb; fg += fgb;
            sc[tid] = ig; sc[16 + tid] = fminf(fg, 0.f) - log1pf(__expf(-fabsf(fg))); }
        __syncthreads();
        for (int i = tid; i < 16 * 256; i += 512) { const int s = i >> 8, c = i & 255; const int ch = (c < 128) ? h * 128 + c : 512 + h * 128 + (c - 128);
            float y = cb[ch];
#pragma unroll
            for (int j = 0; j < 4; ++j) y += cw[j * 1024 + ch] * raw[(s + j) * 256 + c];
            y = siluf_(y);
            if (c < 128) qs[s * 128 + c] = y * 0.08838834764831845f; else ks[s * 128 + c - 128] = y; }
        __syncthreads();
        for (int s = 0; s < 16; ++s) {
            float vt; size_t t = 0;
            if (blk < 0) vt = meta[4 * 16384 + s * 1024 + h * 256 + v]; else { t = (size_t)b * SEQ + blk * 16 + s; vt = bf2f(VB[t * D + h * 256 + v]); }
            const float ig = sc[s], lf = sc[16 + s]; const float Mn = fmaxf(lf + M, ig), fd = __expf(lf + M - Mn), iw = __expf(ig - Mn); M = Mn;
            float num = 0.f, den = 0.f; const float iv = iw * vt;
#pragma unroll
            for (int j = 0; j < 64; ++j) { const float kv = ks[s * 128 + kh * 64 + j], q = qs[s * 128 + kh * 64 + j]; C[j] = fd * C[j] + iv * kv; n[j] = fd * n[j] + iw * kv; num += C[j] * q; den += n[j] * q; }
            num += __shfl_xor(num, 1); den += __shfl_xor(den, 1);
            const float hv = num / fmaxf(fabsf(den), __expf(-M));
            if (blk >= 0 && kh == 0) VB[t * D + h * 256 + v] = (bf16)f2bf(hv);
        }
        if (meta_only) { float* cm = (float*)(ws + WS_CMETA) + (size_t)h * 128 * 256; float* nm = (float*)(ws + WS_NMETA);
#pragma unroll
            for (int j = 0; j < 64; ++j) { cm[(kh * 64 + j) * 256 + v] = C[j]; if (v == 0) nm[h * 128 + kh * 64 + j] = n[j]; }
            if (tid == 0) nm[1024 + h] = M;
            break; }
    }
}

__device__ __forceinline__ void s0_hgrn_prep(const Args& a) {
    unsigned char* ws = a.ws;
    for (int it = blockIdx.x * 512 + threadIdx.x; it < 1024 * 128; it += gridDim.x * 512) {
        const int oct = it & 127, cg = it >> 7; const size_t base = (size_t)cg * 64 * D + oct * 8;
        bf16* Q = (bf16*)(ws + WS_QA) + base; bf16* L = (bf16*)(ws + WS_LFA) + base;
        float r[8], bc[8];
#pragma unroll
        for (int j = 0; j < 8; ++j) { r[j] = 0.f; bc[j] = 0.f; }
#pragma unroll 1
        for (int s0 = 0; s0 < 32; s0 += 16) { u32x4 w[16];
#pragma unroll
            for (int u = 0; u < 16; ++u) w[u] = *(const u32x4*)(L + (size_t)(s0 + u) * D);
#pragma unroll
            for (int u = 0; u < 16; ++u)
#pragma unroll
                for (int i = 0; i < 4; ++i) { r[2 * i] += h2f(w[u][i] & 0xffffu); r[2 * i + 1] += h2f(w[u][i] >> 16); } }
#pragma unroll 1
        for (int s0 = 0; s0 < 64; s0 += 8) { u32x4 wl[8], wq[8];
#pragma unroll
            for (int u = 0; u < 8; ++u) { wl[u] = *(const u32x4*)(L + (size_t)(s0 + u) * D); wq[u] = *(const u32x4*)(Q + (size_t)(s0 + u) * D); }
#pragma unroll
            for (int u = 0; u < 8; ++u) { float qt[8], kt[8];
#pragma unroll
                for (int i = 0; i < 4; ++i) {
#pragma unroll
                    for (int hh = 0; hh < 2; ++hh) { const int j = 2 * i + hh; const float lf = h2f(hh ? (wl[u][i] >> 16) : (wl[u][i] & 0xffffu)), q = bf2f(hh ? (wq[u][i] >> 16) : (wq[u][i] & 0xffffu));
                        bc[j] += lf; qt[j] = q * __expf(fminf(bc[j] - r[j], 80.f)); kt[j] = -expm1f(lf) * __expf(fminf(r[j] - bc[j], 80.f)); } }
                store8_bf16(Q + (size_t)(s0 + u) * D, qt); store8_bf16(L + (size_t)(s0 + u) * D, kt); } }
        float* em = (float*)(ws + WS_EM) + (size_t)cg * 1024 + oct * 8; float* el = (float*)(ws + WS_EL) + (size_t)cg * 1024 + oct * 8;
        *(f32x4*)em = (f32x4){__expf(r[0]), __expf(r[1]), __expf(r[2]), __expf(r[3])}; *(f32x4*)(em + 4) = (f32x4){__expf(r[4]), __expf(r[5]), __expf(r[6]), __expf(r[7])};
        *(f32x4*)el = (f32x4){__expf(bc[0] - r[0]), __expf(bc[1] - r[1]), __expf(bc[2] - r[2]), __expf(bc[3] - r[3])}; *(f32x4*)(el + 4) = (f32x4){__expf(bc[4] - r[4]), __expf(bc[5] - r[5]), __expf(bc[6] - r[6]), __expf(bc[7] - r[7])};
    }
}
__device__ __forceinline__ void s0_mlstm_conv(const Args& a) {
    unsigned char* ws = a.ws; const float* cw = a.in[7]; const float* cb = a.in[8]; const float* meta = (const float*)(ws + WS_META);
    for (int it = blockIdx.x * 512 + threadIdx.x; it < 1024 * 128; it += gridDim.x * 512) {
        const int oct = it & 127, cg = it >> 7, ch = oct * 8; bf16* X = (bf16*)(ws + WS_QKB) + (size_t)cg * 64 * D + ch;
        float w0[8], w1[8], w2[8], c0[8], c1[8], c2[8], c3[8], bb[8];
#pragma unroll
        for (int j = 0; j < 8; ++j) { c0[j] = cw[ch + j]; c1[j] = cw[1024 + ch + j]; c2[j] = cw[2048 + ch + j]; c3[j] = cw[3072 + ch + j]; bb[j] = cb[ch + j]; }
        if ((cg & 127) == 0) {
#pragma unroll
            for (int j = 0; j < 8; ++j) { w0[j] = meta[3 * 16384 + 13 * 1024 + ch + j]; w1[j] = meta[3 * 16384 + 14 * 1024 + ch + j]; w2[j] = meta[3 * 16384 + 15 * 1024 + ch + j]; }
        } else { const bf16* hp = (const bf16*)(ws + WS_HALO) + (size_t)(cg - 1) * 3 * D + ch; load8_bf16(hp, w0); load8_bf16(hp + D, w1); load8_bf16(hp + 2 * D, w2); }
        const bool isq = ch < 512; const int hh = (ch & 511) >> 7; const f32x4* gates = (const f32x4*)(ws + WS_GATES);
        const float scale = isq ? 0.08838834764831845f : 1.0f;
#pragma unroll 1
        for (int s0 = 0; s0 < 64; s0 += 8) { u32x4 xw[8]; f32x4 gt[8];
#pragma unroll
            for (int u = 0; u < 8; ++u) { xw[u] = *(const u32x4*)(X + (size_t)(s0 + u) * D); gt[u] = gates[((size_t)cg * 64 + s0 + u) * 4 + hh]; }
#pragma unroll
            for (int u = 0; u < 8; ++u) { float x[8], y[8]; unpack8(xw[u], x); const float rs_ = scale * (isq ? gt[u].x : gt[u].y);
#pragma unroll
                for (int j = 0; j < 8; ++j) { const float t = bb[j] + c0[j] * w0[j] + c1[j] * w1[j] + c2[j] * w2[j] + c3[j] * x[j]; y[j] = siluf_(t) * rs_; w0[j] = w1[j]; w1[j] = w2[j]; w2[j] = x[j]; }
                store8_bf16(X + (size_t)(s0 + u) * D, y); } }
    }
}
__device__ __forceinline__ float logsigmoidf_(float x) { return fminf(x, 0.f) - log1pf(__expf(-fabsf(x))); }
__device__ __forceinline__ void s0_mlstm_gates(const Args& a, LAS unsigned char* lds, int b, int h) {
    unsigned char* ws = a.ws; const int tid = threadIdx.x, lane = tid & 63, wave = tid >> 6; const float igb = a.in[9][h], fgb = a.in[10][h];
    const float* meta = (const float*)(ws + WS_META); const float* igfg = (const float*)(ws + WS_IGFG); f32x4* gates = (f32x4*)(ws + WS_GATES);
    LAS float* sum = (LAS float*)lds;
    LAS float* mc = sum + 256;
    float bcv[16], pmv[16], igv[16];
    __syncthreads();
#pragma unroll
    for (int i = 0; i < 16; ++i) {
        const int c = wave * 16 + i; const size_t t = (size_t)b * SEQ + c * 64 + lane;
        const float ig = igfg[t * 8 + h] + igb, lf = logsigmoidf_(igfg[t * 8 + 4 + h] + fgb);
        float bc = lf;
#pragma unroll
        for (int o = 1; o < 64; o <<= 1) { const float u = __shfl_up(bc, o); if (lane >= o) bc += u; }
        float pm = ig - bc;
#pragma unroll
        for (int o = 1; o < 64; o <<= 1) { const float u = __shfl_up(pm, o); if (lane >= o) pm = fmaxf(pm, u); }
        bcv[i] = bc; pmv[i] = pm; igv[i] = ig;
        if (lane == 63) { sum[2 * c] = bc; sum[2 * c + 1] = pm; }
    }
    __syncthreads();
    if (tid == 0) { float Mc = 0.f;
        for (int s = 0; s < 16; ++s) { const float ig = meta[5 * 16384 + s * 8 + h] + igb, lf = logsigmoidf_(meta[5 * 16384 + s * 8 + 4 + h] + fgb); Mc = fmaxf(lf + Mc, ig); }
        for (int c = 0; c < 128; ++c) { mc[c] = Mc; Mc = sum[2 * c] + fmaxf(Mc, sum[2 * c + 1]); } }
    __syncthreads();
#pragma unroll
    for (int i = 0; i < 16; ++i) { const int c = wave * 16 + i; const size_t t = (size_t)b * SEQ + c * 64 + lane;
        const float Mt = bcv[i] + fmaxf(mc[c], pmv[i]), bL = __shfl(bcv[i], 63), ML = __shfl(Mt, 63);
        gates[t * 4 + h] = (f32x4){__expf(bcv[i] - Mt - bL + ML), __expf(igv[i] - bcv[i] + bL - ML), __expf(-Mt), __expf(bL + mc[c] - ML)}; }
    __syncthreads();
}
__device__ __forceinline__ void s0_prepass(const Args& a, LAS unsigned char* lds) {
    s0_hgrn_prep(a);
    s0_mlstm_conv(a);
    for (int u = blockIdx.x; u < 12; u += gridDim.x) {
        if (u < 8) scan_hgrn(a, lds, 0, u, true);
        else scan_mlstm(a, lds, 0, u - 8, true); }
}

typedef short v4i16_t __attribute__((ext_vector_type(4)));
typedef short bf16x8_t __attribute__((ext_vector_type(8)));
__device__ __forceinline__ v4i16_t tr16(LAS unsigned char* p) { return __builtin_amdgcn_ds_read_tr16_b64_v4i16((LAS v4i16_t*)p); }
__device__ __forceinline__ bf16x8_t cat44(v4i16_t a, v4i16_t b) { return (bf16x8_t){a[0], a[1], a[2], a[3], b[0], b[1], b[2], b[3]}; }
__device__ __forceinline__ bf16x8_t pack8(f32x4 a, f32x4 b) { const u32x4 w = {pk2(a.x, a.y), pk2(a.z, a.w), pk2(b.x, b.y), pk2(b.z, b.w)}; return __builtin_bit_cast(bf16x8_t, w); }
__device__ __forceinline__ bf16x8_t cat22(u32x2 a, u32x2 b) { const u32x4 w = {a.x, a.y, b.x, b.y}; return __builtin_bit_cast(bf16x8_t, w); }
constexpr int SC_QT = 0, SC_KT = 17408, SC_VT = 34816, SC_PT = 44032, SC_EM = 53248, SC_EL = 53760, SC_QS = 272, SC_VS = 144;

constexpr int S3_SET = 45056, S3_P = 90112, S3_ST = 99328;
__device__ __forceinline__ void fscan3_hgrn(const Args& a, LAS unsigned char* lds, int b, int h, int vh) {
    unsigned char* ws = a.ws; const int tid = threadIdx.x, lane = tid & 63, w = tid >> 6, fr = lane & 15, g = lane >> 4, q4 = fr >> 2, p4 = fr & 3;
    const bf16* QA = (const bf16*)(ws + WS_QA); const bf16* KA = (const bf16*)(ws + WS_LFA); bf16* IA = (bf16*)(ws + WS_IA);
    const float* EMg = (const float*)(ws + WS_EM); const float* ELg = (const float*)(ws + WS_EL);
    const int vt = w & 3, th = w >> 2, tt = w & 3, sh = w >> 2;
    f32x4 S[8];
    { const float* sm = (const float*)(ws + WS_SMETA) + (size_t)h * 128 * 128 + vh * 64 + vt * 16 + fr;
#pragma unroll
      for (int kt = 0; kt < 8; ++kt)
#pragma unroll
          for (int r = 0; r < 4; ++r) S[kt][r] = sm[(16 * kt + 4 * g + r) * 128]; }
    const int r0 = tid >> 4, c0 = tid & 15, rv = tid >> 3, cv = tid & 7;
    u32x4 pq0, pq1, pk0, pk1, pv; f32x4 pe;
#define HG_FETCH(c) do { const size_t t0 = (size_t)b * SEQ + (size_t)(c) * 64; \
        pq0 = *(const u32x4*)(QA + (t0 + r0) * D + h * 128 + c0 * 8); pq1 = *(const u32x4*)(QA + (t0 + r0 + 32) * D + h * 128 + c0 * 8); \
        pk0 = *(const u32x4*)(KA + (t0 + r0) * D + h * 128 + c0 * 8); pk1 = *(const u32x4*)(KA + (t0 + r0 + 32) * D + h * 128 + c0 * 8); \
        pv = *(const u32x4*)(IA + (t0 + rv) * D + h * 128 + vh * 64 + cv * 8); \
        if (tid < 64) { const size_t cgi = ((size_t)b * 128 + (c)) * 1024 + h * 128; pe = *(const f32x4*)((tid < 32 ? EMg : ELg) + cgi + (tid & 31) * 4); } } while (0)
#define HG_COMMIT(sb) do { LAS unsigned char* B_ = lds + (sb); *(LAS u32x4*)(B_ + r0 * SC_QS + c0 * 16) = pq0; *(LAS u32x4*)(B_ + (r0 + 32) * SC_QS + c0 * 16) = pq1; \
        *(LAS u32x4*)(B_ + 17408 + r0 * SC_QS + c0 * 16) = pk0; *(LAS u32x4*)(B_ + 17408 + (r0 + 32) * SC_QS + c0 * 16) = pk1; \
        *(LAS u32x4*)(B_ + 34816 + rv * SC_VS + cv * 16) = pv; \
        if (tid < 64) *(LAS f32x4*)(B_ + (tid < 32 ? 44032 : 44544) + (tid & 31) * 16) = pe; } while (0)
    __syncthreads();
    HG_FETCH(0); HG_COMMIT(0);
    __syncthreads();
    for (int c = 0; c < SEQ / 64; ++c) {
        const int sb = (c & 1) * S3_SET;
        LAS unsigned char* Q_ = lds + sb; LAS unsigned char* K_ = Q_ + 17408; LAS unsigned char* V_ = Q_ + 34816; LAS unsigned char* P_ = lds + S3_P;
        if (c + 1 < SEQ / 64) HG_FETCH(c + 1);
        {
            bf16x8_t bq[4];
#pragma unroll
            for (int ks = 0; ks < 4; ++ks) bq[ks] = *(const LAS bf16x8_t*)(Q_ + (tt * 16 + fr) * SC_QS + ks * 64 + g * 16);
#pragma unroll
            for (int si = 0; si < 2; ++si) { const int st = 2 * sh + si; f32x4 acc = {0.f, 0.f, 0.f, 0.f};
#pragma unroll
                for (int ks = 0; ks < 4; ++ks) { const bf16x8_t ak = *(const LAS bf16x8_t*)(K_ + (st * 16 + fr) * SC_QS + ks * 64 + g * 16); acc = __builtin_amdgcn_mfma_f32_16x16x32_bf16(ak, bq[ks], acc, 0, 0, 0); }
                const int t = tt * 16 + fr, s0 = st * 16 + 4 * g; u32x2 pw;
                pw.x = pk2(s0 + 0 <= t ? acc[0] : 0.f, s0 + 1 <= t ? acc[1] : 0.f); pw.y = pk2(s0 + 2 <= t ? acc[2] : 0.f, s0 + 3 <= t ? acc[3] : 0.f);
                *(LAS u32x2*)(P_ + t * SC_VS + s0 * 2) = pw; }
        }
        __syncthreads();
        {
            bf16x8_t afr[4], vfr[2];
#pragma unroll
            for (int kt = 0; kt < 8; ++kt) S[kt] = S[kt] * *(const LAS f32x4*)(Q_ + 44032 + (16 * kt + 4 * g) * 4);
#pragma unroll
            for (int ks = 0; ks < 4; ++ks) afr[ks] = pack8(S[2 * ks], S[2 * ks + 1]);
#pragma unroll
            for (int k2 = 0; k2 < 2; ++k2) { LAS unsigned char* pa = V_ + (32 * k2 + 8 * g + q4) * SC_VS + (vt * 16 + 4 * p4) * 2; vfr[k2] = cat44(tr16(pa), tr16(pa + 4 * SC_VS)); }
            const size_t t0 = (size_t)b * SEQ + (size_t)c * 64;
#pragma unroll
            for (int ti = 0; ti < 2; ++ti) { const int t = (2 * th + ti) * 16 + fr; f32x4 acc = {0.f, 0.f, 0.f, 0.f};
#pragma unroll
                for (int ks = 0; ks < 4; ++ks) { const u32x2 lo = *(const LAS u32x2*)(Q_ + t * SC_QS + (32 * ks + 4 * g) * 2), hi = *(const LAS u32x2*)(Q_ + t * SC_QS + (32 * ks + 16 + 4 * g) * 2);
                    acc = __builtin_amdgcn_mfma_f32_16x16x32_bf16(afr[ks], cat22(lo, hi), acc, 0, 0, 0); }
#pragma unroll
                for (int k2 = 0; k2 < 2; ++k2) { const bf16x8_t pf = *(const LAS bf16x8_t*)(P_ + t * SC_VS + (32 * k2 + 8 * g) * 2); acc = __builtin_amdgcn_mfma_f32_16x16x32_bf16(vfr[k2], pf, acc, 0, 0, 0); }
                u32x2 ow; ow.x = pk2(acc[0], acc[1]); ow.y = pk2(acc[2], acc[3]);
                *(u32x2*)(IA + (t0 + t) * D + h * 128 + vh * 64 + vt * 16 + 4 * g) = ow;
                float sq = (acc[0] * acc[0] + acc[1] * acc[1]) + (acc[2] * acc[2] + acc[3] * acc[3]); sq += __shfl_xor(sq, 16); sq += __shfl_xor(sq, 32);
                if (g == 0) *(LAS float*)(lds + S3_ST + (vt * 64 + t) * 4) = sq; }
#pragma unroll
            for (int kt = 0; kt < 8; ++kt) {
#pragma unroll
                for (int k2 = 0; k2 < 2; ++k2) { LAS unsigned char* pa = K_ + (32 * k2 + 8 * g + q4) * SC_QS + (16 * kt + 4 * p4) * 2; const bf16x8_t ak = cat44(tr16(pa), tr16(pa + 4 * SC_QS));
                    S[kt] = __builtin_amdgcn_mfma_f32_16x16x32_bf16(ak, vfr[k2], S[kt], 0, 0, 0); }
                S[kt] = S[kt] * *(const LAS f32x4*)(Q_ + 44544 + (16 * kt + 4 * g) * 4); }
        }
        if (c + 1 < SEQ / 64) HG_COMMIT(S3_SET - sb);
        __syncthreads();
        if (tid < 64) { const LAS float* sp = (const LAS float*)(lds + S3_ST) + tid;
            ((float*)(ws + WS_STA2))[((size_t)b * SEQ + (size_t)c * 64 + tid) * 16 + h * 2 + vh] = (sp[0] + sp[64]) + (sp[128] + sp[192]); }
    }
#undef HG_FETCH
#undef HG_COMMIT
}
__device__ __forceinline__ void fscan3_mlstm(const Args& a, LAS unsigned char* lds, int b, int h, int vq) {
    unsigned char* ws = a.ws; const int tid = threadIdx.x, lane = tid & 63, w = tid >> 6, fr = lane & 15, g = lane >> 4, q4 = fr >> 2, p4 = fr & 3;
    const bf16* QK = (const bf16*)(ws + WS_QKB); bf16* VB = (bf16*)(ws + WS_VB); const f32x4* GT = (const f32x4*)(ws + WS_GATES);
    const int vt = w & 3, th = w >> 2, tt = w & 3, sh = w >> 2;
    f32x4 S[8], N[8];
    { const float* cm = (const float*)(ws + WS_CMETA) + (size_t)h * 128 * 256 + vq * 64 + vt * 16 + fr; const float* nm = (const float*)(ws + WS_NMETA) + h * 128;
#pragma unroll
      for (int kt = 0; kt < 8; ++kt)
#pragma unroll
          for (int r = 0; r < 4; ++r) { S[kt][r] = cm[(16 * kt + 4 * g + r) * 256]; N[kt][r] = nm[16 * kt + 4 * g + r]; } }
    const u32x4 onew = {0x3F803F80u, 0x3F803F80u, 0x3F803F80u, 0x3F803F80u}; const bf16x8_t ones = __builtin_bit_cast(bf16x8_t, onew);
    const int r0 = tid >> 4, c0 = tid & 15, rv = tid >> 3, cv = tid & 7;
    u32x4 pq0, pq1, pk0, pk1, pv; f32x4 pe;
#define ML_FETCH(c) do { const size_t t0 = (size_t)b * SEQ + (size_t)(c) * 64; \
        pq0 = *(const u32x4*)(QK + (t0 + r0) * D + h * 128 + c0 * 8); pq1 = *(const u32x4*)(QK + (t0 + r0 + 32) * D + h * 128 + c0 * 8); \
        pk0 = *(const u32x4*)(QK + (t0 + r0) * D + 512 + h * 128 + c0 * 8); pk1 = *(const u32x4*)(QK + (t0 + r0 + 32) * D + 512 + h * 128 + c0 * 8); \
        pv = *(const u32x4*)(VB + (t0 + rv) * D + h * 256 + vq * 64 + cv * 8); \
        if (tid < 64) pe = GT[(t0 + tid) * 4 + h]; } while (0)
#define ML_COMMIT(sb) do { LAS unsigned char* B_ = lds + (sb); *(LAS u32x4*)(B_ + r0 * SC_QS + c0 * 16) = pq0; *(LAS u32x4*)(B_ + (r0 + 32) * SC_QS + c0 * 16) = pq1; \
        *(LAS u32x4*)(B_ + 17408 + r0 * SC_QS + c0 * 16) = pk0; *(LAS u32x4*)(B_ + 17408 + (r0 + 32) * SC_QS + c0 * 16) = pk1; \
        *(LAS u32x4*)(B_ + 34816 + rv * SC_VS + cv * 16) = pv; \
        if (tid < 64) *(LAS f32x4*)(B_ + 44032 + tid * 16) = pe; } while (0)
    __syncthreads();
    ML_FETCH(0); ML_COMMIT(0);
    __syncthreads();
    for (int c = 0; c < SEQ / 64; ++c) {
        const int sb = (c & 1) * S3_SET;
        LAS unsigned char* Q_ = lds + sb; LAS unsigned char* K_ = Q_ + 17408; LAS unsigned char* V_ = Q_ + 34816; LAS unsigned char* G_ = Q_ + 44032; LAS unsigned char* P_ = lds + S3_P;
        if (c + 1 < SEQ / 64) ML_FETCH(c + 1);
        const float decay = (*(const LAS f32x4*)G_).w;
        {
            bf16x8_t bq[4];
#pragma unroll
            for (int ks = 0; ks < 4; ++ks) bq[ks] = *(const LAS bf16x8_t*)(Q_ + (tt * 16 + fr) * SC_QS + ks * 64 + g * 16);
#pragma unroll
            for (int si = 0; si < 2; ++si) { const int st = 2 * sh + si; f32x4 acc = {0.f, 0.f, 0.f, 0.f};
#pragma unroll
                for (int ks = 0; ks < 4; ++ks) { const bf16x8_t ak = *(const LAS bf16x8_t*)(K_ + (st * 16 + fr) * SC_QS + ks * 64 + g * 16); acc = __builtin_amdgcn_mfma_f32_16x16x32_bf16(ak, bq[ks], acc, 0, 0, 0); }
                const int t = tt * 16 + fr, s0 = st * 16 + 4 * g; u32x2 pw;
                pw.x = pk2(s0 + 0 <= t ? acc[0] : 0.f, s0 + 1 <= t ? acc[1] : 0.f); pw.y = pk2(s0 + 2 <= t ? acc[2] : 0.f, s0 + 3 <= t ? acc[3] : 0.f);
                *(LAS u32x2*)(P_ + t * SC_VS + s0 * 2) = pw; }
        }
        __syncthreads();
        {
            bf16x8_t vfr[2];
#pragma unroll
            for (int kt = 0; kt < 8; ++kt) { S[kt] = S[kt] * decay; N[kt] = N[kt] * decay; }
#pragma unroll
            for (int k2 = 0; k2 < 2; ++k2) { LAS unsigned char* pa = V_ + (32 * k2 + 8 * g + q4) * SC_VS + (vt * 16 + 4 * p4) * 2; vfr[k2] = cat44(tr16(pa), tr16(pa + 4 * SC_VS)); }
            const size_t t0 = (size_t)b * SEQ + (size_t)c * 64;
#pragma unroll 1
            for (int ti = 0; ti < 2; ++ti) { const int t = (2 * th + ti) * 16 + fr; f32x4 acc = {0.f, 0.f, 0.f, 0.f}, accd = {0.f, 0.f, 0.f, 0.f};
#pragma unroll
                for (int ks = 0; ks < 4; ++ks) { const bf16x8_t af = pack8(S[2 * ks], S[2 * ks + 1]), an = pack8(N[2 * ks], N[2 * ks + 1]);
                    const u32x2 lo = *(const LAS u32x2*)(Q_ + t * SC_QS + (32 * ks + 4 * g) * 2), hi = *(const LAS u32x2*)(Q_ + t * SC_QS + (32 * ks + 16 + 4 * g) * 2); const bf16x8_t qf = cat22(lo, hi);
                    acc = __builtin_amdgcn_mfma_f32_16x16x32_bf16(af, qf, acc, 0, 0, 0); accd = __builtin_amdgcn_mfma_f32_16x16x32_bf16(an, qf, accd, 0, 0, 0); }
#pragma unroll
                for (int k2 = 0; k2 < 2; ++k2) { const bf16x8_t pf = *(const LAS bf16x8_t*)(P_ + t * SC_VS + (32 * k2 + 8 * g) * 2);
                    acc = __builtin_amdgcn_mfma_f32_16x16x32_bf16(vfr[k2], pf, acc, 0, 0, 0); accd = __builtin_amdgcn_mfma_f32_16x16x32_bf16(ones, pf, accd, 0, 0, 0); }
                const float inv = __builtin_amdgcn_rcpf(fmaxf(fabsf(accd[0]), (*(const LAS f32x4*)(G_ + t * 16)).z));
                const float h0_ = acc[0] * inv, h1_ = acc[1] * inv, h2_ = acc[2] * inv, h3_ = acc[3] * inv;
                u32x2 ow; ow.x = pk2(h0_, h1_); ow.y = pk2(h2_, h3_);
                *(u32x2*)(VB + (t0 + t) * D + h * 256 + vq * 64 + vt * 16 + 4 * g) = ow;
                float s1 = (h0_ + h1_) + (h2_ + h3_), s2 = (h0_ * h0_ + h1_ * h1_) + (h2_ * h2_ + h3_ * h3_);
                s1 += __shfl_xor(s1, 16); s1 += __shfl_xor(s1, 32); s2 += __shfl_xor(s2, 16); s2 += __shfl_xor(s2, 32);
                if (g == 0) { *(LAS float*)(lds + S3_ST + (vt * 64 + t) * 4) = s1; *(LAS float*)(lds + S3_ST + 1024 + (vt * 64 + t) * 4) = s2; } }
#pragma unroll
            for (int kt = 0; kt < 8; ++kt) {
#pragma unroll
                for (int k2 = 0; k2 < 2; ++k2) { LAS unsigned char* pa = K_ + (32 * k2 + 8 * g + q4) * SC_QS + (16 * kt + 4 * p4) * 2; const bf16x8_t ak = cat44(tr16(pa), tr16(pa + 4 * SC_QS));
                    S[kt] = __builtin_amdgcn_mfma_f32_16x16x32_bf16(ak, vfr[k2], S[kt], 0, 0, 0); N[kt] = __builtin_amdgcn_mfma_f32_16x16x32_bf16(ak, ones, N[kt], 0, 0, 0); } }
        }
        if (c + 1 < SEQ / 64) ML_COMMIT(S3_SET - sb);
        __syncthreads();
        if (tid < 128) { const int tk = tid & 63, wh = tid >> 6; const LAS float* sp = (const LAS float*)(lds + S3_ST + wh * 1024) + tk;
            ((float*)(ws + WS_STB2))[(((size_t)b * SEQ + (size_t)c * 64 + tk) * 16 + h * 4 + vq) * 2 + wh] = (sp[0] + sp[64]) + (sp[128] + sp[192]); }
    }
#undef ML_FETCH
#undef ML_COMMIT
}

__device__ __forceinline__ void p_ln1_route(const Args& a, LAS unsigned char* lds) {
    unsigned char* ws = a.ws; const int tid = tidx_(a.wv), lane = tid & 63, wave = tid >> 6, fr = lane & 15, g = lane >> 4;
    LAS int* hist = (LAS int*)lds; LAS float* rbs = (LAS float*)(lds + 256);
    LAS unsigned char* hw = lds + 1024 + wave * 17408;
    LAS float* st = (LAS float*)(lds + 1024 + 8 * 17408 + wave * 256);
    const bf16* z = (const bf16*)(ws + WS_Z); const bf16* WT = (const bf16*)(ws + WS_WRT);
    bf16* h1 = (bf16*)(ws + WS_H0); float* lnst = (float*)(ws + WS_LNST1);
    int* eidx = (int*)(ws + WS_EIDX); float* gwp = (float*)(ws + WS_GW); int* lpos = (int*)(ws + WS_LPOS); int* wgbase = (int*)(ws + WS_WGBASE);
    unsigned* gcnt = (unsigned*)(ws + WS_CTL) + CW_GCNT;
    for (int tile = blockIdx.x; tile < T / 256; tile += gridDim.x) {
        const int half = tile / (T / 512), m0 = tile * 256 + wave * 32;
        __syncthreads();
        if (tid < 64) { hist[tid] = 0; rbs[tid] = a.in[18][tid]; }
        __syncthreads();
        {
            const f32x4* gp = (const f32x4*)a.in[15] + lane; const f32x4* bp = (const f32x4*)a.in[16] + lane;
            f32x4 gg[4], bb[4]; u32x2 zq[4][4];
#pragma unroll
            for (int j = 0; j < 4; ++j) { gg[j] = gp[64 * j]; bb[j] = bp[64 * j]; }
#pragma unroll
            for (int q = 0; q < 3; ++q)
#pragma unroll
                for (int j = 0; j < 4; ++j) zq[q][j] = ((const u32x2*)(z + (size_t)(m0 + q) * D) + lane)[64 * j];
#pragma unroll 1
            for (int r4 = 0; r4 < 32; r4 += 4) {
#pragma unroll
                for (int q = 0; q < 4; ++q) {
                    const int rr = r4 + q, m = m0 + rr; f32x4 v[4]; float s = 0.f, s2 = 0.f;
                    if (rr + 3 < 32) {
#pragma unroll
                        for (int j = 0; j < 4; ++j) zq[(q + 3) & 3][j] = ((const u32x2*)(z + (size_t)(m + 3) * D) + lane)[64 * j]; }
#pragma unroll
                    for (int j = 0; j < 4; ++j) { const u32x2 zw = zq[q][j]; v[j] = (f32x4){bf2f(zw.x & 0xffffu), bf2f(zw.x >> 16), bf2f(zw.y & 0xffffu), bf2f(zw.y >> 16)};
                        s += (v[j].x + v[j].y) + (v[j].z + v[j].w); s2 += (v[j].x * v[j].x + v[j].y * v[j].y) + (v[j].z * v[j].z + v[j].w * v[j].w); }
                    const float mean = wave_sum(s) * (1.f / D), ex2 = wave_sum(s2) * (1.f / D);
                    const float rstd = 1.f / sqrtf(fmaxf(ex2 - mean * mean, 0.f) + EPS);
                    unsigned* o4 = (unsigned*)(ws + WS_H8 + (size_t)m * D) + lane;
#pragma unroll
                    for (int j = 0; j < 4; ++j) { const f32x4 h = (v[j] - mean) * rstd * gg[j] + bb[j];
                        int w8 = __builtin_amdgcn_cvt_pk_fp8_f32(h.x, h.y, 0, false); w8 = __builtin_amdgcn_cvt_pk_fp8_f32(h.z, h.w, w8, true); o4[64 * j] = (unsigned)w8; }
                    if (lane == 0) { lnst[2 * m] = mean; lnst[2 * m + 1] = rstd; st[2 * rr] = mean; st[2 * rr + 1] = rstd; }
                }
            }
        }
        asm volatile("s_waitcnt lgkmcnt(0)" ::: "memory");
        f32x4 acc[2][4];
#pragma unroll
        for (int mt = 0; mt < 2; ++mt)
#pragma unroll
            for (int n = 0; n < 4; ++n) acc[mt][n] = (f32x4){0.f, 0.f, 0.f, 0.f};
        int lane2 = lane; asm volatile("" : "+v"(lane2));
        const int kk = (lane2 & 31) * 4; const bf16* zrow = z + (size_t)(m0 + (lane2 >> 5)) * D + kk;
        u32x2 zc[16];
#pragma unroll
        for (int i = 0; i < 16; ++i) zc[i] = *(const u32x2*)(zrow + (size_t)(2 * i) * D);
        bf16x8_t bh[2][4], bl[2][4];
#pragma unroll
        for (int n = 0; n < 4; ++n) { const bf16* wp = WT + (size_t)(16 * n + fr) * 1024 + g * 8; bh[0][n] = *(const bf16x8_t*)wp; bl[0][n] = *(const bf16x8_t*)(wp + 65536); }
#pragma unroll 1
        for (int kc = 0; kc < 8; ++kc) {
            { const f32x4 g4 = *(const f32x4*)(a.in[15] + kc * 128 + kk), b4 = *(const f32x4*)(a.in[16] + kc * 128 + kk);
#pragma unroll
              for (int i = 0; i < 16; ++i) { const int row = 2 * i + (lane2 >> 5); const u32x2 zw = zc[i];
                  const f32x4 z4 = {bf2f(zw.x & 0xffffu), bf2f(zw.x >> 16), bf2f(zw.y & 0xffffu), bf2f(zw.y >> 16)};
                  const float mean = st[2 * row], rstd = st[2 * row + 1]; const f32x4 h = (z4 - mean) * rstd * g4 + b4;
                  u32x2 hi; hi.x = pk2(h.x, h.y); hi.y = pk2(h.z, h.w);
                  const f32x4 hr = {bf2f(hi.x & 0xffffu), bf2f(hi.x >> 16), bf2f(hi.y & 0xffffu), bf2f(hi.y >> 16)}; const f32x4 l4 = h - hr;
                  u32x2 lo; lo.x = pk2(l4.x, l4.y); lo.y = pk2(l4.z, l4.w);
                  *(LAS u32x2*)(hw + row * 272 + kk * 2) = hi; *(LAS u32x2*)(hw + 8704 + row * 272 + kk * 2) = lo; }
              if (kc + 1 < 8) {
#pragma unroll
                  for (int i = 0; i < 16; ++i) zc[i] = *(const u32x2*)(zrow + (size_t)(2 * i) * D + (kc + 1) * 128); } }
            asm volatile("s_waitcnt lgkmcnt(0)" ::: "memory");
#pragma unroll
            for (int ks = 0; ks < 4; ++ks) {
                const int cb = ks & 1, nb = cb ^ 1; const int kn = kc * 4 + ks + 1;
                if (kn < 32) {
#pragma unroll
                    for (int n = 0; n < 4; ++n) { const bf16* wp = WT + (size_t)(16 * n + fr) * 1024 + kn * 32 + g * 8; bh[nb][n] = *(const bf16x8_t*)wp; bl[nb][n] = *(const bf16x8_t*)(wp + 65536); } }
                bf16x8_t ah[2], al[2];
#pragma unroll
                for (int mt = 0; mt < 2; ++mt) { ah[mt] = *(const LAS bf16x8_t*)(hw + (16 * mt + fr) * 272 + ks * 64 + g * 16); al[mt] = *(const LAS bf16x8_t*)(hw + 8704 + (16 * mt + fr) * 272 + ks * 64 + g * 16); }
#pragma unroll
                for (int n = 0; n < 4; ++n) {
#pragma unroll
                    for (int mt = 0; mt < 2; ++mt) { acc[mt][n] = __builtin_amdgcn_mfma_f32_16x16x32_bf16(ah[mt], bh[cb][n], acc[mt][n], 0, 0, 0);
                        acc[mt][n] = __builtin_amdgcn_mfma_f32_16x16x32_bf16(al[mt], bh[cb][n], acc[mt][n], 0, 0, 0); acc[mt][n] = __builtin_amdgcn_mfma_f32_16x16x32_bf16(ah[mt], bl[cb][n], acc[mt][n], 0, 0, 0); } }
            }
            asm volatile("s_waitcnt lgkmcnt(0)" ::: "memory");
        }
        { LAS float* lg = (LAS float*)hw;
#pragma unroll
          for (int mt = 0; mt < 2; ++mt)
#pragma unroll
              for (int n = 0; n < 4; ++n)
#pragma unroll
                  for (int r = 0; r < 4; ++r) lg[(16 * mt + 4 * g + r) * 65 + 16 * n + fr] = acc[mt][n][r]; }
        asm volatile("s_waitcnt lgkmcnt(0)" ::: "memory");
        if (lane < 32) {
            const LAS float* lg = (const LAS float*)hw + lane * 65; const int m = m0 + lane;
            float bsc[64];
#pragma unroll
            for (int e2 = 0; e2 < 64; ++e2) bsc[e2] = 1.0f / (1.0f + expf(-lg[e2])) + rbs[e2];
            float gs[8];
#pragma unroll
            for (int gi = 0; gi < 8; ++gi) { float m1 = -INFINITY, m2 = -INFINITY;
#pragma unroll
                for (int j = 0; j < 8; ++j) { const float v = bsc[8 * gi + j]; m2 = fmaxf(m2, fminf(m1, v)); m1 = fmaxf(m1, v); }
                gs[gi] = m1 + m2; }
            unsigned selmask = 0;
#pragma unroll
            for (int gi = 0; gi < 8; ++gi) { int rank = 0;
#pragma unroll
                for (int gj = 0; gj < 8; ++gj) rank += (gs[gj] > gs[gi] || (gs[gj] == gs[gi] && gj < gi)) ? 1 : 0;
                selmask |= (rank < 4) ? (1u << gi) : 0u; }
            float tv[8]; int te[8];
#pragma unroll
            for (int i = 0; i < 8; ++i) { tv[i] = -INFINITY; te[i] = 0; }
#pragma unroll
            for (int e2 = 0; e2 < 64; ++e2) { float v = ((selmask >> (e2 >> 3)) & 1u) ? bsc[e2] : -INFINITY; int id = e2;
#pragma unroll
                for (int i = 0; i < 8; ++i) { const bool sw = v > tv[i]; const float tvv = tv[i]; const int tee = te[i]; tv[i] = sw ? v : tvv; te[i] = sw ? id : tee; v = sw ? tvv : v; id = sw ? tee : id; } }
            float sc[8], ssum = 0.f;
#pragma unroll
            for (int i = 0; i < 8; ++i) { sc[i] = tv[i] - rbs[te[i]]; ssum += sc[i]; }
            const float scale = ROUTED_SCALE / ssum;
#pragma unroll
            for (int i = 0; i < 8; ++i) { eidx[(size_t)m * 8 + i] = te[i]; gwp[(size_t)m * 8 + i] = sc[i] * scale; lpos[(size_t)m * 8 + i] = atomicAdd((int*)&hist[te[i]], 1); }
        }
        __syncthreads();
        if (tid < 64) wgbase[tile * 64 + tid] = (int)atomicAdd(&gcnt[half * 64 + tid], (unsigned)hist[tid]);
    }
}
__device__ __forceinline__ void load_pstart(const Args& a, LAS int* ps) {
    const unsigned* gcnt = (const unsigned*)(a.ws + WS_CTL) + CW_GCNT;
    __syncthreads();
    const int tid = tidx_(a.wv);
    if (tid < 128) {
        const int hf = tid >> 6, e = tid & 63; const int c = (int)__hip_atomic_load(gcnt + tid, __ATOMIC_RELAXED, __HIP_MEMORY_SCOPE_AGENT);
        const int p = (c + 255) / 256 * 256; int inc = p;
#pragma unroll
        for (int d = 1; d < 64; d <<= 1) { const int o = __shfl_up(inc, d, 64); if (e >= d) inc += o; }
        ps[hf * 65 + e] = inc - p; if (e == 63) ps[hf * 65 + 64] = inc;
    }
    __syncthreads();
}
__device__ __forceinline__ void p_slots(const Args& a, LAS unsigned char* lds) {
    unsigned char* ws = a.ws; LAS int* ps = (LAS int*)lds; load_pstart(a, ps);
    const int* eidx = (const int*)(ws + WS_EIDX); const float* gwp = (const float*)(ws + WS_GW); const int* lpos = (const int*)(ws + WS_LPOS); const int* wgbase = (const int*)(ws + WS_WGBASE);
    int* slotof = (int*)(ws + WS_SLOTOF); int* tokslot = (int*)(ws + WS_TOKSLOT); float* wslot = (float*)(ws + WS_WSLOT);
    for (int tile = blockIdx.x; tile < T / 256; tile += gridDim.x) {
        const int half = tile / (T / 512);
        for (int i = tidx_(a.wv); i < 256 * 8; i += 512) { const size_t idx = (size_t)tile * 2048 + i; const int e = eidx[idx];
            const int slot = ps[half * 65 + e] + wgbase[tile * 64 + e] + lpos[idx];
            slotof[idx] = slot; tokslot[(size_t)half * NSLOTMAX + slot] = (int)(idx >> 3); wslot[(size_t)half * NSLOTMAX + slot] = gwp[idx]; }
    }
}
template <bool DOWN>
__device__ __forceinline__ void f_moe_gemm(const Args& a, LAS unsigned char* lds, int half) {
    unsigned char* ws = a.ws; LAS int* ps = (LAS int*)(lds + 131072); LAS int* te = (LAS int*)(lds + 131072 + 1024); load_pstart(a, ps);
    const int nrt = __builtin_amdgcn_readfirstlane(ps[half * 65 + 64] / 256);
    for (int rt = tidx_(a.wv); rt < nrt; rt += 512) { int e = 0; for (int j = 1; j < 64; ++j) if (ps[half * 65 + j] <= rt * 256) e = j; te[rt] = e; }
    __syncthreads();
    pg8::GroupedOrder S; S.te = te; S.nct = DOWN ? 4 : 2; S.nrt = nrt; S.nwg1 = nrt * S.nct; S.nwg2 = (HALF_T / 256) * S.nct; S.G = gridDim.x; S.c = blockIdx.x;
    S.idx = (const int*)(ws + WS_TOKSLOT) + (size_t)half * NSLOTMAX; S.ident = (const int*)(ws + WS_IDENT) + half * HALF_T;
    if (!DOWN) { S.K = 512; S.A = (const char*)(ws + WS_H8); S.Bt = (const char*)(ws + WS_WGU); S.Bsh = (const char*)(ws + WS_WSGU); S.estride = (size_t)512 * 1024; S.gather = true;
        const EpiGU eg{(unsigned char*)(ws + WS_HH)}; pg8::gemm_phase2<true, false, true>(lds, a.wv, 512, S, eg, eg); }
    else { S.K = 128; S.A = (const char*)(ws + WS_HH); S.Bt = (const char*)(ws + WS_WD); S.Bsh = (const char*)(ws + WS_WSD); S.estride = (size_t)1024 * 256; S.gather = false;
        pg8::GroupedOrder S1 = S; S1.nwg2 = 0; const EpiDown ed{(unsigned char*)(ws + WS_YH), (const float*)(ws + WS_WSLOT) + (size_t)half * NSLOTMAX};
        pg8::gemm_phase2<false, false, true, true>(lds, a.wv, 128, S1, ed, ed);
        pg8::GroupedOrder S2 = S; S2.nwg1 = 0; const EpiSD2 es{ws, half * HALF_T};
        pg8::gemm_phase2<false, false, true, true>(lds, a.wv, 128, S2, es, es); }
}
__device__ __forceinline__ void p_combine(const Args& a, int half) {
    unsigned char* ws = a.ws; const int lane = tidx_(a.wv) & 63, gw = blockIdx.x * 8 + (tidx_(a.wv) >> 6), NGW = gridDim.x * 8;
    const unsigned char* Y = (const unsigned char*)(ws + WS_YH); const int* slotof = (const int*)(ws + WS_SLOTOF);
    const f32x4* gp = (const f32x4*)a.in[25] + lane; const f32x4* bp = (const f32x4*)a.in[26] + lane; const f32x4* g1p = (const f32x4*)a.in[15] + lane; const f32x4* b1p = (const f32x4*)a.in[16] + lane;
    for (int mm = gw; mm < HALF_T; mm += 2 * NGW) {
        int sl[2][8]; u32x2 rw[2][4], zw[2][4]; f32x2_t st1[2]; unsigned yw[2][8][4];
#pragma unroll
        for (int t = 0; t < 2; ++t) { const int m = half * HALF_T + ((t == 1 && mm + NGW >= HALF_T) ? mm : mm + t * NGW);
#pragma unroll
            for (int k = 0; k < 8; ++k) sl[t][k] = slotof[(size_t)m * 8 + k]; }
#pragma unroll
        for (int t = 0; t < 2; ++t) { const int m = half * HALF_T + ((t == 1 && mm + NGW >= HALF_T) ? mm : mm + t * NGW);
            const u32x2* rb16 = (const u32x2*)((const bf16*)(ws + WS_H0) + (size_t)m * D) + lane; const u32x2* zb16 = (const u32x2*)((const bf16*)(ws + WS_Z) + (size_t)m * D) + lane;
            st1[t] = *(const f32x2_t*)((const float*)(ws + WS_LNST1) + 2 * (size_t)m);
#pragma unroll
            for (int j = 0; j < 4; ++j) { rw[t][j] = rb16[64 * j]; zw[t][j] = zb16[64 * j]; } }
#pragma unroll
        for (int t = 0; t < 2; ++t)
#pragma unroll
            for (int k = 0; k < 8; ++k) { const unsigned* yr = (const unsigned*)(Y + (size_t)sl[t][k] * D) + lane;
#pragma unroll
                for (int j = 0; j < 4; ++j) yw[t][k][j] = yr[64 * j]; }
#pragma unroll
        for (int t = 0; t < 2; ++t) { const int m = half * HALF_T + ((t == 1 && mm + NGW >= HALF_T) ? mm : mm + t * NGW);
            f32x4* rr = (f32x4*)(a.out + (size_t)m * D) + lane;
            f32x4 v[4];
#pragma unroll
            for (int j = 0; j < 4; ++j) { const u32x2 r2 = rw[t][j], z2 = zw[t][j];
                const f32x4 zz = {bf2f(z2.x & 0xffffu), bf2f(z2.x >> 16), bf2f(z2.y & 0xffffu), bf2f(z2.y >> 16)};
                v[j] = ((zz - st1[t].x) * st1[t].y * g1p[64 * j] + b1p[64 * j]) * DN_ALPHA + (f32x4){bf2f(r2.x & 0xffffu), bf2f(r2.x >> 16), bf2f(r2.y & 0xffffu), bf2f(r2.y >> 16)}; }
            f32x4 ys[4];
#pragma unroll
            for (int j = 0; j < 4; ++j) ys[j] = (f32x4){0.f, 0.f, 0.f, 0.f};
#pragma unroll
            for (int k = 0; k < 8; ++k)
#pragma unroll
                for (int j = 0; j < 4; ++j) { const int w = (int)yw[t][k][j]; const f32x2_t lo = __builtin_amdgcn_cvt_pk_f32_fp8(w, false), hi = __builtin_amdgcn_cvt_pk_f32_fp8(w, true);
                    ys[j].x += lo.x; ys[j].y += lo.y; ys[j].z += hi.x; ys[j].w += hi.y; }
#pragma unroll
            for (int j = 0; j < 4; ++j) v[j] = v[j] + ys[j] * 0.03125f;
            float s = 0.f;
#pragma unroll
            for (int j = 0; j < 4; ++j) s += (v[j].x + v[j].y) + (v[j].z + v[j].w);
            const float mean = wave_sum(s) * (1.f / D); float s2 = 0.f;
#pragma unroll
            for (int j = 0; j < 4; ++j) { v[j] = v[j] - mean; s2 += (v[j].x * v[j].x + v[j].y * v[j].y) + (v[j].z * v[j].z + v[j].w * v[j].w); }
            const float rstd = 1.f / sqrtf(wave_sum(s2) * (1.f / D) + EPS);
            if (t == 0 || mm + NGW < HALF_T) {
#pragma unroll
                for (int j = 0; j < 4; ++j) rr[64 * j] = v[j] * rstd * gp[64 * j] + bp[64 * j]; }
        }
    }
}

__global__ void __launch_bounds__(512, 2) fwd(const KArgs ka) {
    extern __shared__ __attribute__((aligned(16))) unsigned char lds_raw[];
    LAS unsigned char* lds = (LAS unsigned char*)lds_raw;
    const Args a{ka.in, ka.out, ka.ws, __builtin_amdgcn_readfirstlane((int)threadIdx.x >> 6)};
    unsigned char* ws = a.ws;
    const int lo = ka.ph_lo, hi = ka.ph_hi;
    volatile LAS unsigned* bst = (volatile LAS unsigned*)(lds + LDS_BYTES - 16);
    const bool lead = tidx_(a.wv) == 0;
    if (lead) { bst[0] = 0u; bst[1] = 0u; }
    __syncthreads();
    XcdBarrier bar = xcd_barrier_post((unsigned*)(ws + WS_CTL) + CW_BAR, bst, lead);
#ifndef PH_MASK
#define PH_MASK 0xFFFFFFFFu
#endif
#define IN(k) ((((PH_MASK) >> (k)) & 1u) && lo <= (k) && (k) < hi)
#ifdef PROBE_MASK
    long long pt_ = 0;
#define PT0(k) do { if (((PROBE_MASK) >> (k)) & 1u) pt_ = (long long)__builtin_amdgcn_s_memrealtime(); } while (0)
#define PT1(k) do { if (((PROBE_MASK) >> (k)) & 1u) { __syncthreads(); const long long t1_ = (long long)__builtin_amdgcn_s_memrealtime(); while ((long long)__builtin_amdgcn_s_memrealtime() - t1_ < 3 * (t1_ - pt_)) __builtin_amdgcn_s_sleep(8); } } while (0)
#else
#define PT0(k) do {} while (0)
#define PT1(k) do {} while (0)
#endif
#define SEAM(k) do { if (IN(k) && IN((k) + 1)) xcd_barrier(bar); } while (0)
    if (IN(0)) p0_prologue(a, lds);
    SEAM(0);
    if (IN(1)) { for (int u = blockIdx.x; u < 32; u += gridDim.x) s0_mlstm_gates(a, lds, u >> 2, u & 3); }
PT0(1); if (IN(1)) fgemm_dense(lds, a.wv, (const bf16*)(ws + WS_H0), (const bf16*)(ws + WS_WINT), T, 7168, 1024, EpiA{ws, (unsigned char*)a.out, a.in[5]}); PT1(1);
    SEAM(1);
PT0(2); if (IN(2)) s0_prepass(a, lds); PT1(2);
    SEAM(2);
    if (IN(3)) { for (int u = blockIdx.x; u < 256; u += gridDim.x) { const int x = u & 7, y = u >> 3; if (y < 16) { const int pi = x * 8 + (y >> 1); fscan3_hgrn(a, lds, pi >> 3, pi & 7, y & 1); } } }
    asm volatile("" ::: "memory");
    if (IN(3)) { for (int u = blockIdx.x; u < 256; u += gridDim.x) { const int x = u & 7, y = u >> 3; if (y >= 16) { const int qi = x * 4 + ((y - 16) >> 2); fscan3_mlstm(a, lds, qi >> 2, qi & 3, (y - 16) & 3); } } }
    if (IN(3) && IN(5)) xcd_barrier(bar);
PT0(5); if (IN(5)) fgemm_dense(lds, a.wv, (const bf16*)(ws + WS_H0), (const bf16*)(ws + WS_WINT) + (size_t)7168 * 1024, T, 2048, 1024, EpiB{ws, a.in[6], a.in[11]}); PT1(5);
    SEAM(5);
PT0(6); if (IN(6)) fgemm_paired(lds, a.wv, (const bf16*)(ws + WS_LFA), (const bf16*)(ws + WS_WAT), (const bf16*)(ws + WS_QKB), (const bf16*)(ws + WS_WBT), T, 1024, 1024, EpiC{ws, (const bf16*)a.out, (const bf16*)a.out + (size_t)T * D}); PT1(6);
    SEAM(6);
PT0(7); if (IN(7)) fgemm_dense(lds, a.wv, (const bf16*)(ws + WS_IA), (const bf16*)(ws + WS_WOT), T, 1024, 1024, EpiD{ws}); PT1(7);
    SEAM(7);
PT0(8); if (IN(8)) p_ln1_route(a, lds); PT1(8);
    SEAM(8);
    if (IN(9)) p_slots(a, lds);
    SEAM(9);
PT0(10); if (IN(10)) f_moe_gemm<false>(a, lds, 0); PT1(10);
    SEAM(10);
PT0(11); if (IN(11)) f_moe_gemm<true>(a, lds, 0); PT1(11);
    SEAM(11);
PT0(12); if (IN(12)) p_combine(a, 0); PT1(12);
    __syncthreads();
PT0(13); if (IN(13)) f_moe_gemm<false>(a, lds, 1); PT1(13);
    SEAM(13);
PT0(14); if (IN(14)) f_moe_gemm<true>(a, lds, 1); PT1(14);
    SEAM(14);
PT0(15); if (IN(15)) p_combine(a, 1); PT1(15);
#undef IN
#undef SEAM
}

extern "C" void kernel_launch(void* const* d_in, const int* in_sizes, int n_in, void* d_out, int out_size, void* d_ws, size_t ws_size, hipStream_t stream) {
    static int grid = 0;
    if (grid == 0) {
        if (n_in != 27 || out_size != T * D || ws_size < WS_END) { fprintf(stderr, "kernel_launch: unexpected shapes (n_in %d out %d ws %zu)\n", n_in, out_size, ws_size); grid = -1; return; }
        int dev = 0, cus = 0;
        if (hipGetDevice(&dev) != hipSuccess || hipDeviceGetAttribute(&cus, hipDeviceAttributeMultiprocessorCount, dev) != hipSuccess) { grid = -1; return; }
        if (hipFuncSetAttribute((const void*)fwd, hipFuncAttributeMaxDynamicSharedMemorySize, LDS_BYTES) != hipSuccess) { grid = -1; return; }
        int per_cu = 0; (void)hipOccupancyMaxActiveBlocksPerMultiprocessor(&per_cu, (const void*)fwd, 512, LDS_BYTES); (void)hipGetLastError();
        grid = cus;
    }
    if (grid < 0) return;
    (void)hipMemsetAsync((char*)d_ws + WS_CTL + CW_BAR * 4, 0, (CW_GCNT + 128 - CW_BAR) * 4, stream);
    KArgs a{};
    for (int i = 0; i < 27; ++i) a.in[i] = (const float*)d_in[i];
    a.out = (float*)d_out; a.ws = (unsigned char*)d_ws;
    a.ph_lo = 0; a.ph_hi = 16; hipLaunchKernelGGL(fwd, dim3(grid), dim3(512), LDS_BYTES, stream, a);
}
```

```cpp
#include <hip/hip_runtime.h>
#include <stdint.h>
#include <stdio.h>
#include <type_traits>

#define LAS __attribute__((address_space(3)))
typedef unsigned short bf16;
typedef float f32x4 __attribute__((ext_vector_type(4)));
typedef unsigned u32x4 __attribute__((ext_vector_type(4)));
typedef unsigned u32x2 __attribute__((ext_vector_type(2)));

constexpr int D = 1024, NB = 8, SEQ = 8192, T = NB * SEQ, NMETA = 16, INW = 9224;
constexpr int NEXP = 64, TOPK = 8, DEXP = 256;
constexpr float EPS = 1e-5f, DN_ALPHA = 1.189207115002721f, ROUTED_SCALE = 2.5f;
constexpr int HALF_T = T / 2;
constexpr int NSLOTMAX = HALF_T * TOPK + NEXP * 256;

constexpr size_t MiB = 1u << 20;
constexpr size_t WS_CTL = 0, CTL_ZERO_BYTES = 1 * MiB;
constexpr size_t WS_WINT = 1 * MiB;
constexpr size_t WS_WAT = 19 * MiB, WS_WBT = 21 * MiB, WS_WOT = 23 * MiB;
constexpr size_t WS_WSGU = 25 * MiB;
constexpr size_t WS_WSD = 26 * MiB;
constexpr size_t WS_META = 27 * MiB;
constexpr size_t WS_WRT = 27 * MiB + 512 * 1024;
constexpr size_t WS_IGFG = 28 * MiB;
constexpr size_t WS_LNST0 = 30 * MiB;
constexpr size_t WS_LNST1 = 30 * MiB + 512 * 1024;
constexpr size_t WS_STA = 31 * MiB;
constexpr size_t WS_STB = 33 * MiB;
constexpr size_t WS_EIDX = 35 * MiB, WS_GW = 37 * MiB, WS_LPOS = 39 * MiB, WS_SLOTOF = 41 * MiB;
constexpr size_t WS_TOKSLOT = 43 * MiB;
constexpr size_t WS_WSLOT = 46 * MiB;
constexpr size_t WS_WGBASE = 49 * MiB;
constexpr size_t WS_IDENT = 49 * MiB + 128 * 1024;
constexpr size_t WS_EM = 50 * MiB, WS_EL = 54 * MiB;
constexpr size_t WS_HALO = 58 * MiB;
constexpr size_t WS_GATES = 932 * MiB;
constexpr size_t WS_SMETA = 940 * MiB;
constexpr size_t WS_CMETA = 941 * MiB;
constexpr size_t WS_NMETA = 942 * MiB;
constexpr size_t WS_STA2 = 944 * MiB;
constexpr size_t WS_STB2 = 948 * MiB;
constexpr size_t WS_WGU = 64 * MiB;
constexpr size_t WS_WD = 128 * MiB;
constexpr size_t WS_H0 = 162 * MiB;
constexpr size_t WS_QA = 290 * MiB, WS_LFA = 418 * MiB, WS_IA = 546 * MiB, WS_QKB = 674 * MiB, WS_VB = 802 * MiB;
constexpr size_t WS_HH = 290 * MiB;
constexpr size_t WS_YH = 444 * MiB;
constexpr size_t WS_HS = 980 * MiB;
constexpr size_t WS_Z = 720 * MiB;
constexpr size_t WS_H8 = 850 * MiB;
constexpr size_t WS_END = 1024 * MiB;
static_assert(WS_HH + (size_t)(NSLOTMAX + HALF_T) * 512 <= WS_YH && WS_YH + (size_t)NSLOTMAX * 1024 <= WS_Z && WS_Z + (size_t)T * D * 2 <= WS_GATES, "moe map");
constexpr int CW_BAR = 4096, CW_GCNT = 8192;

constexpr int LDS_BYTES = 147456;
constexpr int NPHASE = 20;

__device__ __forceinline__ unsigned f2bf(float f) { unsigned u = __float_as_uint(f); return (u + 0x7fffu + ((u >> 16) & 1u)) >> 16; }
__device__ __forceinline__ float bf2f(unsigned h) { return __uint_as_float(h << 16); }
typedef __bf16 hwbf16x2_t __attribute__((ext_vector_type(2)));
typedef float f32x2_t __attribute__((ext_vector_type(2)));
__device__ __forceinline__ unsigned pk2(float lo, float hi) { const f32x2_t f = {lo, hi}; const hwbf16x2_t b = __builtin_convertvector(f, hwbf16x2_t); return __builtin_bit_cast(unsigned, b); }
__device__ __forceinline__ unsigned f2h(float f) { _Float16 h = (_Float16)f; return (unsigned)__builtin_bit_cast(unsigned short, h); }
__device__ __forceinline__ float h2f(unsigned u) { return (float)__builtin_bit_cast(_Float16, (unsigned short)u); }
#define DPPF(v, ctrl) __builtin_bit_cast(float, __builtin_amdgcn_update_dpp(0, __builtin_bit_cast(int, (v)), (ctrl), 0xf, 0xf, true))
__device__ __forceinline__ float rl_(float v, const int l) { return __builtin_bit_cast(float, __builtin_amdgcn_readlane(__builtin_bit_cast(int, v), l)); }
__device__ __forceinline__ float wave_sum(float v) {
    v += DPPF(v, 0xB1); v += DPPF(v, 0x4E); v += DPPF(v, 0x141); v += DPPF(v, 0x140);
    return (rl_(v, 0) + rl_(v, 16)) + (rl_(v, 32) + rl_(v, 48));
}
__device__ __forceinline__ void store8_bf16(bf16* p, const float (&v)[8]);
__device__ __forceinline__ float sigmoidf_(float x) { return __builtin_amdgcn_rcpf(1.0f + __expf(-x)); }
__device__ __forceinline__ float siluf_(float x) { return x * __builtin_amdgcn_rcpf(1.0f + __expf(-x)); }


#define XB_TMO      128
#define XB_XCNT(j)  (256  + 64 * (j))
#define XB_XSUB(j)  (1280 + 64 * (j))
#define XB_XGEN(j)  (2304 + 64 * (j))
#define XB_TOP      3328
#define XB_TOPGEN   3392
#define XCD_BAR_WORDS 3456
#define XB_SPIN_CAP (1u << 20)
__device__ __forceinline__ unsigned xb_ld(unsigned* p)              { return __hip_atomic_load(p, __ATOMIC_RELAXED, __HIP_MEMORY_SCOPE_AGENT); }
__device__ __forceinline__ unsigned xb_add(unsigned* p, unsigned v) { return __hip_atomic_fetch_add(p, v, __ATOMIC_RELAXED, __HIP_MEMORY_SCOPE_AGENT); }
__device__ __forceinline__ unsigned xb_xcc_id() { return (unsigned)__builtin_amdgcn_s_getreg((3 << 11) | 20) & 0xFu; }
#define XB_SPIN(cond, bar) do { unsigned _sp = 0; while (cond) { __builtin_amdgcn_s_sleep(1); \
    if ((++_sp & 255u) == 0u) { if (xb_ld(&(bar)[XB_TMO])) break; if (_sp > XB_SPIN_CAP) { atomicAdd(&(bar)[XB_TMO], 1u); break; } } } } while (0)
struct XcdBarrier { unsigned* bar; unsigned x; volatile LAS unsigned* st; bool lead; };
__device__ __forceinline__ XcdBarrier xcd_barrier_post(unsigned* bar, volatile LAS unsigned* st, bool lead) {
    XcdBarrier b; b.bar = bar; b.x = xb_xcc_id(); b.st = st; b.lead = lead;
    if (lead) (void)xb_add(&bar[XB_XCNT(b.x)], 1u);
    return b;
}
__device__ __forceinline__ void xcd_barrier_complete(unsigned* bar, unsigned x, unsigned& nloc, unsigned& nx) {
    const unsigned G = gridDim.x * gridDim.y * gridDim.z;
    unsigned sum, cnt, mine, sp = 0u;
    for (;;) {
        sum = 0u; cnt = 0u; mine = 0u;
#pragma unroll
        for (unsigned j = 0; j < 16; ++j) { const unsigned c = xb_ld(&bar[XB_XCNT(j)]); sum += c; cnt += (c > 0u) ? 1u : 0u; mine = (j == x) ? c : mine; }
        if (sum == G) break;
        __builtin_amdgcn_s_sleep(1);
        if ((++sp & 255u) == 0u) { if (xb_ld(&bar[XB_TMO])) break; if (sp > XB_SPIN_CAP) { atomicAdd(&bar[XB_TMO], 1u); break; } }
    }
    nloc = mine > 0u ? mine : 1u; nx = cnt > 0u ? cnt : 1u;
}
__device__ __forceinline__ void xcd_barrier(const XcdBarrier& b) {
    asm volatile("s_waitcnt vmcnt(0)" ::: "memory");
    __syncthreads();
    if (b.lead) {
        unsigned* bar = b.bar;
        __builtin_amdgcn_s_waitcnt(0);
        unsigned nloc = b.st[0], nx = b.st[1];
        if (nloc == 0u) { xcd_barrier_complete(bar, b.x, nloc, nx); b.st[0] = nloc; b.st[1] = nx; }
        const unsigned old = xb_add(&bar[XB_XSUB(b.x)], 1u);
        const unsigned gen = old / nloc;
        if (old + 1u == (gen + 1u) * nloc) {
            __builtin_amdgcn_fence(__ATOMIC_RELEASE, "agent");
            asm volatile("s_waitcnt vmcnt(0)" ::: "memory");
            const unsigned og = xb_add(&bar[XB_TOP], 1u);
            const unsigned tg = og / nx;
            if (og + 1u == (tg + 1u) * nx) xb_add(&bar[XB_TOPGEN], 1u);
            else XB_SPIN(xb_ld(&bar[XB_TOPGEN]) == tg, bar);
            __builtin_amdgcn_fence(__ATOMIC_ACQUIRE, "agent");
            xb_add(&bar[XB_XGEN(b.x)], 1u);
            asm volatile("s_waitcnt vmcnt(0)" ::: "memory");
        } else {
            XB_SPIN(xb_ld(&bar[XB_XGEN(b.x)]) == gen, bar);
            __builtin_amdgcn_fence(__ATOMIC_ACQUIRE, "agent");
            asm volatile("s_waitcnt vmcnt(0)" ::: "memory");
        }
    }
    __syncthreads();
}

struct KArgs { const float* in[27]; float* out; unsigned char* ws; int ph_lo, ph_hi; };
struct Args { const float* const (&in)[27]; float* out; unsigned char* ws; int wv; };
__device__ __forceinline__ int tidx_(int wv) { unsigned z; asm volatile("s_mov_b32 %0, 0" : "=s"(z)); return wv * 64 + (int)__builtin_amdgcn_mbcnt_hi(~0u, __builtin_amdgcn_mbcnt_lo(~0u, z)); }

struct TrDesc { const float* W; bf16* WT; int ldw, K, nblk, item, mode, f8; };
__device__ __forceinline__ void tr_load(const TrDesc& d, f32x4 (&t)[8], int lane) {
    const int kb = d.item / d.nblk, nb = d.item % d.nblk, k0 = 64 * kb, n0 = 32 * nb;
#pragma unroll
    for (int i = 0; i < 8; ++i) t[i] = *(const f32x4*)(d.W + (size_t)(k0 + 8 * i + (lane >> 3)) * d.ldw + n0 + 4 * (lane & 7));
}
__device__ __forceinline__ void tr_store(const TrDesc& d, const f32x4 (&t)[8], LAS float* scr, int lane) {
    const int kb = d.item / d.nblk, nb = d.item % d.nblk, k0 = 64 * kb, n0 = 32 * nb;
#pragma unroll
    for (int i = 0; i < 8; ++i) { LAS float* p = scr + (8 * i + (lane >> 3)) * 33 + 4 * (lane & 7); p[0] = t[i].x; p[1] = t[i].y; p[2] = t[i].z; p[3] = t[i].w; }
    asm volatile("s_waitcnt lgkmcnt(0)" ::: "memory");
    const int c = lane & 7;
#pragma unroll
    for (int j = 0; j < 4; ++j) { const int n = (lane >> 3) + 8 * j; const LAS float* s = scr + (8 * c) * 33 + n;
        u32x4 o; o.x = pk2(s[0 * 33], s[1 * 33]); o.y = pk2(s[2 * 33], s[3 * 33]); o.z = pk2(s[4 * 33], s[5 * 33]); o.w = pk2(s[6 * 33], s[7 * 33]);
        const int nn = n0 + n, row = d.mode == 0 ? nn : (nn >> 7) * 256 + (d.mode - 1) * 128 + (nn & 127);
        if (d.f8) {
            int w0 = __builtin_amdgcn_cvt_pk_fp8_f32(64.f * s[0 * 33], 64.f * s[1 * 33], 0, false); w0 = __builtin_amdgcn_cvt_pk_fp8_f32(64.f * s[2 * 33], 64.f * s[3 * 33], w0, true);
            int w1 = __builtin_amdgcn_cvt_pk_fp8_f32(64.f * s[4 * 33], 64.f * s[5 * 33], 0, false); w1 = __builtin_amdgcn_cvt_pk_fp8_f32(64.f * s[6 * 33], 64.f * s[7 * 33], w1, true);
            *(u32x2*)((unsigned char*)d.WT + (size_t)row * d.K + k0 + 8 * c) = (u32x2){(unsigned)w0, (unsigned)w1}; }
        else *(u32x4*)(d.WT + (size_t)row * d.K + k0 + 8 * c) = o; }
    asm volatile("s_waitcnt lgkmcnt(0)" ::: "memory");
}
__device__ __forceinline__ int win_src_off(int g) {
    switch (g) { case 0: return 0; case 1: return 1024; case 2: return 2048; case 3: return 4096; case 4: return 5120; case 5: return 7176; case 6: return 8200; case 7: return 3072; default: return 6144; }
}

__device__ __forceinline__ void p0_prologue(const Args& a, LAS unsigned char* lds) {
    const int tid = threadIdx.x, lane = tid & 63, wave = tid >> 6;
    unsigned char* ws = a.ws;
    const int gw = blockIdx.x * 8 + wave, NGW = gridDim.x * 8;
    {
        LAS float* scr = (LAS float*)(lds + 32768 + wave * 8704);
        constexpr int NA = 12 * 512, NBt = 130 * 128, NC = 65 * 128, NTOT = NA + NBt + NC;
        auto decode = [&](int it) -> TrDesc { TrDesc d; d.f8 = 0;
            if (it < NA) { const int job = it / 512; d.item = it % 512; d.ldw = job < 9 ? INW : 1024; d.K = 1024; d.nblk = 32; d.mode = 0;
                if (job < 9) { d.W = a.in[4] + win_src_off(job); d.WT = (bf16*)(ws + WS_WINT) + (size_t)job * 1024 * 1024;
                    if (job == 5 || job == 6) { d.mode = job - 4; d.WT = (bf16*)(ws + WS_WINT) + (size_t)5 * 1024 * 1024; } }
                else { d.W = a.in[12 + (job - 9)]; d.WT = (bf16*)(ws + (job == 9 ? WS_WAT : job == 10 ? WS_WBT : WS_WOT)); } }
            else if (it < NA + NBt) { const int r = it - NA, job = r / 128; d.item = r % 128; d.ldw = 256; d.K = 1024; d.nblk = 8;
                d.f8 = 1;
                if (job < 128) { const int e = job & 63, up = job >> 6; d.mode = 1 + up; d.W = a.in[19 + up] + (size_t)e * 1024 * 256; d.WT = (bf16*)(ws + WS_WGU + (size_t)e * 512 * 1024); }
                else { const int up = job - 128; d.mode = 1 + up; d.W = a.in[22 + up]; d.WT = (bf16*)(ws + WS_WSGU); } }
            else { const int r = it - NA - NBt, job = r / 128; d.item = r % 128; d.ldw = 1024; d.K = 256; d.nblk = 32; d.mode = 0; d.f8 = 1;
                if (job < 64) { d.W = a.in[21] + (size_t)job * 256 * 1024; d.WT = (bf16*)(ws + WS_WD + (size_t)job * 1024 * 256); }
                else { d.W = a.in[24]; d.WT = (bf16*)(ws + WS_WSD); } }
            return d; };
        if (gw < NTOT) {
            TrDesc d0 = decode(gw); f32x4 t0[8]; tr_load(d0, t0, lane);
            for (int it = gw; it < NTOT; it += NGW) {
                TrDesc d1 = d0; f32x4 t1[8]; const bool more = it + NGW < NTOT;
                if (more) { d1 = decode(it + NGW); tr_load(d1, t1, lane); }
                tr_store(d0, t0, scr, lane);
                if (more) { d0 = d1;
#pragma unroll
                    for (int i = 0; i < 8; ++i) t0[i] = t1[i]; }
            }
        }
    }
    __syncthreads();
    LAS float* Wg8 = (LAS float*)lds;
    for (int i = tid; i < 1024 * 8; i += 512) Wg8[i] = a.in[4][(size_t)(i >> 3) * INW + 7168 + (i & 7)];
    __syncthreads();
    {
        const float* x = a.in[0]; const f32x4* gp = (const f32x4*)a.in[2] + lane; const f32x4* bp = (const f32x4*)a.in[3] + lane;
        f32x4 g[4], b[4];
#pragma unroll
        for (int j = 0; j < 4; ++j) { g[j] = gp[64 * j]; b[j] = bp[64 * j]; }
        bf16* h0 = (bf16*)(ws + WS_H0); float* lnst = (float*)(ws + WS_LNST0); float* igfg = (float*)(ws + WS_IGFG);
        f32x4 vn[2][4];
#pragma unroll
        for (int q = 0; q < 2; ++q) if (gw + q * NGW < T) { const f32x4* xr = (const f32x4*)(x + (size_t)(gw + q * NGW) * D) + lane;
#pragma unroll
            for (int j = 0; j < 4; ++j) vn[q][j] = xr[64 * j]; }
#pragma unroll 1
        for (int m = gw; m < T; m += NGW) {
            f32x4 v[4]; float s = 0.f;
#pragma unroll
            for (int j = 0; j < 4; ++j) { v[j] = vn[0][j]; vn[0][j] = vn[1][j]; s += (v[j].x + v[j].y) + (v[j].z + v[j].w); }
            if (m + 2 * NGW < T) { const f32x4* xr = (const f32x4*)(x + (size_t)(m + 2 * NGW) * D) + lane;
#pragma unroll
                for (int j = 0; j < 4; ++j) vn[1][j] = xr[64 * j]; }
            const float mean = wave_sum(s) * (1.f / D); float s2 = 0.f;
#pragma unroll
            for (int j = 0; j < 4; ++j) { v[j] = v[j] - mean; s2 += (v[j].x * v[j].x + v[j].y * v[j].y) + (v[j].z * v[j].z + v[j].w * v[j].w); }
            const float rstd = 1.f / sqrtf(wave_sum(s2) * (1.f / D) + EPS);
            float acc[8];
#pragma unroll
            for (int c = 0; c < 8; ++c) acc[c] = 0.f;
            unsigned long long* o8 = (unsigned long long*)(h0 + (size_t)m * D) + lane;
#pragma unroll
            for (int j = 0; j < 4; ++j) {
                f32x4 h = v[j] * rstd * g[j] + b[j];
                o8[64 * j] = (unsigned long long)pk2(h.x, h.y) | ((unsigned long long)pk2(h.z, h.w) << 32);
#pragma unroll
                for (int i = 0; i < 4; ++i) { const int k = 4 * lane + i + 256 * j; const f32x4 w0 = *(const LAS f32x4*)(Wg8 + k * 8), w1 = *(const LAS f32x4*)(Wg8 + k * 8 + 4);
                    const float hv = h[i];
                    acc[0] += hv * w0.x; acc[1] += hv * w0.y; acc[2] += hv * w0.z; acc[3] += hv * w0.w; acc[4] += hv * w1.x; acc[5] += hv * w1.y; acc[6] += hv * w1.z; acc[7] += hv * w1.w; }
            }
            float r4[4], r2[2], r1;
            { const bool up = lane & 1;
#pragma unroll
              for (int c = 0; c < 4; ++c) { const float send = up ? acc[c] : acc[4 + c], keep = up ? acc[4 + c] : acc[c]; r4[c] = keep + __shfl_xor(send, 1); } }
            { const bool up = lane & 2;
#pragma unroll
              for (int c = 0; c < 2; ++c) { const float send = up ? r4[c] : r4[2 + c], keep = up ? r4[2 + c] : r4[c]; r2[c] = keep + __shfl_xor(send, 2); } }
            { const bool up = lane & 4; const float send = up ? r2[0] : r2[1], keep = up ? r2[1] : r2[0]; r1 = keep + __shfl_xor(send, 4); }
            r1 += __shfl_xor(r1, 8); r1 += __shfl_xor(r1, 16); r1 += __shfl_xor(r1, 32);
            if (lane < 8) igfg[(size_t)m * 8 + 4 * (lane & 1) + 2 * ((lane >> 1) & 1) + ((lane >> 2) & 1)] = r1;
            if (lane == 0) { lnst[2 * m] = mean; lnst[2 * m + 1] = rstd; }
        }
    }
    __syncthreads();
    for (int cgp = blockIdx.x; cgp < 81; cgp += gridDim.x) {
        LAS float* hm = (LAS float*)(lds + 32768);
        LAS float* part = (LAS float*)(lds + 32768 + 65536);
        __syncthreads();
        for (int r = wave * 2; r < wave * 2 + 2; ++r) {
            const f32x4* xr = (const f32x4*)(a.in[1] + (size_t)r * D) + lane; const f32x4* gp = (const f32x4*)a.in[2] + lane; const f32x4* bp = (const f32x4*)a.in[3] + lane;
            f32x4 v[4]; float s = 0.f;
#pragma unroll
            for (int j = 0; j < 4; ++j) { v[j] = xr[64 * j]; s += (v[j].x + v[j].y) + (v[j].z + v[j].w); }
            const float mean = wave_sum(s) * (1.f / D); float s2 = 0.f;
#pragma unroll
            for (int j = 0; j < 4; ++j) { v[j] = v[j] - mean; s2 += (v[j].x * v[j].x + v[j].y * v[j].y) + (v[j].z * v[j].z + v[j].w * v[j].w); }
            const float rstd = 1.f / sqrtf(wave_sum(s2) * (1.f / D) + EPS);
#pragma unroll
            for (int j = 0; j < 4; ++j) { const f32x4 h = v[j] * rstd * gp[64 * j] + bp[64 * j]; *(LAS f32x4*)(hm + r * 1024 + 4 * (lane + 64 * j)) = h; }
        }
        __syncthreads();
        const int c = cgp * 64 + lane;
        const int cc = c < 5128 ? c : 5127, g = cc >> 10, srccol = (cc < 5120) ? win_src_off(g) + (cc & 1023) : 7168 + (cc - 5120);
        float acc[16];
#pragma unroll
        for (int r = 0; r < 16; ++r) acc[r] = 0.f;
        const float* wp = a.in[4] + (size_t)(wave * 128) * INW + srccol;
#pragma unroll 4
        for (int k = 0; k < 128; ++k) { const float w = wp[(size_t)k * INW];
#pragma unroll
            for (int r = 0; r < 16; ++r) acc[r] += hm[r * 1024 + wave * 128 + k] * w; }
#pragma unroll
        for (int r = 0; r < 16; ++r) part[(wave * 16 + r) * 64 + lane] = acc[r];
        __syncthreads();
        if (c < 5128) {
            float* meta = (float*)(ws + WS_META);
            for (int r = wave * 2; r < wave * 2 + 2; ++r) { float v = 0.f;
#pragma unroll
                for (int w8 = 0; w8 < 8; ++w8) v += part[(w8 * 16 + r) * 64 + lane];
                if (c < 5120) { const int c1 = c & 1023;
                    if (g == 1) { const float lb = 1.0f / (1.0f + expf(a.in[5][1024 + c1] - a.in[5][c1])); v = logf(lb + (1.0f - lb) * sigmoidf_(v)); }
                    meta[(size_t)g * 16384 + r * 1024 + c1] = v; }
                else meta[5 * 16384 + r * 8 + (c - 5120)] = v; }
        }
    }
    for (int it = blockIdx.x * 512 + tid; it < 64 * 128; it += gridDim.x * 512) { const int e = it >> 7, k0 = (it & 127) * 8; float hi[8], lo[8];
#pragma unroll
        for (int j = 0; j < 8; ++j) { const float wv = a.in[17][(size_t)(k0 + j) * 64 + e]; const float h = bf2f(f2bf(wv)); hi[j] = h; lo[j] = wv - h; }
        store8_bf16((bf16*)(ws + WS_WRT) + (size_t)e * 1024 + k0, hi); store8_bf16((bf16*)(ws + WS_WRT) + 65536 + (size_t)e * 1024 + k0, lo); }
    {
        int* ts = (int*)(ws + WS_TOKSLOT); float* wsl = (float*)(ws + WS_WSLOT);
        for (int i = blockIdx.x * 512 + tid; i < 2 * NSLOTMAX; i += gridDim.x * 512) { ts[i] = 0; wsl[i] = 0.f; }
        int* ident = (int*)(ws + WS_IDENT);
        for (int i = blockIdx.x * 512 + tid; i < T; i += gridDim.x * 512) ident[i] = i;
    }
}

__device__ __forceinline__ void store8_bf16(bf16* p, const float (&v)[8]) { u32x4 w; w.x = pk2(v[0], v[1]); w.y = pk2(v[2], v[3]); w.z = pk2(v[4], v[5]); w.w = pk2(v[6], v[7]); *(u32x4*)p = w; }
__device__ __forceinline__ void load8_bf16(const bf16* p, float (&v)[8]) { const u32x4 w = *(const u32x4*)p;
    v[0] = bf2f(w.x & 0xffffu); v[1] = bf2f(w.x >> 16); v[2] = bf2f(w.y & 0xffffu); v[3] = bf2f(w.y >> 16); v[4] = bf2f(w.z & 0xffffu); v[5] = bf2f(w.z >> 16); v[6] = bf2f(w.w & 0xffffu); v[7] = bf2f(w.w >> 16); }

struct NoData {};
template <int K> struct KindTag { static constexpr int value = K; };
template <class T, class = void> struct epigroup { static constexpr int value = 4; };
template <class T> struct epigroup<T, typename std::enable_if<(T::GROUP > 0)>::type> { static constexpr int value = T::GROUP; };
template <class T, class = void> struct rowld : std::false_type {};
template <class T> struct rowld<T, typename std::enable_if<T::ROWLD>::type> : std::true_type {};
template <class T, class = void> struct statld : std::false_type {};
template <class T> struct statld<T, typename std::enable_if<T::STATLD>::type> : std::true_type {};
template <class T, int K, class = void> struct pairkind_v : std::false_type {};
template <class T, int K> struct pairkind_v<T, K, typename std::enable_if<T::template pairkind<K>()>::type> : std::true_type {};
template <class T, class = void> struct pairbj : std::false_type {};
template <class T> struct pairbj<T, typename std::enable_if<T::PAIRBJ>::type> : std::true_type {};
__device__ __forceinline__ void unpack8(const u32x4 w, float (&v)[8]) { v[0] = bf2f(w.x & 0xffffu); v[1] = bf2f(w.x >> 16); v[2] = bf2f(w.y & 0xffffu); v[3] = bf2f(w.y >> 16); v[4] = bf2f(w.z & 0xffffu); v[5] = bf2f(w.z >> 16); v[6] = bf2f(w.w & 0xffffu); v[7] = bf2f(w.w >> 16); }
struct EpiA {
    static constexpr bool PIPE = false; static constexpr int NKIND = 4;
    template <int K> static constexpr bool pairkind() { return K == 2; }
    unsigned char* ws; unsigned char* dout; const float* lbl;
    struct Cl { float lb[8]; bf16* base; }; typedef NoData Ld;
    __device__ __forceinline__ int kind(int col0) const { const int g = col0 >> 10; return g == 1 ? 1 : g >= 5 ? 2 : g == 3 ? 3 : 0; }
    template <int K> __device__ __forceinline__ void colload(int col0, Cl& cl) const { const int g = col0 >> 10, c = col0 & 1023;
        if (K == 1) {
#pragma unroll
            for (int j = 0; j < 8; ++j) cl.lb[j] = __builtin_amdgcn_rcpf(1.0f + __expf(lbl[1024 + c + j] - lbl[c + j]));
            cl.base = (bf16*)(ws + WS_LFA) + c; }
        else if (K == 2) cl.base = (bf16*)dout + (size_t)(g - 5) * T * D + c;
        else if (K == 3) cl.base = (bf16*)(ws + WS_QKB) + c;
        else cl.base = (bf16*)(ws + (g == 0 ? WS_QA : g == 2 ? WS_IA : WS_VB)) + c; }
    template <int K> __device__ __forceinline__ void load(int, int, Ld&) const {}
    template <int K> __device__ __forceinline__ void apply_pair(int row, int col0, const float (&ga)[8], const float (&gb)[8]) const {
        const int c = ((col0 - 5120) >> 8) * 128 + (col0 & 127); float r[8], sb[8];
#pragma unroll
        for (int j = 0; j < 8; ++j) { const float ea = __expf(-ga[j]), eb = __expf(-gb[j]); sb[j] = __builtin_amdgcn_rcpf(1.0f + eb); r[j] = (1.0f + eb) * __builtin_amdgcn_rcpf(1.0f + ea); }
        store8_bf16((bf16*)dout + (size_t)row * D + c, r); store8_bf16((bf16*)dout + (size_t)T * D + (size_t)row * D + c, sb); }
    template <int K> __device__ __forceinline__ void apply(int row, int col0, int m, const float (&v)[8], const Ld&, const Cl& cl) const {
        if (K == 1) { float o[8];
#pragma unroll
            for (int j = 0; j < 8; ++j) o[j] = __logf(cl.lb[j] + (1.0f - cl.lb[j]) * sigmoidf_(v[j]));
            u32x4 w; w.x = f2h(o[0]) | (f2h(o[1]) << 16); w.y = f2h(o[2]) | (f2h(o[3]) << 16); w.z = f2h(o[4]) | (f2h(o[5]) << 16); w.w = f2h(o[6]) | (f2h(o[7]) << 16);
            *(u32x4*)(cl.base + (size_t)row * D) = w; }
        else if (K == 2) {}
        else { store8_bf16(cl.base + (size_t)row * D, v);
            if (K == 3 && m == 3) { if ((row & 63) >= 61) store8_bf16((bf16*)(ws + WS_HALO) + ((size_t)(row >> 6) * 3 + ((row & 63) - 61)) * D + (col0 & 1023), v); } }
    }
};
struct EpiB {
    static constexpr bool PIPE = false; static constexpr int NKIND = 2; static constexpr bool STATLD = true;
    unsigned char* ws; const float* hg_g; const float* ml_g;
    struct Cl { float gn[8]; }; struct Ld { u32x4 x; }; struct Rs { float mean, rstd; };
    __device__ __forceinline__ int kind(int col0) const { return col0 >> 10; }
    template <int K> static constexpr bool stat_per_half() { return K == 0; }
    template <int K> __device__ __forceinline__ void colload(int col0, Cl& cl) const { const int c = col0 & 1023; const float* gp = (K == 0 ? hg_g : ml_g) + c;
#pragma unroll
        for (int j = 0; j < 8; ++j) cl.gn[j] = gp[j]; }
    template <int K> __device__ __forceinline__ void rowstat(int row, int col0, Rs& rs) const { const int c = col0 & 1023;
        if (K == 0) { rs.mean = 0.f; const f32x2_t p = *(const f32x2_t*)((const float*)(ws + WS_STA2) + (size_t)row * 16 + (c >> 7) * 2); rs.rstd = __builtin_amdgcn_rsqf((p.x + p.y) * (1.f / 128.f) + EPS); }
        else { const f32x4* st = (const f32x4*)((const float*)(ws + WS_STB2) + ((size_t)row * 16 + (c >> 8) * 4) * 2);
            const f32x4 a0 = st[0], a1 = st[1]; const float s1 = (a0.x + a0.z) + (a1.x + a1.z), s2 = (a0.y + a0.w) + (a1.y + a1.w);
            rs.mean = s1 * (1.f / 256.f); rs.rstd = __builtin_amdgcn_rsqf(fmaxf(s2 * (1.f / 256.f) - rs.mean * rs.mean, 0.f) + EPS); } }
    template <int K> __device__ __forceinline__ void load(int row, int col0, Ld& ld) const { const int c = col0 & 1023;
        ld.x = *(const u32x4*)((const bf16*)(ws + (K == 0 ? WS_IA : WS_VB)) + (size_t)row * D + c); }
    template <int K> __device__ __forceinline__ void apply(int row, int col0, const float (&v)[8], const Ld& ld, const Rs& rs, const Cl& cl) const {
        const int c = col0 & 1023; float x[8], o[8]; unpack8(ld.x, x);
        if (K == 0) {
#pragma unroll
            for (int j = 0; j < 8; ++j) o[j] = x[j] * rs.rstd * cl.gn[j] * siluf_(v[j]);
            store8_bf16((bf16*)(ws + WS_LFA) + (size_t)row * D + c, o);
        } else {
#pragma unroll
            for (int j = 0; j < 8; ++j) o[j] = (x[j] - rs.mean) * rs.rstd * cl.gn[j] * sigmoidf_(v[j]);
            store8_bf16((bf16*)(ws + WS_QKB) + (size_t)row * D + c, o);
        }
    }
};
struct EpiC {
    static constexpr bool PIPE = true; static constexpr int NKIND = 1;
    unsigned char* ws; const bf16* sga; const bf16* sgb;
    typedef NoData Cl; struct Ld { u32x4 a, b; };
    __device__ __forceinline__ int kind(int) const { return 0; }
    template <int K> __device__ __forceinline__ void colload(int, Cl&) const {}
    __device__ __forceinline__ void midload(int row, int col0, Ld& ld) const { ld.a = *(const u32x4*)(sga + (size_t)row * D + col0); }
    __device__ __forceinline__ void mid(float (&v)[8], const Ld& ld) const { float ra[8]; unpack8(ld.a, ra);
#pragma unroll
        for (int j = 0; j < 8; ++j) v[j] *= ra[j]; }
    template <int K> __device__ __forceinline__ void load(int row, int col0, Ld& ld) const { ld.b = *(const u32x4*)(sgb + (size_t)row * D + col0); }
    template <int K> __device__ __forceinline__ void apply(int row, int col0, int, const float (&v)[8], const Ld& ld, const Cl&) const { float sb[8], o[8]; unpack8(ld.b, sb);
#pragma unroll
        for (int j = 0; j < 8; ++j) o[j] = sb[j] * v[j];
        store8_bf16((bf16*)(ws + WS_IA) + (size_t)row * D + col0, o); }
};
struct EpiD {
    static constexpr bool PIPE = true; static constexpr int NKIND = 1;
    unsigned char* ws;
    typedef NoData Cl; struct Ld { u32x4 h; };
    __device__ __forceinline__ int kind(int) const { return 0; }
    template <int K> __device__ __forceinline__ void colload(int, Cl&) const {}
    template <int K> __device__ __forceinline__ void load(int row, int col0, Ld& ld) const { ld.h = *(const u32x4*)((const bf16*)(ws + WS_H0) + (size_t)row * D + col0); }
    template <int K> __device__ __forceinline__ void apply(int row, int col0, int, const float (&v)[8], const Ld& ld, const Cl&) const { float h[8], o[8]; unpack8(ld.h, h);
#pragma unroll
        for (int j = 0; j < 8; ++j) o[j] = DN_ALPHA * h[j] + v[j];
        store8_bf16((bf16*)(ws + WS_Z) + (size_t)row * D + col0, o); }
};
struct EpiGU {
    static constexpr bool PIPE = false; static constexpr int NKIND = 1; static constexpr bool PAIRBJ = true;
    unsigned char* H; const float* w;
    typedef NoData Cl; typedef NoData Ld;
    __device__ __forceinline__ int kind(int) const { return 0; }
    __device__ __forceinline__ float roww(int row) const { return w ? 8.0f * w[row] : 8.0f; }
    __device__ __forceinline__ void apply_pair(int row, int col0, const float (&g)[8], const float (&u)[8], const float s) const {
        float o[8];
#pragma unroll
        for (int j = 0; j < 8; ++j) {
            const float e = __builtin_amdgcn_exp2f(g[j] * (-1.4426950408889634f / 256.f));
            o[j] = __builtin_amdgcn_fmed3f(g[j] * u[j] * __builtin_amdgcn_rcpf(__builtin_fmaf(e, 65536.f, 65536.f)) * s, -448.f, 448.f); }
        int w0 = __builtin_amdgcn_cvt_pk_fp8_f32(o[0], o[1], 0, false); w0 = __builtin_amdgcn_cvt_pk_fp8_f32(o[2], o[3], w0, true);
        int w1 = __builtin_amdgcn_cvt_pk_fp8_f32(o[4], o[5], 0, false); w1 = __builtin_amdgcn_cvt_pk_fp8_f32(o[6], o[7], w1, true);
        *(u32x2*)(H + (size_t)row * DEXP + (col0 >> 8) * 128 + (col0 & 127)) = (u32x2){(unsigned)w0, (unsigned)w1}; }
};
struct EpiDown {
    static constexpr bool PIPE = false; static constexpr int NKIND = 1; static constexpr bool ROWLD = true;
    unsigned char* Y; const float* w;
    typedef NoData Cl; struct Ld { float s; };
    __device__ __forceinline__ int kind(int) const { return 0; }
    template <int K> __device__ __forceinline__ void colload(int, Cl&) const {}
    template <int K> __device__ __forceinline__ void load(int, int, Ld& ld) const { ld.s = 1.0f; }
    typedef u32x2 Pk;
    template <int K> __device__ __forceinline__ Pk pack(const float (&v)[8], const Ld& ld) const { float o[8]; const float s = ld.s * 0.015625f;
#pragma unroll
        for (int j = 0; j < 8; ++j) o[j] = __builtin_amdgcn_fmed3f(s * v[j], -448.f, 448.f);
        int w0 = __builtin_amdgcn_cvt_pk_fp8_f32(o[0], o[1], 0, false); w0 = __builtin_amdgcn_cvt_pk_fp8_f32(o[2], o[3], w0, true);
        int w1 = __builtin_amdgcn_cvt_pk_fp8_f32(o[4], o[5], 0, false); w1 = __builtin_amdgcn_cvt_pk_fp8_f32(o[6], o[7], w1, true);
        return (u32x2){(unsigned)w0, (unsigned)w1}; }
    template <int K> __device__ __forceinline__ void put(int row, int col0, const Pk w) const { *(u32x2*)(Y + (size_t)row * D + ycol(col0)) = w; }
    static __device__ __forceinline__ int ycol(int col) { return (col & ~255) + ((col & 127) >> 3) * 16 + ((col >> 7) & 1) * 8 + (col & 7); }
    __device__ __forceinline__ void put2(int row, int col0, const Pk w0, const Pk w1) const { *(u32x4*)(Y + (size_t)row * D + ycol(col0)) = (u32x4){w0.x, w0.y, w1.x, w1.y}; }
    template <int K> __device__ __forceinline__ void apply(int row, int col0, int, const float (&v)[8], const Ld& ld, const Cl&) const { put<K>(row, col0, pack<K>(v, ld)); }
};
struct EpiSD2 {
    static constexpr bool PIPE = false; static constexpr int NKIND = 1;
    unsigned char* ws; int tokbase;
    typedef NoData Cl; typedef NoData Ld;
    __device__ __forceinline__ int kind(int) const { return 0; }
    template <int K> __device__ __forceinline__ void colload(int, Cl&) const {}
    template <int K> __device__ __forceinline__ void load(int, int, Ld&) const {}
    typedef u32x4 Pk;
    template <int K> __device__ __forceinline__ Pk pack(const float (&v)[8], const Ld&) const { u32x4 w;
        w.x = pk2(v[0] * 0.00048828125f, v[1] * 0.00048828125f); w.y = pk2(v[2] * 0.00048828125f, v[3] * 0.00048828125f); w.z = pk2(v[4] * 0.00048828125f, v[5] * 0.00048828125f); w.w = pk2(v[6] * 0.00048828125f, v[7] * 0.00048828125f); return w; }
    template <int K> __device__ __forceinline__ void put(int row, int col0, const Pk w) const { *(u32x4*)((bf16*)(ws + WS_H0) + (size_t)(tokbase + row - NSLOTMAX) * D + col0) = w; }
    __device__ __forceinline__ void put2(int row, int col0, const Pk w0, const Pk w1) const { put<0>(row, col0, w0); put<0>(row, col0 + 128, w1); }
    template <int K> __device__ __forceinline__ void apply(int row, int col0, int, const float (&v)[8], const Ld& ld, const Cl&) const { put<K>(row, col0, pack<K>(v, ld)); }
};

namespace pg8 {
typedef short bf16x8 __attribute__((ext_vector_type(8)));
constexpr int BM = 256, BK = 64, HALF = 128, HTB = HALF * BK * 2, STAGE_BYTES = 8 * HTB, NXCD = 8, WGM = 8;
__device__ __forceinline__ int lds_byte(int r, int c) { const int st = (r >> 4) * 2 + (c >> 5), rr = r & 15, cc = c & 31, ob = rr * 64 + cc * 2; return st * 1024 + (ob ^ (((ob >> 9) & 1) << 5)); }
__device__ __forceinline__ void stage_rc(int b, int& R, int& C) { const int st = b / 1024, sb = b % 1024, swz = sb ^ (((sb >> 9) & 1) << 5); R = (st >> 1) * 16 + swz / 64; C = (st & 1) * 32 + (swz % 64) / 2; }
__device__ __forceinline__ int perm32(int rho) { const int n = rho >> 4, i = rho & 15; return 8 * (i >> 2) + 4 * n + (i & 3); }
typedef int v8i32_t __attribute__((ext_vector_type(8)));
typedef int v4i32_t __attribute__((ext_vector_type(4)));
__device__ __forceinline__ v8i32_t cat88(bf16x8 a, bf16x8 b) { const u32x4 x = __builtin_bit_cast(u32x4, a), y = __builtin_bit_cast(u32x4, b); return (v8i32_t){(int)x.x, (int)x.y, (int)x.z, (int)x.w, (int)y.x, (int)y.y, (int)y.z, (int)y.w}; }
struct Unit { int row0, col0; const char* A; const char* B; const int* idx; int mode; };
__device__ __forceinline__ int xcd_remap(int L, int nwg) { const int q = nwg / NXCD, r = nwg % NXCD, xcd = L % NXCD, off = L / NXCD; return (xcd < r ? xcd * (q + 1) : r * (q + 1) + (xcd - r) * q) + off; }
struct DenseOrder {
    int nM, nN, nwg, G, c, K; const char* A; const char* Bt;
    __device__ __forceinline__ void init(const bf16* A_, const bf16* Bt_, int M, int N, int K_) { A = (const char*)A_; Bt = (const char*)Bt_; K = K_; nM = M / BM; nN = N / BM; nwg = nM * nN; G = gridDim.x; c = blockIdx.x; }
    __device__ __forceinline__ bool next(int i, Unit& u) const {
        const long L = (long)i * G + c; if (L >= nwg) return false;
        const int wgid = xcd_remap((int)L, nwg);
        const int nig = WGM * nN, gid = wgid / nig, fm = gid * WGM, gsz = (nM - fm) < WGM ? (nM - fm) : WGM;
        const int pm = fm + ((wgid % nig) % gsz), pn = (wgid % nig) / gsz;
        u.row0 = pm * BM; u.col0 = pn * BM; u.A = A + (size_t)pm * BM * K * 2; u.B = Bt + (size_t)pn * BM * K * 2; u.idx = nullptr; u.mode = 0; return true;
    }
};
struct PairedOrder {
    DenseOrder d; const char* A2; const char* B2;
    __device__ __forceinline__ bool next(int i, Unit& u) const {
        if (!d.next(i >> 1, u)) return false;
        if (i & 1) { u.A = A2 + (size_t)u.row0 * d.K * 2; u.B = B2 + (size_t)u.col0 * d.K * 2; u.mode = 2; } else u.mode = 1;
        return true;
    }
};
struct GroupedOrder {
    const LAS int* te; int nct, nrt, nwg1, nwg2, G, c, K; const char* A; const int* idx; const int* ident; const char* Bt; const char* Bsh; size_t estride; bool gather;
    __device__ __forceinline__ bool next(int i, Unit& u) const {
        const int n1 = c < nwg1 ? (nwg1 - c + G - 1) / G : 0;
        if (i < n1) { const int wgid = xcd_remap(i * G + c, nwg1), rt = wgid / nct, ct = wgid % nct, row0 = rt * BM; const int e = __builtin_amdgcn_readfirstlane(te[rt]); u.mode = 0; u.col0 = ct * BM;
            u.row0 = row0; u.A = gather ? A : A + (size_t)row0 * K * 2; u.idx = idx + row0; u.B = Bt + (size_t)e * estride + (size_t)ct * BM * K * 2; return true; }
        const int L2 = (i - n1) * G + c; if (L2 >= nwg2) return false;
        const int wgid = xcd_remap(L2, nwg2), rt = wgid / nct, ct = wgid % nct, row0 = NSLOTMAX + rt * BM; u.mode = 3; u.col0 = ct * BM;
        u.row0 = row0; u.A = gather ? A : A + (size_t)row0 * K * 2; u.idx = ident + rt * BM; u.B = Bsh + (size_t)ct * BM * K * 2; return true;
    }
};

template <bool GATHER, bool PAIRED, bool FP8, bool NT2 = false, class Epi, class Sched, class Epi2>
__device__ __forceinline__ void gemm_phase2(LAS unsigned char* lds, const int wv, const int K, const Sched& S, const Epi& E, const Epi2& E2) {
    int tid = tidx_(wv); asm volatile("" : "+v"(tid));
    const int wid = __builtin_amdgcn_readfirstlane(tid >> 6), lane = tid & 63, wr = wid >> 2, wc = wid & 3, fr = lane & 15, fq = lane >> 4;
    const int nt = K / BK;
    unsigned voffA, voffB;
    { int R, C; stage_rc(tid * 16, R, C); const int Rb = (R & ~31) + perm32(R & 31); voffA = (unsigned)(R * K + C) * 2u; voffB = (unsigned)(Rb * K + C) * 2u; }
    const size_t pstep = (size_t)64 * K * 2;
    const size_t kstep = (size_t)(BK * 2);
    const size_t hstep = (size_t)HALF * K * 2;
    const unsigned ldsw = (unsigned)wid * 1024u;
    const int aoffk[2] = { FP8 ? lds_byte(wr * 64 + fr, fq * 16) : lds_byte(wr * 64 + fr, fq * 8), FP8 ? lds_byte(wr * 64 + fr, fq * 16 + 8) : lds_byte(wr * 64 + fr, fq * 8) + 1024 };
    const int boffk[2] = { FP8 ? lds_byte(wc * 32 + fr, fq * 16) : lds_byte(wc * 32 + fr, fq * 8), FP8 ? lds_byte(wc * 32 + fr, fq * 16 + 8) : lds_byte(wc * 32 + fr, fq * 8) + 1024 };
    LAS unsigned char* ldsB[2];
#pragma unroll
    for (int k = 0; k < 2; ++k) { ldsB[k] = lds + 65536 + boffk[k]; asm volatile("" : "+v"(ldsB[k])); }
    unsigned cvA[2][2];
#define PG8_SA(b, h) (((b) * 2 + (h)) * HTB)
#define PG8_SB(b, h) ((4 + (b) * 2 + (h)) * HTB)
#define PG8_STAGE(bufoff, gbase, voff) do { _Pragma("unroll") for (int _i = 0; _i < 2; ++_i) { const char* _b = (const char*)(gbase) + _i * pstep; asm volatile("" : "+s"(_b)); \
        __builtin_amdgcn_global_load_lds((const unsigned*)(_b + (voff)), (LAS unsigned*)(lds + (bufoff) + ldsw + _i * 8192), 16, 0, 0); } } while (0)
#define PG8_STAGE_G(bufoff, gbase, voff) do { const char* _b = (const char*)(gbase); asm volatile("" : "+s"(_b)); _Pragma("unroll") for (int _i = 0; _i < 2; ++_i) \
        __builtin_amdgcn_global_load_lds((const unsigned*)(_b + (voff)[_i]), (LAS unsigned*)(lds + (bufoff) + ldsw + _i * 8192), 16, 0, 0); } while (0)
#define PG8_STAGE_A(bufoff, kbase, h, usenext) do { if constexpr (GATHER) { PG8_STAGE_G(bufoff, kbase, cvA[h]); } \
        else { PG8_STAGE(bufoff, (kbase) + (h) * hstep, voffA); } } while (0)
#define PG8_LOADIDX(dst, un) do { _Pragma("unroll") for (int _i = 0; _i < 2; ++_i) { int _R, _C; stage_rc(tid * 16 + _i * 8192, _R, _C); _Pragma("unroll") for (int _h = 0; _h < 2; ++_h) \
        dst[_h][_i] = ((unsigned)(un).idx[_h * HALF + _R] * (unsigned)K + (unsigned)_C) * 2u; } } while (0)
#define PG8_LDA(dst, b, h) do { _Pragma("unroll") for (int m = 0; m < 4; ++m) { if constexpr (FP8) { dst##8[m].lo = *(const LAS v4i32_t*)(lds + PG8_SA(b, h) + aoffk[0] + m * 2048); dst##8[m].hi = *(const LAS v4i32_t*)(lds + PG8_SA(b, h) + aoffk[1] + m * 2048); } \
        else { _Pragma("unroll") for (int k = 0; k < 2; ++k) dst[m][k] = *(const LAS bf16x8*)(lds + PG8_SA(b, h) + aoffk[k] + m * 2048); } } } while (0)
#define PG8_LDB(dst, b, h) do { _Pragma("unroll") for (int n = 0; n < 2; ++n) { if constexpr (FP8) { dst##8[n].lo = *(const LAS v4i32_t*)(ldsB[0] + (PG8_SB(b, h) - 65536) + n * 2048); dst##8[n].hi = *(const LAS v4i32_t*)(ldsB[1] + (PG8_SB(b, h) - 65536) + n * 2048); } \
        else { _Pragma("unroll") for (int k = 0; k < 2; ++k) dst[n][k] = *(const LAS bf16x8*)(lds + PG8_SB(b, h) + boffk[k] + n * 2048); } } } while (0)
#define PG8_MMA(ai, bj, At, Bt) do { __builtin_amdgcn_s_setprio(1); _Pragma("unroll") for (int m = 0; m < 4; ++m) _Pragma("unroll") for (int n = 0; n < 2; ++n) { \
        if constexpr (FP8) acc[ai][bj][m][n] = __builtin_amdgcn_mfma_scale_f32_16x16x128_f8f6f4(Bt##8[n], At##8[m], acc[ai][bj][m][n], 0, 0, 2, 0x3F800000, 2, 0x3F800000);        \
        else { _Pragma("unroll") for (int k = 0; k < 2; ++k) acc[ai][bj][m][n] = __builtin_amdgcn_mfma_f32_16x16x32_bf16(Bt[n][k], At[m][k], acc[ai][bj][m][n], 0, 0, 0); } } \
        __builtin_amdgcn_s_setprio(0); \
        if (nt == 2) { _Pragma("unroll") for (int m = 0; m < 4; ++m) asm volatile("" : "+v"(acc[ai][bj][m][0]), "+v"(acc[ai][bj][m][1])); } } while (0)
#define PG8_WAIT_V(n) asm volatile("s_waitcnt vmcnt(" #n ")" ::: "memory")
#define PG8_WAIT_L(n) asm volatile("s_waitcnt lgkmcnt(" #n ")" ::: "memory")
#define PG8_BAR __builtin_amdgcn_s_barrier()
#define PG8_SCHED __builtin_amdgcn_sched_barrier(0)
    Unit cur, nxt; int ui = 0;
    if (!S.next(0, cur)) return;
    f32x4 acc[2][2][4][2];
#pragma unroll
    for (int a = 0; a < 2; ++a)
#pragma unroll
        for (int b = 0; b < 2; ++b)
#pragma unroll
            for (int m = 0; m < 4; ++m)
#pragma unroll
                for (int n = 0; n < 2; ++n) acc[a][b][m][n] = (f32x4){0.f, 0.f, 0.f, 0.f};
    bf16x8 At[4][2], B0[2][2], B1[2][2]; v8i32_t At8[4], B08[2], B18[2];
    const char* cA = cur.A; const char* cB = cur.B;
    if constexpr (GATHER) { PG8_LOADIDX(cvA, cur); }
    PG8_STAGE(PG8_SB(0, 0), cB, voffB); PG8_STAGE(PG8_SB(0, 1), cB + hstep, voffB); PG8_STAGE_A(PG8_SA(0, 0), cA, 0, false); PG8_STAGE_A(PG8_SA(0, 1), cA, 1, false);
    if (wr == 1) PG8_BAR;
    PG8_WAIT_V(2); PG8_BAR;
    PG8_STAGE(PG8_SB(1, 0), cB + kstep, voffB); PG8_STAGE_A(PG8_SA(1, 0), cA + kstep, 0, false); PG8_STAGE(PG8_SB(1, 1), cB + hstep + kstep, voffB);
    PG8_WAIT_V(6); PG8_BAR;
    if constexpr (NT2) { PG8_STAGE_A(PG8_SA(1, 1), cA + kstep, 1, false); PG8_WAIT_V(0); PG8_BAR; }
    for (;;) {
        const bool has_next = S.next(ui + 1, nxt);
        const char* nA = has_next ? nxt.A : cA; const char* nB = has_next ? nxt.B : cB;
        if constexpr (NT2) {
            PG8_LDB(B0, 0, 0); PG8_LDB(B1, 0, 1); PG8_SCHED; PG8_LDA(At, 0, 0);
            PG8_WAIT_L(0); PG8_BAR; PG8_MMA(0, 0, At, B0); PG8_MMA(0, 1, At, B1); PG8_BAR; PG8_SCHED;
            PG8_LDA(At, 0, 1); PG8_STAGE(PG8_SB(0, 0), nB, voffB); PG8_STAGE(PG8_SB(0, 1), nB + hstep, voffB); PG8_STAGE_A(PG8_SA(0, 0), nA, 0, true);
            PG8_WAIT_L(0); PG8_BAR; PG8_MMA(1, 0, At, B0); PG8_MMA(1, 1, At, B1); PG8_BAR; PG8_SCHED;
            PG8_LDB(B0, 1, 0); PG8_LDB(B1, 1, 1); PG8_SCHED; PG8_LDA(At, 1, 0); PG8_STAGE_A(PG8_SA(0, 1), nA, 1, true);
            PG8_WAIT_L(0); PG8_BAR; PG8_MMA(0, 0, At, B0); PG8_MMA(0, 1, At, B1); PG8_BAR; PG8_SCHED;
            PG8_LDA(At, 1, 1); PG8_STAGE(PG8_SB(1, 0), nB + kstep, voffB); PG8_STAGE(PG8_SB(1, 1), nB + hstep + kstep, voffB); PG8_STAGE_A(PG8_SA(1, 0), nA + kstep, 0, true);
            PG8_WAIT_L(0); PG8_BAR; PG8_MMA(1, 0, At, B0); PG8_MMA(1, 1, At, B1); PG8_BAR; PG8_SCHED;
            PG8_STAGE_A(PG8_SA(1, 1), nA + kstep, 1, true);
        } else
#pragma unroll 1
        for (int t = 0; t < nt; t += 2) {
            const bool last = (t == nt - 2);
            const char* a1 = cA + (size_t)(t + 1) * kstep;
            const char* a2 = last ? nA : cA + (size_t)(t + 2) * kstep; const char* b2 = last ? nB : cB + (size_t)(t + 2) * kstep;
            const char* a3 = a2 + kstep; const char* b3 = b2 + kstep;
            PG8_LDB(B0, 0, 0); PG8_LDB(B1, 0, 1); PG8_SCHED; PG8_LDA(At, 0, 0); PG8_STAGE_A(PG8_SA(1, 1), a1, 1, false);
            if constexpr (GATHER) { if (last && has_next) PG8_LOADIDX(cvA, nxt); }
            PG8_WAIT_V(8);
            PG8_WAIT_L(0); PG8_BAR; PG8_MMA(0, 0, At, B0); PG8_MMA(0, 1, At, B1); PG8_BAR; PG8_SCHED;
            PG8_LDA(At, 0, 1); PG8_STAGE(PG8_SB(0, 0), b2, voffB); PG8_STAGE(PG8_SB(0, 1), b2 + hstep, voffB); PG8_STAGE_A(PG8_SA(0, 0), a2, 0, last);
            PG8_WAIT_V(8);
            PG8_WAIT_L(0); PG8_BAR; PG8_MMA(1, 0, At, B0); PG8_MMA(1, 1, At, B1); PG8_BAR; PG8_SCHED;
            PG8_LDB(B0, 1, 0); PG8_LDB(B1, 1, 1); PG8_SCHED; PG8_LDA(At, 1, 0); PG8_STAGE_A(PG8_SA(0, 1), a2, 1, last);
            PG8_WAIT_V(8); PG8_WAIT_L(0); PG8_BAR; PG8_MMA(0, 0, At, B0); PG8_MMA(0, 1, At, B1); PG8_BAR; PG8_SCHED;
            PG8_LDA(At, 1, 1); PG8_STAGE(PG8_SB(1, 0), b3, voffB); PG8_STAGE(PG8_SB(1, 1), b3 + hstep, voffB); PG8_STAGE_A(PG8_SA(1, 0), a3, 0, last);
            PG8_WAIT_V(8); PG8_WAIT_L(0); PG8_BAR; PG8_MMA(1, 0, At, B0); PG8_MMA(1, 1, At, B1); PG8_BAR; PG8_SCHED;
        }
        if (wr == 0) PG8_BAR;
        {
            const int erow = cur.row0 + wr * 64 + fr, ecol = cur.col0 + wc * 32 + 8 * fq;
#define PG8_V8(ai, bj, m) { acc[ai][bj][m][0][0], acc[ai][bj][m][0][1], acc[ai][bj][m][0][2], acc[ai][bj][m][0][3], acc[ai][bj][m][1][0], acc[ai][bj][m][1][1], acc[ai][bj][m][1][2], acc[ai][bj][m][1][3] }
            auto run = [&](const auto& EE, auto KT) {
                typedef typename std::remove_cv<typename std::remove_reference<decltype(EE)>::type>::type EP; constexpr int KIND = decltype(KT)::value;
                if constexpr (pairkind_v<EP, KIND>::value) {
#pragma unroll
                    for (int ai = 0; ai < 2; ++ai)
#pragma unroll
                        for (int m = 0; m < 4; ++m) { const float vg[8] = PG8_V8(ai, 0, m); const float vu[8] = PG8_V8(ai, 1, m); EE.template apply_pair<KIND>(erow + ai * HALF + m * 16, ecol, vg, vu); }
                } else if constexpr (pairbj<EP>::value) {
                    float rsc[2][4];
#pragma unroll
                    for (int ai = 0; ai < 2; ++ai)
#pragma unroll
                        for (int m = 0; m < 4; ++m) rsc[ai][m] = EE.roww(erow + ai * HALF + m * 16);
#pragma unroll
                    for (int ai = 0; ai < 2; ++ai)
#pragma unroll
                        for (int m = 0; m < 4; ++m) { const float vg[8] = PG8_V8(ai, 0, m); const float vu[8] = PG8_V8(ai, 1, m); EE.apply_pair(erow + ai * HALF + m * 16, ecol, vg, vu, rsc[ai][m]); }
                } else if constexpr (statld<EP>::value) {
                    typename EP::Rs rs[2][4];
#pragma unroll
                    for (int bj = 0; bj < 2; ++bj) { typename EP::Cl cl; typename EP::Ld ld[2][4]; EE.template colload<KIND>(ecol + bj * HALF, cl);
                        if (bj == 0 || EP::template stat_per_half<KIND>()) {
#pragma unroll
                            for (int ai = 0; ai < 2; ++ai)
#pragma unroll
                                for (int m = 0; m < 4; ++m) EE.template rowstat<KIND>(erow + ai * HALF + m * 16, ecol + bj * HALF, rs[ai][m]); }
#pragma unroll
                        for (int ai = 0; ai < 2; ++ai)
#pragma unroll
                            for (int m = 0; m < 4; ++m) EE.template load<KIND>(erow + ai * HALF + m * 16, ecol + bj * HALF, ld[ai][m]);
                        PG8_SCHED;
#pragma unroll
                        for (int ai = 0; ai < 2; ++ai)
#pragma unroll
                            for (int m = 0; m < 4; ++m) { const float v[8] = PG8_V8(ai, bj, m); EE.template apply<KIND>(erow + ai * HALF + m * 16, ecol + bj * HALF, v, ld[ai][m], rs[ai][m], cl); }
                        PG8_SCHED; }
                } else if constexpr (NT2) {
                    typename EP::Cl cl; typename EP::Ld ld[2][4]; typename EP::Pk pk[2][2][4];
#pragma unroll
                    for (int ai = 0; ai < 2; ++ai)
#pragma unroll
                        for (int m = 0; m < 4; ++m) EE.template load<KIND>(erow + ai * HALF + m * 16, ecol, ld[ai][m]);
#pragma unroll
                    for (int bj = 0; bj < 2; ++bj)
#pragma unroll
                        for (int ai = 0; ai < 2; ++ai)
#pragma unroll
                            for (int m = 0; m < 4; ++m) { const float v[8] = PG8_V8(ai, bj, m); pk[bj][ai][m] = EE.template pack<KIND>(v, ld[ai][m]); }
                    PG8_WAIT_V(0); PG8_BAR;
#pragma unroll
                    for (int ai = 0; ai < 2; ++ai)
#pragma unroll
                        for (int m = 0; m < 4; ++m) EE.put2(erow + ai * HALF + m * 16, ecol, pk[0][ai][m], pk[1][ai][m]);
                } else if constexpr (rowld<EP>::value) {
                    typename EP::Cl cl; typename EP::Ld ld[2][4];
#pragma unroll
                    for (int ai = 0; ai < 2; ++ai)
#pragma unroll
                        for (int m = 0; m < 4; ++m) EE.template load<KIND>(erow + ai * HALF + m * 16, ecol, ld[ai][m]);
#pragma unroll
                    for (int bj = 0; bj < 2; ++bj)
#pragma unroll
                        for (int ai = 0; ai < 2; ++ai)
#pragma unroll
                            for (int m = 0; m < 4; ++m) { const float v[8] = PG8_V8(ai, bj, m); EE.template apply<KIND>(erow + ai * HALF + m * 16, ecol + bj * HALF, m, v, ld[ai][m], cl); }
                } else if constexpr (EP::PIPE) {
                    typename EP::Cl cl[2]; EE.template colload<KIND>(ecol, cl[0]); EE.template colload<KIND>(ecol + HALF, cl[1]);
                    typename EP::Ld ld[2][4];
#pragma unroll
                    for (int m = 0; m < 4; ++m) EE.template load<KIND>(erow + m * 16, ecol, ld[0][m]);
#pragma unroll
                    for (int gi = 0; gi < 4; ++gi) { const int ai = gi >> 1, bj = gi & 1;
                        if (gi < 3) { const int ai2 = (gi + 1) >> 1, bj2 = (gi + 1) & 1;
#pragma unroll
                            for (int m = 0; m < 4; ++m) EE.template load<KIND>(erow + ai2 * HALF + m * 16, ecol + bj2 * HALF, ld[(gi + 1) & 1][m]); }
#pragma unroll
                        for (int m = 0; m < 4; ++m) { const float v[8] = PG8_V8(ai, bj, m); EE.template apply<KIND>(erow + ai * HALF + m * 16, ecol + bj * HALF, m, v, ld[gi & 1][m], cl[bj]); } }
                } else {
#pragma unroll
                    for (int bj = 0; bj < 2; ++bj) { typename EP::Cl cl; EE.template colload<KIND>(ecol + bj * HALF, cl);
#pragma unroll
                        for (int ai = 0; ai < 2; ++ai)
#pragma unroll
                            for (int mg = 0; mg < 4; mg += epigroup<EP>::value) { typename EP::Ld ld[4];
#pragma unroll
                                for (int m = mg; m < mg + epigroup<EP>::value; ++m) EE.template load<KIND>(erow + ai * HALF + m * 16, ecol + bj * HALF, ld[m]);
#pragma unroll
                                for (int m = mg; m < mg + epigroup<EP>::value; ++m) { const float v[8] = PG8_V8(ai, bj, m); EE.template apply<KIND>(erow + ai * HALF + m * 16, ecol + bj * HALF, m, v, ld[m], cl); } } }
                }
            };
            if (cur.mode == 3) run(E2, KindTag<0>{});
            else if (PAIRED && cur.mode == 1) {
                if constexpr (PAIRED) {
#pragma unroll
                for (int bj = 0; bj < 2; ++bj)
#pragma unroll
                    for (int ai = 0; ai < 2; ++ai) { typename Epi::Ld ld[4];
#pragma unroll
                        for (int m = 0; m < 4; ++m) E.midload(erow + ai * HALF + m * 16, ecol + bj * HALF, ld[m]);
#pragma unroll
                        for (int m = 0; m < 4; ++m) { float v[8] = PG8_V8(ai, bj, m); E.mid(v, ld[m]);
                            acc[ai][bj][m][0] = (f32x4){v[0], v[1], v[2], v[3]}; acc[ai][bj][m][1] = (f32x4){v[4], v[5], v[6], v[7]}; } }
                }
            } else if constexpr (Epi::NKIND == 1) run(E, KindTag<0>{});
            else { const int kd = __builtin_amdgcn_readfirstlane(E.kind(cur.col0));
                if (kd == 0) run(E, KindTag<0>{}); else if (kd == 1) run(E, KindTag<1>{});
                else if constexpr (Epi::NKIND > 2) { if (kd == 2) run(E, KindTag<2>{}); else run(E, KindTag<3>{}); } }
#undef PG8_V8
        }
        if (!has_next) break;
        if (!PAIRED || cur.mode != 1) {
#pragma unroll
        for (int a = 0; a < 2; ++a)
#pragma unroll
            for (int b = 0; b < 2; ++b)
#pragma unroll
                for (int m = 0; m < 4; ++m)
#pragma unroll
                    for (int n = 0; n < 2; ++n) acc[a][b][m][n] = (f32x4){0.f, 0.f, 0.f, 0.f};
        }
        cur = nxt; cA = nA; cB = nB; ++ui;
        if (wr == 1) PG8_BAR;
    }
    PG8_WAIT_V(0);
    PG8_BAR;
#undef PG8_SA
#undef PG8_SB
#undef PG8_STAGE
#undef PG8_STAGE_A
#undef PG8_LOADIDX
#undef PG8_LDA
#undef PG8_LDB
#undef PG8_MMA
#undef PG8_WAIT_V
#undef PG8_WAIT_L
#undef PG8_BAR
#undef PG8_SCHED
}
template <bool GATHER, bool PAIRED, class Epi, class Sched>
__device__ __forceinline__ void gemm_phase(LAS unsigned char* lds, const int wv, const int K, const Sched& S, const Epi& E) { gemm_phase2<GATHER, PAIRED, false>(lds, wv, K, S, E, E); }
}
template <class Epi>
__device__ __forceinline__ void fgemm_dense(LAS unsigned char* lds, const int wv, const bf16* A, const bf16* Bt, int M, int N, int K, const Epi& epi) {
    pg8::DenseOrder S; S.init(A, Bt, M, N, K);
    pg8::gemm_phase<false, false>(lds, wv, K, S, epi);
}
template <class Epi>
__device__ __forceinline__ void fgemm_paired(LAS unsigned char* lds, const int wv, const bf16* A1, const bf16* B1, const bf16* A2, const bf16* B2, int M, int N, int K, const Epi& epi) {
    pg8::PairedOrder S; S.d.init(A1, B1, M, N, K); S.A2 = (const char*)A2; S.B2 = (const char*)B2;
    pg8::gemm_phase<false, true>(lds, wv, K, S, epi);
}

__device__ __forceinline__ void scan_hgrn(const Args& a, LAS unsigned char* lds, int b, int h, bool meta_only) {
    unsigned char* ws = a.ws; const int tid = threadIdx.x, v = tid >> 2, kq = tid & 3;
    LAS float* qs = (LAS float*)lds; LAS float* fs = qs + 16 * 128;
    const float* meta = (const float*)(ws + WS_META);
    bf16* QA = (bf16*)(ws + WS_QA); const bf16* LFA = (const bf16*)(ws + WS_LFA); const bf16* IA = (const bf16*)(ws + WS_IA);
    float S[32];
#pragma unroll
    for (int j = 0; j < 32; ++j) S[j] = 0.f;
    for (int blk = -1; blk < SEQ / 16; ++blk) {
        __syncthreads();
        for (int i = tid; i < 16 * 128; i += 512) { const int s = i >> 7, k = i & 127;
            if (blk < 0) { qs[i] = meta[0 * 16384 + s * 1024 + h * 128 + k]; fs[i] = __expf(meta[1 * 16384 + s * 1024 + h * 128 + k]); }
            else { const size_t t = (size_t)b * SEQ + blk * 16 + s; qs[i] = bf2f(QA[t * D + h * 128 + k]); fs[i] = __expf(h2f(LFA[t * D + h * 128 + k])); } }
        __syncthreads();
        for (int s = 0; s < 16; ++s) {
            float vt; size_t t = 0;
            if (blk < 0) vt = meta[2 * 16384 + s * 1024 + h * 128 + v]; else { t = (size_t)b * SEQ + blk * 16 + s; vt = bf2f(IA[t * D + h * 128 + v]); }
            float o = 0.f;
#pragma unroll
            for (int j = 0; j < 32; ++j) { const float f = fs[s * 128 + kq * 32 + j], q = qs[s * 128 + kq * 32 + j]; S[j] = f * S[j] + (1.0f - f) * vt; o += S[j] * q; }
            o += __shfl_xor(o, 1); o += __shfl_xor(o, 2);
            if (blk >= 0 && kq == 0) QA[t * D + h * 128 + v] = (bf16)f2bf(o);
        }
        if (meta_only) { float* sm = (float*)(ws + WS_SMETA) + (size_t)h * 128 * 128;
#pragma unroll
            for (int j = 0; j < 32; ++j) sm[(kq * 32 + j) * 128 + v] = S[j];
            break; }
    }
}
__device__ __forceinline__ void scan_mlstm(const Args& a, LAS unsigned char* lds, int b, int h, bool meta_only) {
    unsigned char* ws = a.ws; const int tid = threadIdx.x, v = tid >> 1, kh = tid & 1;
    LAS float* qs = (LAS float*)lds; LAS float* ks = qs + 16 * 128; LAS float* raw = ks + 16 * 128; LAS float* sc = raw + 19 * 256;
    const float* meta = (const float*)(ws + WS_META); const float* igfg = (const float*)(ws + WS_IGFG);
    const bf16* QKB = (const bf16*)(ws + WS_QKB); bf16* VB = (bf16*)(ws + WS_VB);
    const float* cw = a.in[7]; const float* cb = a.in[8]; const float igb = a.in[9][h], fgb = a.in[10][h];
    float C[64], n[64];
#pragma unroll
    for (int j = 0; j < 64; ++j) { C[j] = 0.f; n[j] = 0.f; }
    float M = 0.f;
    for (int blk = -1; blk < SEQ / 16; ++blk) {
        __syncthreads();
        for (int i = tid; i < 19 * 256; i += 512) { const int r = i >> 8, c = i & 255; const int ch = (c < 128) ? h * 128 + c : 512 + h * 128 + (c - 128);
            float val;
            if (blk < 0) { const int mr = r - 3; val = mr >= 0 ? meta[3 * 16384 + mr * 1024 + ch] : 0.f; }
            else { const int tt = blk * 16 + r - 3; val = tt >= 0 ? bf2f(QKB[((size_t)b * SEQ + tt) * D + ch]) : meta[3 * 16384 + (16 + tt) * 1024 + ch]; }
            raw[i] = val; }
        if (tid < 16) { float ig, fg;
            if (blk < 0) { ig = meta[5 * 16384 + tid * 8 + h]; fg = meta[5 * 16384 + tid * 8 + 4 + h]; }
            else { const size_t t = (size_t)b * SEQ + blk * 16 + tid; ig = igfg[t * 8 + h]; fg = igfg[t * 8 + 4 + h]; }
            ig += igb; fg += fgb;
            sc[tid] = ig; sc[16 + tid] = fminf(fg, 0.f) - log1pf(__expf(-fabsf(fg))); }
        __syncthreads();
        for (int i = tid; i < 16 * 256; i += 512) { const int s = i >> 8, c = i & 255; const int ch = (c < 128) ? h * 128 + c : 512 + h * 128 + (c - 128);
            float y = cb[ch];
#pragma unroll
            for (int j = 0; j < 4; ++j) y += cw[j * 1024 + ch] * raw[(s + j) * 256 + c];
            y = siluf_(y);
            if (c < 128) qs[s * 128 + c] = y * 0.08838834764831845f; else ks[s * 128 + c - 128] = y; }
        __syncthreads();
        for (int s = 0; s < 16; ++s) {
            float vt; size_t t = 0;
            if (blk < 0) vt = meta[4 * 16384 + s * 1024 + h * 256 + v]; else { t = (size_t)b * SEQ + blk * 16 + s; vt = bf2f(VB[t * D + h * 256 + v]); }
            const float ig = sc[s], lf = sc[16 + s]; const float Mn = fmaxf(lf + M, ig), fd = __expf(lf + M - Mn), iw = __expf(ig - Mn); M = Mn;
            float num = 0.f, den = 0.f; const float iv = iw * vt;
#pragma unroll
            for (int j = 0; j < 64; ++j) { const float kv = ks[s * 128 + kh * 64 + j], q = qs[s * 128 + kh * 64 + j]; C[j] = fd * C[j] + iv * kv; n[j] = fd * n[j] + iw * kv; num += C[j] * q; den += n[j] * q; }
            num += __shfl_xor(num, 1); den += __shfl_xor(den, 1);
            const float hv = num / fmaxf(fabsf(den), __expf(-M));
            if (blk >= 0 && kh == 0) VB[t * D + h * 256 + v] = (bf16)f2bf(hv);
        }
        if (meta_only) { float* cm = (float*)(ws + WS_CMETA) + (size_t)h * 128 * 256; float* nm = (float*)(ws + WS_NMETA);
#pragma unroll
            for (int j = 0; j < 64; ++j) { cm[(kh * 64 + j) * 256 + v] = C[j]; if (v == 0) nm[h * 128 + kh * 64 + j] = n[j]; }
            if (tid == 0) nm[1024 + h] = M;
            break; }
    }
}

__device__ __forceinline__ void s0_hgrn_prep(const Args& a) {
    unsigned char* ws = a.ws;
    for (int it = blockIdx.x * 512 + threadIdx.x; it < 1024 * 128; it += gridDim.x * 512) {
        const int oct = it & 127, cg = it >> 7; const size_t base = (size_t)cg * 64 * D + oct * 8;
        bf16* Q = (bf16*)(ws + WS_QA) + base; bf16* L = (bf16*)(ws + WS_LFA) + base;
        float r[8], bc[8];
#pragma unroll
        for (int j = 0; j < 8; ++j) { r[j] = 0.f; bc[j] = 0.f; }
#pragma unroll 1
        for (int s0 = 0; s0 < 32; s0 += 16) { u32x4 w[16];
#pragma unroll
            for (int u = 0; u < 16; ++u) w[u] = *(const u32x4*)(L + (size_t)(s0 + u) * D);
#pragma unroll
            for (int u = 0; u < 16; ++u)
#pragma unroll
                for (int i = 0; i < 4; ++i) { r[2 * i] += h2f(w[u][i] & 0xffffu); r[2 * i + 1] += h2f(w[u][i] >> 16); } }
#pragma unroll 1
        for (int s0 = 0; s0 < 64; s0 += 8) { u32x4 wl[8], wq[8];
#pragma unroll
            for (int u = 0; u < 8; ++u) { wl[u] = *(const u32x4*)(L + (size_t)(s0 + u) * D); wq[u] = *(const u32x4*)(Q + (size_t)(s0 + u) * D); }
#pragma unroll
            for (int u = 0; u < 8; ++u) { float qt[8], kt[8];
#pragma unroll
                for (int i = 0; i < 4; ++i) {
#pragma unroll
                    for (int hh = 0; hh < 2; ++hh) { const int j = 2 * i + hh; const float lf = h2f(hh ? (wl[u][i] >> 16) : (wl[u][i] & 0xffffu)), q = bf2f(hh ? (wq[u][i] >> 16) : (wq[u][i] & 0xffffu));
                        bc[j] += lf; qt[j] = q * __expf(fminf(bc[j] - r[j], 80.f)); kt[j] = -expm1f(lf) * __expf(fminf(r[j] - bc[j], 80.f)); } }
                store8_bf16(Q + (size_t)(s0 + u) * D, qt); store8_bf16(L + (size_t)(s0 + u) * D, kt); } }
        float* em = (float*)(ws + WS_EM) + (size_t)cg * 1024 + oct * 8; float* el = (float*)(ws + WS_EL) + (size_t)cg * 1024 + oct * 8;
        *(f32x4*)em = (f32x4){__expf(r[0]), __expf(r[1]), __expf(r[2]), __expf(r[3])}; *(f32x4*)(em + 4) = (f32x4){__expf(r[4]), __expf(r[5]), __expf(r[6]), __expf(r[7])};
        *(f32x4*)el = (f32x4){__expf(bc[0] - r[0]), __expf(bc[1] - r[1]), __expf(bc[2] - r[2]), __expf(bc[3] - r[3])}; *(f32x4*)(el + 4) = (f32x4){__expf(bc[4] - r[4]), __expf(bc[5] - r[5]), __expf(bc[6] - r[6]), __expf(bc[7] - r[7])};
    }
}
__device__ __forceinline__ void s0_mlstm_conv(const Args& a) {
    unsigned char* ws = a.ws; const float* cw = a.in[7]; const float* cb = a.in[8]; const float* meta = (const float*)(ws + WS_META);
    for (int it = blockIdx.x * 512 + threadIdx.x; it < 1024 * 128; it += gridDim.x * 512) {
        const int oct = it & 127, cg = it >> 7, ch = oct * 8; bf16* X = (bf16*)(ws + WS_QKB) + (size_t)cg * 64 * D + ch;
        float w0[8], w1[8], w2[8], c0[8], c1[8], c2[8], c3[8], bb[8];
#pragma unroll
        for (int j = 0; j < 8; ++j) { c0[j] = cw[ch + j]; c1[j] = cw[1024 + ch + j]; c2[j] = cw[2048 + ch + j]; c3[j] = cw[3072 + ch + j]; bb[j] = cb[ch + j]; }
        if ((cg & 127) == 0) {
#pragma unroll
            for (int j = 0; j < 8; ++j) { w0[j] = meta[3 * 16384 + 13 * 1024 + ch + j]; w1[j] = meta[3 * 16384 + 14 * 1024 + ch + j]; w2[j] = meta[3 * 16384 + 15 * 1024 + ch + j]; }
        } else { const bf16* hp = (const bf16*)(ws + WS_HALO) + (size_t)(cg - 1) * 3 * D + ch; load8_bf16(hp, w0); load8_bf16(hp + D, w1); load8_bf16(hp + 2 * D, w2); }
        const bool isq = ch < 512; const int hh = (ch & 511) >> 7; const f32x4* gates = (const f32x4*)(ws + WS_GATES);
        const float scale = isq ? 0.08838834764831845f : 1.0f;
#pragma unroll 1
        for (int s0 = 0; s0 < 64; s0 += 8) { u32x4 xw[8]; f32x4 gt[8];
#pragma unroll
            for (int u = 0; u < 8; ++u) { xw[u] = *(const u32x4*)(X + (size_t)(s0 + u) * D); gt[u] = gates[((size_t)cg * 64 + s0 + u) * 4 + hh]; }
#pragma unroll
            for (int u = 0; u < 8; ++u) { float x[8], y[8]; unpack8(xw[u], x); const float rs_ = scale * (isq ? gt[u].x : gt[u].y);
#pragma unroll
                for (int j = 0; j < 8; ++j) { const float t = bb[j] + c0[j] * w0[j] + c1[j] * w1[j] + c2[j] * w2[j] + c3[j] * x[j]; y[j] = siluf_(t) * rs_; w0[j] = w1[j]; w1[j] = w2[j]; w2[j] = x[j]; }
                store8_bf16(X + (size_t)(s0 + u) * D, y); } }
    }
}
__device__ __forceinline__ float logsigmoidf_(float x) { return fminf(x, 0.f) - log1pf(__expf(-fabsf(x))); }
#define DPPI(v, idv, ctrl, rmask) __builtin_bit_cast(float, __builtin_amdgcn_update_dpp(__builtin_bit_cast(int, (float)(idv)), __builtin_bit_cast(int, (v)), (ctrl), (rmask), 0xf, false))
__device__ __forceinline__ float wave_scan_add(float v) {
    v += DPPI(v, 0.f, 0x111, 0xf); v += DPPI(v, 0.f, 0x112, 0xf); v += DPPI(v, 0.f, 0x114, 0xf); v += DPPI(v, 0.f, 0x118, 0xf);
    v += DPPI(v, 0.f, 0x142, 0xa); v += DPPI(v, 0.f, 0x143, 0xc); return v; }
__device__ __forceinline__ float wave_scan_max(float v) {
    v = fmaxf(v, DPPI(v, -INFINITY, 0x111, 0xf)); v = fmaxf(v, DPPI(v, -INFINITY, 0x112, 0xf)); v = fmaxf(v, DPPI(v, -INFINITY, 0x114, 0xf)); v = fmaxf(v, DPPI(v, -INFINITY, 0x118, 0xf));
    v = fmaxf(v, DPPI(v, -INFINITY, 0x142, 0xa)); v = fmaxf(v, DPPI(v, -INFINITY, 0x143, 0xc)); return v; }
__device__ __forceinline__ void s0_mlstm_gates(const Args& a, LAS unsigned char* lds, int b, int h) {
    unsigned char* ws = a.ws; const int tid = threadIdx.x, lane = tid & 63, wave = tid >> 6; const float igb = a.in[9][h], fgb = a.in[10][h];
    const float* meta = (const float*)(ws + WS_META); const float* igfg = (const float*)(ws + WS_IGFG); f32x4* gates = (f32x4*)(ws + WS_GATES);
    LAS float* sum = (LAS float*)lds;
    LAS float* mc = sum + 256;
    float bcv[16], pmv[16], igv[16];
    __syncthreads();
    float rig[16], rfg[16];
#pragma unroll
    for (int i = 0; i < 16; ++i) { const size_t t = (size_t)b * SEQ + (wave * 16 + i) * 64 + lane; rig[i] = igfg[t * 8 + h]; rfg[i] = igfg[t * 8 + 4 + h]; }
    __builtin_amdgcn_sched_barrier(0);
#pragma unroll
    for (int i = 0; i < 16; ++i) {
        const int c = wave * 16 + i; const size_t t = (size_t)b * SEQ + c * 64 + lane;
        const float ig = rig[i] + igb, lf = logsigmoidf_(rfg[i] + fgb);
        const float bc = wave_scan_add(lf);
        const float pm = wave_scan_max(ig - bc);
        bcv[i] = bc; pmv[i] = pm; igv[i] = ig;
        if (lane == 63) { sum[2 * c] = bc; sum[2 * c + 1] = pm; }
    }
    __syncthreads();
    if (wave == 0) {
        float mig = 0.f, mlf = 0.f; if (lane < 16) { mig = meta[5 * 16384 + lane * 8 + h] + igb; mlf = logsigmoidf_(meta[5 * 16384 + lane * 8 + 4 + h] + fgb); }
        const float sb0 = sum[2 * lane], sp0 = sum[2 * lane + 1], sb1 = sum[2 * (lane + 64)], sp1 = sum[2 * (lane + 64) + 1];
        float Mc = 0.f;
#pragma unroll 4
        for (int s = 0; s < 16; ++s) Mc = fmaxf(rl_(mlf, s) + Mc, rl_(mig, s));
        float m0 = 0.f, m1 = 0.f;
#pragma unroll 4
        for (int c = 0; c < 64; ++c) { if (lane == c) m0 = Mc; Mc = rl_(sb0, c) + fmaxf(Mc, rl_(sp0, c)); }
#pragma unroll 4
        for (int c = 0; c < 64; ++c) { if (lane == c) m1 = Mc; Mc = rl_(sb1, c) + fmaxf(Mc, rl_(sp1, c)); }
        mc[lane] = m0; mc[lane + 64] = m1; }
    __syncthreads();
#pragma unroll
    for (int i = 0; i < 16; ++i) { const int c = wave * 16 + i; const size_t t = (size_t)b * SEQ + c * 64 + lane;
        const float Mt = bcv[i] + fmaxf(mc[c], pmv[i]), bL = rl_(bcv[i], 63), ML = rl_(Mt, 63);
        gates[t * 4 + h] = (f32x4){__expf(bcv[i] - Mt - bL + ML), __expf(igv[i] - bcv[i] + bL - ML), __expf(-Mt), __expf(bL + mc[c] - ML)}; }
    __syncthreads();
}
__device__ __forceinline__ void meta_state_hgrn(const Args& a, int h, int vs) {
    const float* meta = (const float*)(a.ws + WS_META); const int tid = threadIdx.x, v = vs * 16 + (tid & 15), k0 = (tid >> 4) * 4;
    f32x4 lf[16]; float vt[16];
#pragma unroll
    for (int s = 0; s < 16; ++s) { lf[s] = *(const f32x4*)(meta + 1 * 16384 + s * 1024 + h * 128 + k0); vt[s] = meta[2 * 16384 + s * 1024 + h * 128 + v]; }
    float S[4] = {0.f, 0.f, 0.f, 0.f};
#pragma unroll
    for (int s = 0; s < 16; ++s)
#pragma unroll
        for (int j = 0; j < 4; ++j) { const float f = __expf(lf[s][j]); S[j] = f * S[j] + (1.0f - f) * vt[s]; }
    float* sm = (float*)(a.ws + WS_SMETA) + (size_t)h * 128 * 128;
#pragma unroll
    for (int j = 0; j < 4; ++j) sm[(k0 + j) * 128 + v] = S[j];
}
__device__ __forceinline__ void meta_state_mlstm(const Args& a, int h, int vs) {
    const float* meta = (const float*)(a.ws + WS_META); const float* cw = a.in[7]; const float* cb = a.in[8]; const float igb = a.in[9][h], fgb = a.in[10][h];
    const int tid = threadIdx.x, v = vs * 16 + (tid & 15), k0 = (tid >> 4) * 4, ch0 = 512 + h * 128 + k0;
    f32x4 rawk[19], cwv[4]; float vt[16], ig[16], fg[16];
#pragma unroll
    for (int r = 0; r < 19; ++r) rawk[r] = r >= 3 ? *(const f32x4*)(meta + 3 * 16384 + (r - 3) * 1024 + ch0) : (f32x4){0.f, 0.f, 0.f, 0.f};
#pragma unroll
    for (int j = 0; j < 4; ++j) cwv[j] = *(const f32x4*)(cw + j * 1024 + ch0);
    const f32x4 cbv = *(const f32x4*)(cb + ch0);
#pragma unroll
    for (int s = 0; s < 16; ++s) { vt[s] = meta[4 * 16384 + s * 1024 + h * 256 + v]; ig[s] = meta[5 * 16384 + s * 8 + h]; fg[s] = meta[5 * 16384 + s * 8 + 4 + h]; }
    float C[4] = {0.f, 0.f, 0.f, 0.f}, n[4] = {0.f, 0.f, 0.f, 0.f}, M = 0.f;
#pragma unroll
    for (int s = 0; s < 16; ++s) {
        f32x4 y = cbv;
#pragma unroll
        for (int j = 0; j < 4; ++j) y += cwv[j] * rawk[s + j];
        const float igs = ig[s] + igb, fgs = fg[s] + fgb, lf = fminf(fgs, 0.f) - log1pf(__expf(-fabsf(fgs)));
        const float Mn = fmaxf(lf + M, igs), fd = __expf(lf + M - Mn), iw = __expf(igs - Mn); M = Mn;
        const float iv = iw * vt[s];
#pragma unroll
        for (int j = 0; j < 4; ++j) { const float kv = siluf_(y[j]); C[j] = fd * C[j] + iv * kv; n[j] = fd * n[j] + iw * kv; }
    }
    float* cm = (float*)(a.ws + WS_CMETA) + (size_t)h * 128 * 256; float* nm = (float*)(a.ws + WS_NMETA);
#pragma unroll
    for (int j = 0; j < 4; ++j) { cm[(k0 + j) * 256 + v] = C[j]; if (v == 0) nm[h * 128 + k0 + j] = n[j]; }
    if (vs == 0 && tid == 0) nm[1024 + h] = M;
}
__device__ __forceinline__ void s0_prepass(const Args& a, LAS unsigned char* lds) {
    s0_hgrn_prep(a);
    s0_mlstm_conv(a);
    for (int u = blockIdx.x; u < 128; u += gridDim.x) {
        if (u < 64) meta_state_hgrn(a, u >> 3, u & 7);
        else meta_state_mlstm(a, (u - 64) >> 4, (u - 64) & 15); }
}

typedef short v4i16_t __attribute__((ext_vector_type(4)));
typedef short bf16x8_t __attribute__((ext_vector_type(8)));
__device__ __forceinline__ v4i16_t tr16(LAS unsigned char* p) { return __builtin_amdgcn_ds_read_tr16_b64_v4i16((LAS v4i16_t*)p); }
__device__ __forceinline__ bf16x8_t cat44(v4i16_t a, v4i16_t b) { return (bf16x8_t){a[0], a[1], a[2], a[3], b[0], b[1], b[2], b[3]}; }
__device__ __forceinline__ bf16x8_t pack8(f32x4 a, f32x4 b) { const u32x4 w = {pk2(a.x, a.y), pk2(a.z, a.w), pk2(b.x, b.y), pk2(b.z, b.w)}; return __builtin_bit_cast(bf16x8_t, w); }
__device__ __forceinline__ bf16x8_t cat22(u32x2 a, u32x2 b) { const u32x4 w = {a.x, a.y, b.x, b.y}; return __builtin_bit_cast(bf16x8_t, w); }
constexpr int SC_QT = 0, SC_KT = 17408, SC_VT = 34816, SC_PT = 44032, SC_EM = 53248, SC_EL = 53760, SC_QS = 272, SC_VS = 144;

constexpr int S3_SET = 45056, S3_P = 90112, S3_ST = 99328;
__device__ __forceinline__ void fscan3_hgrn(const Args& a, LAS unsigned char* lds, int b, int h, int vh) {
    unsigned char* ws = a.ws; const int tid = threadIdx.x, lane = tid & 63, w = tid >> 6, fr = lane & 15, g = lane >> 4, q4 = fr >> 2, p4 = fr & 3;
    const bf16* QA = (const bf16*)(ws + WS_QA); const bf16* KA = (const bf16*)(ws + WS_LFA); bf16* IA = (bf16*)(ws + WS_IA);
    const float* EMg = (const float*)(ws + WS_EM); const float* ELg = (const float*)(ws + WS_EL);
    const int vt = w & 3, th = w >> 2, tt = w & 3, sh = w >> 2;
    f32x4 S[4];
    { const float* sm = (const float*)(ws + WS_SMETA) + (size_t)h * 128 * 128 + vh * 64 + vt * 16 + fr;
#pragma unroll
      for (int j = 0; j < 4; ++j)
#pragma unroll
          for (int r = 0; r < 4; ++r) S[j][r] = sm[(16 * (4 * th + j) + 4 * g + r) * 128]; }
    LAS unsigned char* XS = lds + 106496;
    const int r0 = tid >> 4, c0 = tid & 15, rv = tid >> 3, cv = tid & 7;
    u32x4 pq0, pq1, pk0, pk1, pv; f32x4 pe;
#define HG_FETCH(c) do { const size_t t0 = (size_t)b * SEQ + (size_t)(c) * 64; \
        pq0 = *(const u32x4*)(QA + (t0 + r0) * D + h * 128 + c0 * 8); pq1 = *(const u32x4*)(QA + (t0 + r0 + 32) * D + h * 128 + c0 * 8); \
        pk0 = *(const u32x4*)(KA + (t0 + r0) * D + h * 128 + c0 * 8); pk1 = *(const u32x4*)(KA + (t0 + r0 + 32) * D + h * 128 + c0 * 8); \
        pv = *(const u32x4*)(IA + (t0 + rv) * D + h * 128 + vh * 64 + cv * 8); \
        if (tid < 64) { const size_t cgi = ((size_t)b * 128 + (c)) * 1024 + h * 128; pe = *(const f32x4*)((tid < 32 ? EMg : ELg) + cgi + (tid & 31) * 4); } } while (0)
#define HG_COMMIT(sb) do { LAS unsigned char* B_ = lds + (sb); *(LAS u32x4*)(B_ + r0 * SC_QS + c0 * 16) = pq0; *(LAS u32x4*)(B_ + (r0 + 32) * SC_QS + c0 * 16) = pq1; \
        *(LAS u32x4*)(B_ + 17408 + r0 * SC_QS + c0 * 16) = pk0; *(LAS u32x4*)(B_ + 17408 + (r0 + 32) * SC_QS + c0 * 16) = pk1; \
        *(LAS u32x4*)(B_ + 34816 + rv * SC_VS + cv * 16) = pv; \
        if (tid < 64) *(LAS f32x4*)(B_ + (tid < 32 ? 44032 : 44544) + (tid & 31) * 16) = pe; } while (0)
    __syncthreads();
    HG_FETCH(0); HG_COMMIT(0);
    __syncthreads();
    for (int c = 0; c < SEQ / 64; ++c) {
        const int sb = (c & 1) * S3_SET;
        LAS unsigned char* Q_ = lds + sb; LAS unsigned char* K_ = Q_ + 17408; LAS unsigned char* V_ = Q_ + 34816; LAS unsigned char* P_ = lds + S3_P;
        if (c + 1 < SEQ / 64) HG_FETCH(c + 1);
        bf16x8_t afo[2];
        {
            bf16x8_t bq[4];
#pragma unroll
            for (int ks = 0; ks < 4; ++ks) bq[ks] = *(const LAS bf16x8_t*)(Q_ + (tt * 16 + fr) * SC_QS + ks * 64 + g * 16);
            bf16x8_t ak[2][4];
#pragma unroll
            for (int si = 0; si < 2; ++si)
#pragma unroll
                for (int ks = 0; ks < 4; ++ks) ak[si][ks] = *(const LAS bf16x8_t*)(K_ + ((2 * sh + si) * 16 + fr) * SC_QS + ks * 64 + g * 16);
#pragma unroll
            for (int j = 0; j < 4; ++j) S[j] = S[j] * *(const LAS f32x4*)(Q_ + 44032 + (16 * (4 * th + j) + 4 * g) * 4);
#pragma unroll
            for (int jj = 0; jj < 2; ++jj) { afo[jj] = pack8(S[2 * jj], S[2 * jj + 1]); *(LAS bf16x8_t*)(XS + (w * 2 + jj) * 1024 + lane * 16) = afo[jj]; }
            f32x4 accA[2] = {{0.f, 0.f, 0.f, 0.f}, {0.f, 0.f, 0.f, 0.f}};
#pragma unroll
            for (int ks = 0; ks < 4; ++ks)
#pragma unroll
                for (int si = 0; si < 2; ++si) accA[si] = __builtin_amdgcn_mfma_f32_16x16x32_bf16(ak[si][ks], bq[ks], accA[si], 0, 0, 0);
#pragma unroll
            for (int si = 0; si < 2; ++si) { const int st = 2 * sh + si; const f32x4 acc = accA[si];
                const int t = tt * 16 + fr, s0 = st * 16 + 4 * g; u32x2 pw;
                pw.x = pk2(s0 + 0 <= t ? acc[0] : 0.f, s0 + 1 <= t ? acc[1] : 0.f); pw.y = pk2(s0 + 2 <= t ? acc[2] : 0.f, s0 + 3 <= t ? acc[3] : 0.f);
                *(LAS u32x2*)(P_ + t * SC_VS + s0 * 2) = pw; }
        }
        __syncthreads();
        {
            bf16x8_t afr[4], vfr[2];
            { bf16x8_t pa[2];
#pragma unroll
              for (int jj = 0; jj < 2; ++jj) pa[jj] = *(const LAS bf16x8_t*)(XS + ((w ^ 4) * 2 + jj) * 1024 + lane * 16);
              if (th == 0) { afr[0] = afo[0]; afr[1] = afo[1]; afr[2] = pa[0]; afr[3] = pa[1]; } else { afr[0] = pa[0]; afr[1] = pa[1]; afr[2] = afo[0]; afr[3] = afo[1]; } }
#pragma unroll
            for (int k2 = 0; k2 < 2; ++k2) { LAS unsigned char* pa = V_ + (32 * k2 + 8 * g + q4) * SC_VS + (vt * 16 + 4 * p4) * 2; vfr[k2] = cat44(tr16(pa), tr16(pa + 4 * SC_VS)); }
            const size_t t0 = (size_t)b * SEQ + (size_t)c * 64;
            bf16x8_t qfB[2][4], pfB[2][2];
#pragma unroll
            for (int ti = 0; ti < 2; ++ti) { const int t = (2 * th + ti) * 16 + fr;
#pragma unroll
                for (int ks = 0; ks < 4; ++ks) { const u32x2 lo = *(const LAS u32x2*)(Q_ + t * SC_QS + (32 * ks + 4 * g) * 2), hi = *(const LAS u32x2*)(Q_ + t * SC_QS + (32 * ks + 16 + 4 * g) * 2); qfB[ti][ks] = cat22(lo, hi); }
#pragma unroll
                for (int k2 = 0; k2 < 2; ++k2) pfB[ti][k2] = *(const LAS bf16x8_t*)(P_ + t * SC_VS + (32 * k2 + 8 * g) * 2); }
            f32x4 accB[2] = {{0.f, 0.f, 0.f, 0.f}, {0.f, 0.f, 0.f, 0.f}};
#pragma unroll
            for (int ks = 0; ks < 4; ++ks)
#pragma unroll
                for (int ti = 0; ti < 2; ++ti) accB[ti] = __builtin_amdgcn_mfma_f32_16x16x32_bf16(afr[ks], qfB[ti][ks], accB[ti], 0, 0, 0);
#pragma unroll
            for (int k2 = 0; k2 < 2; ++k2)
#pragma unroll
                for (int ti = 0; ti < 2; ++ti) accB[ti] = __builtin_amdgcn_mfma_f32_16x16x32_bf16(vfr[k2], pfB[ti][k2], accB[ti], 0, 0, 0);
#pragma unroll
            for (int ti = 0; ti < 2; ++ti) { const int t = (2 * th + ti) * 16 + fr; const f32x4 acc = accB[ti];
                u32x2 ow; ow.x = pk2(acc[0], acc[1]); ow.y = pk2(acc[2], acc[3]);
                *(u32x2*)(IA + (t0 + t) * D + h * 128 + vh * 64 + vt * 16 + 4 * g) = ow;
                float sq = (acc[0] * acc[0] + acc[1] * acc[1]) + (acc[2] * acc[2] + acc[3] * acc[3]); sq += __shfl_xor(sq, 16); sq += __shfl_xor(sq, 32);
                if (g == 0) *(LAS float*)(lds + S3_ST + (vt * 64 + t) * 4) = sq; }
#pragma unroll
            for (int j = 0; j < 4; ++j) { const int kt = 4 * th + j;
#pragma unroll
                for (int k2 = 0; k2 < 2; ++k2) { LAS unsigned char* pa = K_ + (32 * k2 + 8 * g + q4) * SC_QS + (16 * kt + 4 * p4) * 2; const bf16x8_t ak = cat44(tr16(pa), tr16(pa + 4 * SC_QS));
                    S[j] = __builtin_amdgcn_mfma_f32_16x16x32_bf16(ak, vfr[k2], S[j], 0, 0, 0); }
                S[j] = S[j] * *(const LAS f32x4*)(Q_ + 44544 + (16 * kt + 4 * g) * 4); }
        }
        if (c + 1 < SEQ / 64) HG_COMMIT(S3_SET - sb);
        __syncthreads();
        if (tid < 64) { const LAS float* sp = (const LAS float*)(lds + S3_ST) + tid;
            ((float*)(ws + WS_STA2))[((size_t)b * SEQ + (size_t)c * 64 + tid) * 16 + h * 2 + vh] = (sp[0] + sp[64]) + (sp[128] + sp[192]); }
    }
#undef HG_FETCH
#undef HG_COMMIT
}
__device__ __forceinline__ void fscan3_mlstm(const Args& a, LAS unsigned char* lds, int b, int h, int vq) {
    unsigned char* ws = a.ws; const int tid = threadIdx.x, lane = tid & 63, w = tid >> 6, fr = lane & 15, g = lane >> 4, q4 = fr >> 2, p4 = fr & 3;
    const bf16* QK = (const bf16*)(ws + WS_QKB); bf16* VB = (bf16*)(ws + WS_VB); const f32x4* GT = (const f32x4*)(ws + WS_GATES);
    const int vt = w & 3, th = w >> 2, tt = w & 3, sh = w >> 2;
    f32x4 S[4], N[4];
    { const float* cm = (const float*)(ws + WS_CMETA) + (size_t)h * 128 * 256 + vq * 64 + vt * 16 + fr; const float* nm = (const float*)(ws + WS_NMETA) + h * 128;
#pragma unroll
      for (int j = 0; j < 4; ++j)
#pragma unroll
          for (int r = 0; r < 4; ++r) { S[j][r] = cm[(16 * (4 * th + j) + 4 * g + r) * 256]; N[j][r] = nm[16 * (4 * th + j) + 4 * g + r]; } }
    LAS unsigned char* XS = lds + 106496;
    const u32x4 onew = {0x3F803F80u, 0x3F803F80u, 0x3F803F80u, 0x3F803F80u}; const bf16x8_t ones = __builtin_bit_cast(bf16x8_t, onew);
    const int r0 = tid >> 4, c0 = tid & 15, rv = tid >> 3, cv = tid & 7;
    u32x4 pq0, pq1, pk0, pk1, pv; f32x4 pe;
#define ML_FETCH(c) do { const size_t t0 = (size_t)b * SEQ + (size_t)(c) * 64; \
        pq0 = *(const u32x4*)(QK + (t0 + r0) * D + h * 128 + c0 * 8); pq1 = *(const u32x4*)(QK + (t0 + r0 + 32) * D + h * 128 + c0 * 8); \
        pk0 = *(const u32x4*)(QK + (t0 + r0) * D + 512 + h * 128 + c0 * 8); pk1 = *(const u32x4*)(QK + (t0 + r0 + 32) * D + 512 + h * 128 + c0 * 8); \
        pv = *(const u32x4*)(VB + (t0 + rv) * D + h * 256 + vq * 64 + cv * 8); \
        if (tid < 64) pe = GT[(t0 + tid) * 4 + h]; } while (0)
#define ML_COMMIT(sb) do { LAS unsigned char* B_ = lds + (sb); *(LAS u32x4*)(B_ + r0 * SC_QS + c0 * 16) = pq0; *(LAS u32x4*)(B_ + (r0 + 32) * SC_QS + c0 * 16) = pq1; \
        *(LAS u32x4*)(B_ + 17408 + r0 * SC_QS + c0 * 16) = pk0; *(LAS u32x4*)(B_ + 17408 + (r0 + 32) * SC_QS + c0 * 16) = pk1; \
        *(LAS u32x4*)(B_ + 34816 + rv * SC_VS + cv * 16) = pv; \
        if (tid < 64) *(LAS f32x4*)(B_ + 44032 + tid * 16) = pe; } while (0)
    __syncthreads();
    ML_FETCH(0); ML_COMMIT(0);
    __syncthreads();
    for (int c = 0; c < SEQ / 64; ++c) {
        const int sb = (c & 1) * S3_SET;
        LAS unsigned char* Q_ = lds + sb; LAS unsigned char* K_ = Q_ + 17408; LAS unsigned char* V_ = Q_ + 34816; LAS unsigned char* G_ = Q_ + 44032; LAS unsigned char* P_ = lds + S3_P;
        if (c + 1 < SEQ / 64) ML_FETCH(c + 1);
        const float decay = (*(const LAS f32x4*)G_).w;
        bf16x8_t afo[2], ano[2];
        {
            bf16x8_t bq[4];
#pragma unroll
            for (int ks = 0; ks < 4; ++ks) bq[ks] = *(const LAS bf16x8_t*)(Q_ + (tt * 16 + fr) * SC_QS + ks * 64 + g * 16);
            bf16x8_t ak[2][4];
#pragma unroll
            for (int si = 0; si < 2; ++si)
#pragma unroll
                for (int ks = 0; ks < 4; ++ks) ak[si][ks] = *(const LAS bf16x8_t*)(K_ + ((2 * sh + si) * 16 + fr) * SC_QS + ks * 64 + g * 16);
#pragma unroll
            for (int j = 0; j < 4; ++j) { S[j] = S[j] * decay; N[j] = N[j] * decay; }
#pragma unroll
            for (int jj = 0; jj < 2; ++jj) { afo[jj] = pack8(S[2 * jj], S[2 * jj + 1]); ano[jj] = pack8(N[2 * jj], N[2 * jj + 1]);
                *(LAS bf16x8_t*)(XS + ((w * 2 + jj) * 2 + 0) * 1024 + lane * 16) = afo[jj]; *(LAS bf16x8_t*)(XS + ((w * 2 + jj) * 2 + 1) * 1024 + lane * 16) = ano[jj]; }
            f32x4 accA[2] = {{0.f, 0.f, 0.f, 0.f}, {0.f, 0.f, 0.f, 0.f}};
#pragma unroll
            for (int ks = 0; ks < 4; ++ks)
#pragma unroll
                for (int si = 0; si < 2; ++si) accA[si] = __builtin_amdgcn_mfma_f32_16x16x32_bf16(ak[si][ks], bq[ks], accA[si], 0, 0, 0);
#pragma unroll
            for (int si = 0; si < 2; ++si) { const int st = 2 * sh + si; const f32x4 acc = accA[si];
                const int t = tt * 16 + fr, s0 = st * 16 + 4 * g; u32x2 pw;
                pw.x = pk2(s0 + 0 <= t ? acc[0] : 0.f, s0 + 1 <= t ? acc[1] : 0.f); pw.y = pk2(s0 + 2 <= t ? acc[2] : 0.f, s0 + 3 <= t ? acc[3] : 0.f);
                *(LAS u32x2*)(P_ + t * SC_VS + s0 * 2) = pw; }
        }
        __syncthreads();
        {
            bf16x8_t vfr[2];
            bf16x8_t af4[4], an4[4];
            { bf16x8_t pa[2], pn[2];
#pragma unroll
              for (int jj = 0; jj < 2; ++jj) { pa[jj] = *(const LAS bf16x8_t*)(XS + (((w ^ 4) * 2 + jj) * 2 + 0) * 1024 + lane * 16); pn[jj] = *(const LAS bf16x8_t*)(XS + (((w ^ 4) * 2 + jj) * 2 + 1) * 1024 + lane * 16); }
              if (th == 0) { af4[0] = afo[0]; af4[1] = afo[1]; af4[2] = pa[0]; af4[3] = pa[1]; an4[0] = ano[0]; an4[1] = ano[1]; an4[2] = pn[0]; an4[3] = pn[1]; }
              else { af4[0] = pa[0]; af4[1] = pa[1]; af4[2] = afo[0]; af4[3] = afo[1]; an4[0] = pn[0]; an4[1] = pn[1]; an4[2] = ano[0]; an4[3] = ano[1]; } }
#pragma unroll
            for (int k2 = 0; k2 < 2; ++k2) { LAS unsigned char* pa = V_ + (32 * k2 + 8 * g + q4) * SC_VS + (vt * 16 + 4 * p4) * 2; vfr[k2] = cat44(tr16(pa), tr16(pa + 4 * SC_VS)); }
            const size_t t0 = (size_t)b * SEQ + (size_t)c * 64;
#pragma unroll
            for (int ti = 0; ti < 2; ++ti) { const int t = (2 * th + ti) * 16 + fr; f32x4 acc = {0.f, 0.f, 0.f, 0.f}, accd = {0.f, 0.f, 0.f, 0.f};
                bf16x8_t qfM[4], pfM[2];
#pragma unroll
                for (int ks = 0; ks < 4; ++ks) { const u32x2 lo = *(const LAS u32x2*)(Q_ + t * SC_QS + (32 * ks + 4 * g) * 2), hi = *(const LAS u32x2*)(Q_ + t * SC_QS + (32 * ks + 16 + 4 * g) * 2); qfM[ks] = cat22(lo, hi); }
#pragma unroll
                for (int k2 = 0; k2 < 2; ++k2) pfM[k2] = *(const LAS bf16x8_t*)(P_ + t * SC_VS + (32 * k2 + 8 * g) * 2);
                const f32x4 gz = *(const LAS f32x4*)(G_ + t * 16);
#pragma unroll
                for (int ks = 0; ks < 4; ++ks) {
                    acc = __builtin_amdgcn_mfma_f32_16x16x32_bf16(af4[ks], qfM[ks], acc, 0, 0, 0); accd = __builtin_amdgcn_mfma_f32_16x16x32_bf16(an4[ks], qfM[ks], accd, 0, 0, 0); }
#pragma unroll
                for (int k2 = 0; k2 < 2; ++k2) {
                    acc = __builtin_amdgcn_mfma_f32_16x16x32_bf16(vfr[k2], pfM[k2], acc, 0, 0, 0); accd = __builtin_amdgcn_mfma_f32_16x16x32_bf16(ones, pfM[k2], accd, 0, 0, 0); }
                const float inv = __builtin_amdgcn_rcpf(fmaxf(fabsf(accd[0]), gz.z));
                const float h0_ = acc[0] * inv, h1_ = acc[1] * inv, h2_ = acc[2] * inv, h3_ = acc[3] * inv;
                u32x2 ow; ow.x = pk2(h0_, h1_); ow.y = pk2(h2_, h3_);
                *(u32x2*)(VB + (t0 + t) * D + h * 256 + vq * 64 + vt * 16 + 4 * g) = ow;
                float s1 = (h0_ + h1_) + (h2_ + h3_), s2 = (h0_ * h0_ + h1_ * h1_) + (h2_ * h2_ + h3_ * h3_);
                s1 += __shfl_xor(s1, 16); s1 += __shfl_xor(s1, 32); s2 += __shfl_xor(s2, 16); s2 += __shfl_xor(s2, 32);
                if (g == 0) { *(LAS float*)(lds + S3_ST + (vt * 64 + t) * 4) = s1; *(LAS float*)(lds + S3_ST + 1024 + (vt * 64 + t) * 4) = s2; } }
#pragma unroll
            for (int j = 0; j < 4; ++j) { const int kt = 4 * th + j;
#pragma unroll
                for (int k2 = 0; k2 < 2; ++k2) { LAS unsigned char* pa = K_ + (32 * k2 + 8 * g + q4) * SC_QS + (16 * kt + 4 * p4) * 2; const bf16x8_t ak = cat44(tr16(pa), tr16(pa + 4 * SC_QS));
                    S[j] = __builtin_amdgcn_mfma_f32_16x16x32_bf16(ak, vfr[k2], S[j], 0, 0, 0); N[j] = __builtin_amdgcn_mfma_f32_16x16x32_bf16(ak, ones, N[j], 0, 0, 0); } }
        }
        if (c + 1 < SEQ / 64) ML_COMMIT(S3_SET - sb);
        __syncthreads();
        if (tid < 128) { const int tk = tid & 63, wh = tid >> 6; const LAS float* sp = (const LAS float*)(lds + S3_ST + wh * 1024) + tk;
            ((float*)(ws + WS_STB2))[(((size_t)b * SEQ + (size_t)c * 64 + tk) * 16 + h * 4 + vq) * 2 + wh] = (sp[0] + sp[64]) + (sp[128] + sp[192]); }
    }
#undef ML_FETCH
#undef ML_COMMIT
}

__device__ __forceinline__ void p_ln1_route(const Args& a, LAS unsigned char* lds) {
    unsigned char* ws = a.ws; const int tid = tidx_(a.wv), lane = tid & 63, wave = tid >> 6, fr = lane & 15, g = lane >> 4;
    LAS int* hist = (LAS int*)lds; LAS float* rbs = (LAS float*)(lds + 256);
    LAS unsigned char* hw = lds + 1024 + wave * 17408;
    LAS float* st = (LAS float*)(lds + 1024 + 8 * 17408 + wave * 256);
    const bf16* z = (const bf16*)(ws + WS_Z); const bf16* WT = (const bf16*)(ws + WS_WRT);
    bf16* h1 = (bf16*)(ws + WS_H0); float* lnst = (float*)(ws + WS_LNST1);
    int* eidx = (int*)(ws + WS_EIDX); float* gwp = (float*)(ws + WS_GW); int* lpos = (int*)(ws + WS_LPOS); int* wgbase = (int*)(ws + WS_WGBASE);
    unsigned* gcnt = (unsigned*)(ws + WS_CTL) + CW_GCNT;
    for (int tile = blockIdx.x; tile < T / 256; tile += gridDim.x) {
        const int half = tile / (T / 512), m0 = tile * 256 + wave * 32;
        __syncthreads();
        if (tid < 64) { hist[tid] = 0; rbs[tid] = a.in[18][tid]; }
        __syncthreads();
        {
            const f32x4* gp = (const f32x4*)a.in[15] + lane; const f32x4* bp = (const f32x4*)a.in[16] + lane;
            f32x4 gg[4], bb[4]; u32x2 zq[4][4];
#pragma unroll
            for (int j = 0; j < 4; ++j) { gg[j] = gp[64 * j]; bb[j] = bp[64 * j]; }
#pragma unroll
            for (int q = 0; q < 3; ++q)
#pragma unroll
                for (int j = 0; j < 4; ++j) zq[q][j] = ((const u32x2*)(z + (size_t)(m0 + q) * D) + lane)[64 * j];
#pragma unroll 1
            for (int r4 = 0; r4 < 32; r4 += 4) {
#pragma unroll
                for (int q = 0; q < 4; ++q) {
                    const int rr = r4 + q, m = m0 + rr; f32x4 v[4]; float s = 0.f, s2 = 0.f;
                    if (rr + 3 < 32) {
#pragma unroll
                        for (int j = 0; j < 4; ++j) zq[(q + 3) & 3][j] = ((const u32x2*)(z + (size_t)(m + 3) * D) + lane)[64 * j]; }
#pragma unroll
                    for (int j = 0; j < 4; ++j) { const u32x2 zw = zq[q][j]; v[j] = (f32x4){bf2f(zw.x & 0xffffu), bf2f(zw.x >> 16), bf2f(zw.y & 0xffffu), bf2f(zw.y >> 16)};
                        s += (v[j].x + v[j].y) + (v[j].z + v[j].w); s2 += (v[j].x * v[j].x + v[j].y * v[j].y) + (v[j].z * v[j].z + v[j].w * v[j].w); }
                    const float mean = wave_sum(s) * (1.f / D), ex2 = wave_sum(s2) * (1.f / D);
                    const float rstd = 1.f / sqrtf(fmaxf(ex2 - mean * mean, 0.f) + EPS);
                    unsigned* o4 = (unsigned*)(ws + WS_H8 + (size_t)m * D) + lane;
#pragma unroll
                    for (int j = 0; j < 4; ++j) { const f32x4 h = (v[j] - mean) * rstd * gg[j] + bb[j];
                        int w8 = __builtin_amdgcn_cvt_pk_fp8_f32(h.x, h.y, 0, false); w8 = __builtin_amdgcn_cvt_pk_fp8_f32(h.z, h.w, w8, true); o4[64 * j] = (unsigned)w8; }
                    if (lane == 0) { lnst[2 * m] = mean; lnst[2 * m + 1] = rstd; st[2 * rr] = mean; st[2 * rr + 1] = rstd; }
                }
            }
        }
        asm volatile("s_waitcnt lgkmcnt(0)" ::: "memory");
        f32x4 acc[2][4];
#pragma unroll
        for (int mt = 0; mt < 2; ++mt)
#pragma unroll
            for (int n = 0; n < 4; ++n) acc[mt][n] = (f32x4){0.f, 0.f, 0.f, 0.f};
        int lane2 = lane; asm volatile("" : "+v"(lane2));
        const int kk = (lane2 & 31) * 4; const bf16* zrow = z + (size_t)(m0 + (lane2 >> 5)) * D + kk;
        u32x2 zc[16];
#pragma unroll
        for (int i = 0; i < 16; ++i) zc[i] = *(const u32x2*)(zrow + (size_t)(2 * i) * D);
        bf16x8_t bh[2][4], bl[2][4];
#pragma unroll
        for (int n = 0; n < 4; ++n) { const bf16* wp = WT + (size_t)(16 * n + fr) * 1024 + g * 8; bh[0][n] = *(const bf16x8_t*)wp; bl[0][n] = *(const bf16x8_t*)(wp + 65536); }
#pragma unroll 1
        for (int kc = 0; kc < 8; ++kc) {
            { const f32x4 g4 = *(const f32x4*)(a.in[15] + kc * 128 + kk), b4 = *(const f32x4*)(a.in[16] + kc * 128 + kk);
#pragma unroll
              for (int i = 0; i < 16; ++i) { const int row = 2 * i + (lane2 >> 5); const u32x2 zw = zc[i];
                  const f32x4 z4 = {bf2f(zw.x & 0xffffu), bf2f(zw.x >> 16), bf2f(zw.y & 0xffffu), bf2f(zw.y >> 16)};
                  const float mean = st[2 * row], rstd = st[2 * row + 1]; const f32x4 h = (z4 - mean) * rstd * g4 + b4;
                  u32x2 hi; hi.x = pk2(h.x, h.y); hi.y = pk2(h.z, h.w);
                  const f32x4 hr = {bf2f(hi.x & 0xffffu), bf2f(hi.x >> 16), bf2f(hi.y & 0xffffu), bf2f(hi.y >> 16)}; const f32x4 l4 = h - hr;
                  u32x2 lo; lo.x = pk2(l4.x, l4.y); lo.y = pk2(l4.z, l4.w);
                  *(LAS u32x2*)(hw + row * 272 + kk * 2) = hi; *(LAS u32x2*)(hw + 8704 + row * 272 + kk * 2) = lo; }
              if (kc + 1 < 8) {
#pragma unroll
                  for (int i = 0; i < 16; ++i) zc[i] = *(const u32x2*)(zrow + (size_t)(2 * i) * D + (kc + 1) * 128); } }
            asm volatile("s_waitcnt lgkmcnt(0)" ::: "memory");
#pragma unroll
            for (int ks = 0; ks < 4; ++ks) {
                const int cb = ks & 1, nb = cb ^ 1; const int kn = kc * 4 + ks + 1;
                if (kn < 32) {
#pragma unroll
                    for (int n = 0; n < 4; ++n) { const bf16* wp = WT + (size_t)(16 * n + fr) * 1024 + kn * 32 + g * 8; bh[nb][n] = *(const bf16x8_t*)wp; bl[nb][n] = *(const bf16x8_t*)(wp + 65536); } }
                bf16x8_t ah[2], al[2];
#pragma unroll
                for (int mt = 0; mt < 2; ++mt) { ah[mt] = *(const LAS bf16x8_t*)(hw + (16 * mt + fr) * 272 + ks * 64 + g * 16); al[mt] = *(const LAS bf16x8_t*)(hw + 8704 + (16 * mt + fr) * 272 + ks * 64 + g * 16); }
#pragma unroll
                for (int n = 0; n < 4; ++n) {
#pragma unroll
                    for (int mt = 0; mt < 2; ++mt) { acc[mt][n] = __builtin_amdgcn_mfma_f32_16x16x32_bf16(ah[mt], bh[cb][n], acc[mt][n], 0, 0, 0);
                        acc[mt][n] = __builtin_amdgcn_mfma_f32_16x16x32_bf16(al[mt], bh[cb][n], acc[mt][n], 0, 0, 0); acc[mt][n] = __builtin_amdgcn_mfma_f32_16x16x32_bf16(ah[mt], bl[cb][n], acc[mt][n], 0, 0, 0); } }
            }
            asm volatile("s_waitcnt lgkmcnt(0)" ::: "memory");
        }
        { LAS float* lg = (LAS float*)hw;
#pragma unroll
          for (int mt = 0; mt < 2; ++mt)
#pragma unroll
              for (int n = 0; n < 4; ++n)
#pragma unroll
                  for (int r = 0; r < 4; ++r) lg[(16 * mt + 4 * g + r) * 65 + 16 * n + fr] = acc[mt][n][r]; }
        asm volatile("s_waitcnt lgkmcnt(0)" ::: "memory");
        if (lane < 32) {
            const LAS float* lg = (const LAS float*)hw + lane * 65; const int m = m0 + lane;
            float bsc[64];
#pragma unroll
            for (int e2 = 0; e2 < 64; ++e2) bsc[e2] = 1.0f / (1.0f + expf(-lg[e2])) + rbs[e2];
            float gs[8];
#pragma unroll
            for (int gi = 0; gi < 8; ++gi) { float m1 = -INFINITY, m2 = -INFINITY;
#pragma unroll
                for (int j = 0; j < 8; ++j) { const float v = bsc[8 * gi + j]; m2 = fmaxf(m2, fminf(m1, v)); m1 = fmaxf(m1, v); }
                gs[gi] = m1 + m2; }
            unsigned selmask = 0;
#pragma unroll
            for (int gi = 0; gi < 8; ++gi) { int rank = 0;
#pragma unroll
                for (int gj = 0; gj < 8; ++gj) rank += (gs[gj] > gs[gi] || (gs[gj] == gs[gi] && gj < gi)) ? 1 : 0;
                selmask |= (rank < 4) ? (1u << gi) : 0u; }
            float tv[8]; int te[8];
#pragma unroll
            for (int i = 0; i < 8; ++i) { tv[i] = -INFINITY; te[i] = 0; }
#pragma unroll
            for (int e2 = 0; e2 < 64; ++e2) { float v = ((selmask >> (e2 >> 3)) & 1u) ? bsc[e2] : -INFINITY; int id = e2;
#pragma unroll
                for (int i = 0; i < 8; ++i) { const bool sw = v > tv[i]; const float tvv = tv[i]; const int tee = te[i]; tv[i] = sw ? v : tvv; te[i] = sw ? id : tee; v = sw ? tvv : v; id = sw ? tee : id; } }
            float sc[8], ssum = 0.f;
#pragma unroll
            for (int i = 0; i < 8; ++i) { sc[i] = tv[i] - rbs[te[i]]; ssum += sc[i]; }
            const float scale = ROUTED_SCALE / ssum;
#pragma unroll
            for (int i = 0; i < 8; ++i) { eidx[(size_t)m * 8 + i] = te[i]; gwp[(size_t)m * 8 + i] = sc[i] * scale; lpos[(size_t)m * 8 + i] = atomicAdd((int*)&hist[te[i]], 1); }
        }
        __syncthreads();
        if (tid < 64) wgbase[tile * 64 + tid] = (int)atomicAdd(&gcnt[half * 64 + tid], (unsigned)hist[tid]);
    }
}
__device__ __forceinline__ void load_pstart(const Args& a, LAS int* ps) {
    const unsigned* gcnt = (const unsigned*)(a.ws + WS_CTL) + CW_GCNT;
    __syncthreads();
    const int tid = tidx_(a.wv);
    if (tid < 128) {
        const int hf = tid >> 6, e = tid & 63; const int c = (int)__hip_atomic_load(gcnt + tid, __ATOMIC_RELAXED, __HIP_MEMORY_SCOPE_AGENT);
        const int p = (c + 255) / 256 * 256; int inc = p;
#pragma unroll
        for (int d = 1; d < 64; d <<= 1) { const int o = __shfl_up(inc, d, 64); if (e >= d) inc += o; }
        ps[hf * 65 + e] = inc - p; if (e == 63) ps[hf * 65 + 64] = inc;
    }
    __syncthreads();
}
__device__ __forceinline__ void p_slots(const Args& a, LAS unsigned char* lds) {
    unsigned char* ws = a.ws; LAS int* ps = (LAS int*)lds; load_pstart(a, ps);
    const int* eidx = (const int*)(ws + WS_EIDX); const float* gwp = (const float*)(ws + WS_GW); const int* lpos = (const int*)(ws + WS_LPOS); const int* wgbase = (const int*)(ws + WS_WGBASE);
    int* slotof = (int*)(ws + WS_SLOTOF); int* tokslot = (int*)(ws + WS_TOKSLOT); float* wslot = (float*)(ws + WS_WSLOT);
    for (int tile = blockIdx.x; tile < T / 256; tile += gridDim.x) {
        const int half = tile / (T / 512);
        for (int i = tidx_(a.wv); i < 256 * 8; i += 512) { const size_t idx = (size_t)tile * 2048 + i; const int e = eidx[idx];
            const int slot = ps[half * 65 + e] + wgbase[tile * 64 + e] + lpos[idx];
            slotof[idx] = slot; tokslot[(size_t)half * NSLOTMAX + slot] = (int)(idx >> 3); wslot[(size_t)half * NSLOTMAX + slot] = gwp[idx]; }
    }
}
template <bool DOWN>
__device__ __forceinline__ void f_moe_gemm(const Args& a, LAS unsigned char* lds, int half) {
    unsigned char* ws = a.ws; LAS int* ps = (LAS int*)(lds + 131072); LAS int* te = (LAS int*)(lds + 131072 + 1024); load_pstart(a, ps);
    const int nrt = __builtin_amdgcn_readfirstlane(ps[half * 65 + 64] / 256);
    for (int rt = tidx_(a.wv); rt < nrt; rt += 512) { int e = 0; for (int j = 1; j < 64; ++j) if (ps[half * 65 + j] <= rt * 256) e = j; te[rt] = e; }
    __syncthreads();
    pg8::GroupedOrder S; S.te = te; S.nct = DOWN ? 4 : 2; S.nrt = nrt; S.nwg1 = nrt * S.nct; S.nwg2 = (HALF_T / 256) * S.nct; S.G = gridDim.x; S.c = blockIdx.x;
    S.idx = (const int*)(ws + WS_TOKSLOT) + (size_t)half * NSLOTMAX; S.ident = (const int*)(ws + WS_IDENT) + half * HALF_T;
    if (!DOWN) { S.K = 512; S.A = (const char*)(ws + WS_H8); S.Bt = (const char*)(ws + WS_WGU); S.Bsh = (const char*)(ws + WS_WSGU); S.estride = (size_t)512 * 1024; S.gather = true;
        const EpiGU eg{(unsigned char*)(ws + WS_HH), (const float*)(ws + WS_WSLOT) + (size_t)half * NSLOTMAX}, egs{(unsigned char*)(ws + WS_HH), nullptr};
        pg8::gemm_phase2<true, false, true>(lds, a.wv, 512, S, eg, egs); }
    else { S.K = 128; S.A = (const char*)(ws + WS_HH); S.Bt = (const char*)(ws + WS_WD); S.Bsh = (const char*)(ws + WS_WSD); S.estride = (size_t)1024 * 256; S.gather = false;
        const EpiDown ed{(unsigned char*)(ws + WS_YH), (const float*)(ws + WS_WSLOT) + (size_t)half * NSLOTMAX}; const EpiSD2 es{ws, half * HALF_T};
        pg8::gemm_phase2<false, false, true, true>(lds, a.wv, 128, S, ed, es); }
}
__device__ __forceinline__ void p_combine(const Args& a, int half) {
    unsigned char* ws = a.ws; const int lane = tidx_(a.wv) & 63, gw = blockIdx.x * 8 + (tidx_(a.wv) >> 6), NGW = gridDim.x * 8;
    const int c0 = (lane >> 4) * 256 + (lane & 15) * 8;
    const unsigned char* Y = (const unsigned char*)(ws + WS_YH); const int* slotof = (const int*)(ws + WS_SLOTOF);
    f32x4 g1[4], b1[4];
#pragma unroll
    for (int q = 0; q < 4; ++q) { const int c = c0 + (q >> 1) * 128 + (q & 1) * 4; g1[q] = *(const f32x4*)(a.in[15] + c); b1[q] = *(const f32x4*)(a.in[16] + c); }
#pragma unroll 1
    for (int mm = gw; mm < HALF_T; mm += 2 * NGW) {
        int sl[2][8]; u32x4 zw[2][2], rw[2][2], yw[2][8]; f32x2_t st1[2];
#pragma unroll
        for (int t = 0; t < 2; ++t) { const int m = half * HALF_T + ((t == 1 && mm + NGW >= HALF_T) ? mm : mm + t * NGW);
#pragma unroll
            for (int k = 0; k < 8; ++k) sl[t][k] = slotof[(size_t)m * 8 + k]; }
#pragma unroll
        for (int t = 0; t < 2; ++t) { const int m = half * HALF_T + ((t == 1 && mm + NGW >= HALF_T) ? mm : mm + t * NGW);
            const bf16* zr = (const bf16*)(ws + WS_Z) + (size_t)m * D + c0; const bf16* rr_ = (const bf16*)(ws + WS_H0) + (size_t)m * D + c0;
            st1[t] = *(const f32x2_t*)((const float*)(ws + WS_LNST1) + 2 * (size_t)m);
            zw[t][0] = *(const u32x4*)zr; zw[t][1] = *(const u32x4*)(zr + 128); rw[t][0] = *(const u32x4*)rr_; rw[t][1] = *(const u32x4*)(rr_ + 128); }
#pragma unroll
        for (int t = 0; t < 2; ++t)
#pragma unroll
            for (int k = 0; k < 8; ++k) yw[t][k] = *(const u32x4*)(Y + (size_t)sl[t][k] * D + 16 * lane);
#pragma unroll
        for (int t = 0; t < 2; ++t) { const int m = half * HALF_T + ((t == 1 && mm + NGW >= HALF_T) ? mm : mm + t * NGW);
            f32x4 v[4];
#pragma unroll
            for (int hq = 0; hq < 2; ++hq) { float zz[8], sd[8]; unpack8(zw[t][hq], zz); unpack8(rw[t][hq], sd);
#pragma unroll
                for (int p = 0; p < 2; ++p) { const int q = hq * 2 + p; const f32x4 z4 = {zz[4 * p], zz[4 * p + 1], zz[4 * p + 2], zz[4 * p + 3]}, s4 = {sd[4 * p], sd[4 * p + 1], sd[4 * p + 2], sd[4 * p + 3]};
                    v[q] = ((z4 - st1[t].x) * st1[t].y * g1[q] + b1[q]) * DN_ALPHA + s4; } }
            f32x4 ys[4];
#pragma unroll
            for (int q = 0; q < 4; ++q) ys[q] = (f32x4){0.f, 0.f, 0.f, 0.f};
#pragma unroll
            for (int k = 0; k < 8; ++k)
#pragma unroll
                for (int q = 0; q < 4; ++q) { const int w = (int)yw[t][k][q]; const f32x2_t lo = __builtin_amdgcn_cvt_pk_f32_fp8(w, false), hi = __builtin_amdgcn_cvt_pk_f32_fp8(w, true);
                    ys[q].x += lo.x; ys[q].y += lo.y; ys[q].z += hi.x; ys[q].w += hi.y; }
#pragma unroll
            for (int q = 0; q < 4; ++q) v[q] = v[q] + ys[q] * 0.03125f;
            f32x4 g2[4], b2[4];
            { const float* gp2 = a.in[25] + c0; const float* bp2 = a.in[26] + c0; asm volatile("" : "+v"(gp2), "+v"(bp2));
#pragma unroll
              for (int q = 0; q < 4; ++q) { g2[q] = *(const f32x4*)(gp2 + (q >> 1) * 128 + (q & 1) * 4); b2[q] = *(const f32x4*)(bp2 + (q >> 1) * 128 + (q & 1) * 4); } }
            float s = 0.f;
#pragma unroll
            for (int q = 0; q < 4; ++q) s += (v[q].x + v[q].y) + (v[q].z + v[q].w);
            const float mean = wave_sum(s) * (1.f / D); float s2 = 0.f;
#pragma unroll
            for (int q = 0; q < 4; ++q) { v[q] = v[q] - mean; s2 += (v[q].x * v[q].x + v[q].y * v[q].y) + (v[q].z * v[q].z + v[q].w * v[q].w); }
            const float rstd = 1.f / sqrtf(wave_sum(s2) * (1.f / D) + EPS);
            if (t == 0 || mm + NGW < HALF_T) { float* orow = a.out + (size_t)m * D + c0;
#pragma unroll
                for (int q = 0; q < 4; ++q) *(f32x4*)(orow + (q >> 1) * 128 + (q & 1) * 4) = v[q] * rstd * g2[q] + b2[q]; }
        }
    }
}

__global__ void __launch_bounds__(512, 2) fwd(const KArgs ka) {
    extern __shared__ __attribute__((aligned(16))) unsigned char lds_raw[];
    LAS unsigned char* lds = (LAS unsigned char*)lds_raw;
    const Args a{ka.in, ka.out, ka.ws, __builtin_amdgcn_readfirstlane((int)threadIdx.x >> 6)};
    unsigned char* ws = a.ws;
    const int lo = ka.ph_lo, hi = ka.ph_hi;
    volatile LAS unsigned* bst = (volatile LAS unsigned*)(lds + LDS_BYTES - 16);
    const bool lead = tidx_(a.wv) == 0;
    if (lead) { bst[0] = 0u; bst[1] = 0u; }
    __syncthreads();
    XcdBarrier bar = xcd_barrier_post((unsigned*)(ws + WS_CTL) + CW_BAR, bst, lead);
#ifndef PH_MASK
#define PH_MASK 0xFFFFFFFFu
#endif
#define IN(k) ((((PH_MASK) >> (k)) & 1u) && lo <= (k) && (k) < hi)
#ifdef PROBE_MASK
    long long pt_ = 0;
#define PT0(k) do { if (((PROBE_MASK) >> (k)) & 1u) pt_ = (long long)__builtin_amdgcn_s_memrealtime(); } while (0)
#define PT1(k) do { if (((PROBE_MASK) >> (k)) & 1u) { __syncthreads(); const long long t1_ = (long long)__builtin_amdgcn_s_memrealtime(); while ((long long)__builtin_amdgcn_s_memrealtime() - t1_ < 3 * (t1_ - pt_)) __builtin_amdgcn_s_sleep(8); } } while (0)
#else
#define PT0(k) do {} while (0)
#define PT1(k) do {} while (0)
#endif
#define SEAM(k) do { if (IN(k) && IN((k) + 1)) xcd_barrier(bar); } while (0)
    PT0(0); if (IN(0)) p0_prologue(a, lds); PT1(0);
    SEAM(0);
    if (IN(1)) { for (int u = blockIdx.x; u < 32; u += gridDim.x) s0_mlstm_gates(a, lds, u >> 2, u & 3); }
PT0(1); if (IN(1)) fgemm_dense(lds, a.wv, (const bf16*)(ws + WS_H0), (const bf16*)(ws + WS_WINT), T, 7168, 1024, EpiA{ws, (unsigned char*)a.out, a.in[5]}); PT1(1);
    SEAM(1);
PT0(2); if (IN(2)) s0_prepass(a, lds); PT1(2);
    SEAM(2);
    if (IN(3)) { for (int u = blockIdx.x; u < 256; u += gridDim.x) { const int x = u & 7, y = u >> 3; if (y < 16) { const int pi = x * 8 + (y >> 1); fscan3_hgrn(a, lds, pi >> 3, pi & 7, y & 1); } } }
    asm volatile("" ::: "memory");
    if (IN(3)) { for (int u = blockIdx.x; u < 256; u += gridDim.x) { const int x = u & 7, y = u >> 3; if (y >= 16) { const int qi = x * 4 + ((y - 16) >> 2); fscan3_mlstm(a, lds, qi >> 2, qi & 3, (y - 16) & 3); } } }
    if (IN(3) && IN(5)) xcd_barrier(bar);
PT0(5); if (IN(5)) fgemm_dense(lds, a.wv, (const bf16*)(ws + WS_H0), (const bf16*)(ws + WS_WINT) + (size_t)7168 * 1024, T, 2048, 1024, EpiB{ws, a.in[6], a.in[11]}); PT1(5);
    SEAM(5);
PT0(6); if (IN(6)) fgemm_paired(lds, a.wv, (const bf16*)(ws + WS_LFA), (const bf16*)(ws + WS_WAT), (const bf16*)(ws + WS_QKB), (const bf16*)(ws + WS_WBT), T, 1024, 1024, EpiC{ws, (const bf16*)a.out, (const bf16*)a.out + (size_t)T * D}); PT1(6);
    SEAM(6);
PT0(7); if (IN(7)) fgemm_dense(lds, a.wv, (const bf16*)(ws + WS_IA), (const bf16*)(ws + WS_WOT), T, 1024, 1024, EpiD{ws}); PT1(7);
    SEAM(7);
PT0(8); if (IN(8)) p_ln1_route(a, lds); PT1(8);
    SEAM(8);
    if (IN(9)) p_slots(a, lds);
    SEAM(9);
PT0(10); if (IN(10)) f_moe_gemm<false>(a, lds, 0); PT1(10);
    SEAM(10);
PT0(11); if (IN(11)) f_moe_gemm<true>(a, lds, 0); PT1(11);
    SEAM(11);
PT0(12); if (IN(12)) p_combine(a, 0); PT1(12);
    __syncthreads();
PT0(13); if (IN(13)) f_moe_gemm<false>(a, lds, 1); PT1(13);
    SEAM(13);
PT0(14); if (IN(14)) f_moe_gemm<true>(a, lds, 1); PT1(14);
    SEAM(14);
PT0(15); if (IN(15)) p_combine(a, 1); PT1(15);
#undef IN
#undef SEAM
}

extern "C" void kernel_launch(void* const* d_in, const int* in_sizes, int n_in, void* d_out, int out_size, void* d_ws, size_t ws_size, hipStream_t stream) {
    static int grid = 0;
    if (grid == 0) {
        if (n_in != 27 || out_size != T * D || ws_size < WS_END) { fprintf(stderr, "kernel_launch: unexpected shapes (n_in %d out %d ws %zu)\n", n_in, out_size, ws_size); grid = -1; return; }
        int dev = 0, cus = 0;
        if (hipGetDevice(&dev) != hipSuccess || hipDeviceGetAttribute(&cus, hipDeviceAttributeMultiprocessorCount, dev) != hipSuccess) { grid = -1; return; }
        if (hipFuncSetAttribute((const void*)fwd, hipFuncAttributeMaxDynamicSharedMemorySize, LDS_BYTES) != hipSuccess) { grid = -1; return; }
        int per_cu = 0; (void)hipOccupancyMaxActiveBlocksPerMultiprocessor(&per_cu, (const void*)fwd, 512, LDS_BYTES); (void)hipGetLastError();
        grid = cus;
    }
    if (grid < 0) return;
    (void)hipMemsetAsync((char*)d_ws + WS_CTL + CW_BAR * 4, 0, (CW_GCNT + 128 - CW_BAR) * 4, stream);
    KArgs a{};
    for (int i = 0; i < 27; ++i) a.in[i] = (const float*)d_in[i];
    a.out = (float*)d_out; a.ws = (unsigned char*)d_ws;
    a.ph_lo = 0; a.ph_hi = 16; hipLaunchKernelGGL(fwd, dim3(grid), dim3(512), LDS_BYTES, stream, a);
}
```
